# Optimizing an MI355X kernel written in HIP

```python
import math
import jax
import jax.numpy as jnp
from jax import lax
import numpy as np

D_MODEL = 2048
BATCH = 32
SEQ = 256
DEPTH = 2
DEC_BATCH = 4
DEC_SEQ = 2048
PAST_LEN = 512

GRID_W = 64
N_DIR = 2
EPS = 1e-6
RWKV_WIDTH = 1024
RWKV_HEAD = 64
RWKV_HEADS = RWKV_WIDTH // RWKV_HEAD
RWKV_DECAY_RANK = 64
RWKV_AICL_RANK = 64
RWKV_GATE_RANK = 128
RWKV_LN_EPS = 64e-5
RWKV_COLS = 3 * RWKV_WIDTH + RWKV_DECAY_RANK + RWKV_AICL_RANK + RWKV_GATE_RANK
SSD_WIDTH = 1024
SSD_HEAD = 64
SSD_HEADS = SSD_WIDTH // SSD_HEAD
SSD_GROUPS = 2
SSD_STATE = 128
SSD_CONV = 5
SSD_CHUNK = 128
SSD_XBC = SSD_WIDTH + 2 * SSD_GROUPS * SSD_STATE
SSD_COLS = SSD_WIDTH + SSD_XBC + SSD_HEADS
S5_WIDTH = 1024
S5_GROUP = 16
S5_GROUPS = S5_WIDTH // S5_GROUP
S5_STATE = 64
D_FF = 5504
N_MOD = 9
D_IN = RWKV_COLS + SSD_COLS + S5_WIDTH + 3 * D_MODEL

kernel_name = "hybrid_rwkv7_ssd_s5_diffusion_step"


def _split(x, sizes):
    return jnp.split(x, np.cumsum(sizes)[:-1].tolist(), axis=-1)


def _rmsnorm(x, g):
    xf = x.astype(jnp.float32)
    y = xf * lax.rsqrt(jnp.mean(xf * xf, axis=-1, keepdims=True) + EPS)
    return (y * g.astype(jnp.float32)).astype(x.dtype)


def _swiglu(h, w_in, w_out):
    gate, up = jnp.split(h @ w_in, 2, axis=-1)
    return (jax.nn.silu(gate) * up) @ w_out


def _centred_shift(x, grid):
    bsz, t, ch = x.shape
    if grid:
        rows = t // GRID_W
        pg = jnp.pad(x.reshape(bsz, rows, GRID_W, ch), ((0, 0), (1, 1), (1, 1), (0, 0)))
        nb = 0.25 * (pg[:, :-2, 1:-1] + pg[:, 2:, 1:-1] + pg[:, 1:-1, :-2] + pg[:, 1:-1, 2:])
        return nb.reshape(bsz, t, ch)
    ps = jnp.pad(x, ((0, 0), (1, 1), (0, 0)))
    return 0.5 * (ps[:, :-2] + ps[:, 2:])


def _depthwise_conv(x, w, b):
    k, ch = w.shape
    y = lax.conv_general_dilated(x, w[:, None, :].astype(x.dtype), window_strides=(1,),
                                 padding=[(k // 2, k // 2)], dimension_numbers=("NWC", "WIO", "NWC"),
                                 feature_group_count=ch)
    return y + b


def _rwkv7_scan(r, w, k, v, kk, a, s0, reverse):
    def step(s, inp):
        r_t, w_t, k_t, v_t, kk_t, a_t = inp
        s_kk = jnp.einsum("bhvk,bhk->bhv", s, kk_t)
        s = (s * w_t[:, :, None, :] - s_kk[..., None] * (kk_t * a_t)[:, :, None, :]
             + v_t[..., None] * k_t[:, :, None, :])
        return s, jnp.einsum("bhvk,bhk->bhv", s, r_t)
    xs = tuple(jnp.moveaxis(u, 1, 0) for u in (r, w, k, v, kk, a))
    s_fin, out = lax.scan(step, s0, xs, reverse=reverse)
    return jnp.moveaxis(out, 0, 1), s_fin


def _rwkv7_mixer(stream, grid, s0, p, l):
    bsz, t, _ = stream.shape
    f32 = jnp.float32
    xs = stream + p["rwkv_mu"][l] * (_centred_shift(stream, grid) - stream)
    r, k, v, wl, al, gl = _split(xs.astype(f32), [RWKV_WIDTH] * 3 + [RWKV_DECAY_RANK, RWKV_AICL_RANK, RWKV_GATE_RANK])

    def heads(u):
        return u.reshape(bsz, t, RWKV_HEADS, RWKV_HEAD)

    kk = heads(k * p["rwkv_k_k"][l])
    kk = kk * lax.rsqrt(jnp.sum(kk * kk, axis=-1, keepdims=True) + 1e-12)
    s0 = s0.astype(f32)
    outs, finals = [], []
    for d in range(N_DIR):
        w_log = -jax.nn.softplus(-(p["rwkv_w0"][l, d] + jnp.tanh(wl) @ p["rwkv_w2"][l, d])) - 0.5
        decay = jnp.exp(-jnp.exp(w_log))
        a_d = jax.nn.sigmoid(p["rwkv_a0"][l, d] + al @ p["rwkv_a2"][l, d])
        k_d = k * (1.0 + (a_d - 1.0) * p["rwkv_k_a"][l])
        o_d, s_d = _rwkv7_scan(heads(r), heads(decay), heads(k_d), heads(v), kk, heads(a_d), s0[:, d], d == 1)
        outs.append(o_d)
        finals.append(s_d)
    o = outs[0] + outs[1]
    mu = jnp.mean(o, axis=-1, keepdims=True)
    var = jnp.mean(jnp.square(o - mu), axis=-1, keepdims=True)
    o = ((o - mu) * lax.rsqrt(var + RWKV_LN_EPS)).reshape(bsz, t, RWKV_WIDTH) * p["rwkv_ln_g"][l] + p["rwkv_ln_b"][l]
    bonus = jnp.sum(heads(r) * heads(k) * p["rwkv_r_k"][l], axis=-1, keepdims=True) * heads(v)
    o = o + bonus.reshape(bsz, t, RWKV_WIDTH)
    g = jax.nn.sigmoid(gl) @ p["rwkv_g2"][l]
    return (o * g).astype(stream.dtype), jnp.stack(finals, axis=1)


def _ssd_chunked(x, dt, a, bm, cm, s0):
    bsz, t, h, pd = x.shape
    g, n = bm.shape[2], bm.shape[3]
    e = h // g
    nc, lc = t // SSD_CHUNK, SSD_CHUNK
    xc = (x * dt[..., None]).reshape(bsz, nc, lc, g, e, pd)
    da = jnp.moveaxis((dt * a).reshape(bsz, nc, lc, g, e), 2, -1)
    cum = jnp.cumsum(da, axis=-1)
    bc = bm.reshape(bsz, nc, lc, g, n)
    cc = cm.reshape(bsz, nc, lc, g, n)
    seg = cum[..., :, None] - cum[..., None, :]
    lower = jnp.tril(jnp.ones((lc, lc), dtype=bool))
    lmat = jnp.exp(jnp.where(lower, seg, -jnp.inf))
    y_diag = jnp.einsum("bclgn,bcsgn,bcgels,bcsgep->bclgep", cc, bc, lmat, xc)
    decay_states = jnp.exp(cum[..., -1:] - cum)
    states = jnp.einsum("bclgn,bcgel,bclgep->bcgepn", bc, decay_states, xc)
    chunk_decay = jnp.exp(cum[..., -1])

    def step(s, inp):
        st, dec = inp
        return s * dec[..., None, None] + st, s

    s_fin, s_in = lax.scan(step, s0.reshape(bsz, g, e, pd, n),
                           (jnp.moveaxis(states, 1, 0), jnp.moveaxis(chunk_decay, 1, 0)))
    s_in = jnp.moveaxis(s_in, 0, 1)
    y_off = jnp.einsum("bclgn,bcgel,bcgepn->bclgep", cc, jnp.exp(cum), s_in)
    return (y_diag + y_off).reshape(bsz, t, h, pd), s_fin.reshape(bsz, h, pd, n)


def _ssd_mixer(stream, s0, p, l):
    bsz, t, _ = stream.shape
    f32 = jnp.float32
    z, xbc, dt_raw = _split(stream, [SSD_WIDTH, SSD_XBC, SSD_HEADS])
    xbc = jax.nn.silu(_depthwise_conv(xbc, p["ssd_conv_w"][l], p["ssd_conv_b"][l])).astype(f32)
    xs, bm, cm = _split(xbc, [SSD_WIDTH, SSD_GROUPS * SSD_STATE, SSD_GROUPS * SSD_STATE])
    x = xs.reshape(bsz, t, SSD_HEADS, SSD_HEAD)
    bm = bm.reshape(bsz, t, SSD_GROUPS, SSD_STATE)
    cm = cm.reshape(bsz, t, SSD_GROUPS, SSD_STATE)
    s0 = s0.astype(f32)
    y = p["ssd_d"][l][:, None] * x
    finals = []
    for d in range(N_DIR):
        dt = jax.nn.softplus(dt_raw.astype(f32) + p["ssd_dt_bias"][l, d])
        a = -jnp.exp(p["ssd_a_log"][l, d].astype(f32))
        if d == 0:
            y_d, s_d = _ssd_chunked(x, dt, a, bm, cm, s0[:, d])
        else:
            y_d, s_d = _ssd_chunked(jnp.flip(x, 1), jnp.flip(dt, 1), a, jnp.flip(bm, 1), jnp.flip(cm, 1), s0[:, d])
            y_d = jnp.flip(y_d, 1)
        y = y + y_d
        finals.append(s_d)
    y = y.reshape(bsz, t, SSD_WIDTH) * jax.nn.silu(z.astype(f32))
    return _rmsnorm(y, p["ssd_norm_g"][l]).astype(stream.dtype), jnp.stack(finals, axis=1)


def _complex_affine_combine(e1, e2):
    a1r, a1i, b1r, b1i = e1
    a2r, a2i, b2r, b2i = e2
    return (a2r * a1r - a2i * a1i, a2r * a1i + a2i * a1r,
            a2r * b1r - a2i * b1i + b2r, a2r * b1i + a2i * b1r + b2i)


def _s5_mixer(u, s0_re, s0_im, p, l):
    bsz, t, _ = u.shape
    f32 = jnp.float32
    uf = u.astype(f32).reshape(bsz, t, S5_GROUPS, S5_GROUP)
    s0_re, s0_im = s0_re.astype(f32), s0_im.astype(f32)
    y = p["s5_d"][l].reshape(S5_GROUPS, S5_GROUP) * uf
    fin_re, fin_im = [], []
    for d in range(N_DIR):
        lam_re, lam_im = p["s5_lambda_re"][l, d], p["s5_lambda_im"][l, d]
        delta = jnp.exp(p["s5_log_dt"][l, d])[:, None]
        mag = jnp.exp(lam_re * delta)
        lb_re, lb_im = mag * jnp.cos(lam_im * delta), mag * jnp.sin(lam_im * delta)
        den = lam_re * lam_re + lam_im * lam_im
        q_re = ((lb_re - 1.0) * lam_re + lb_im * lam_im) / den
        q_im = (lb_im * lam_re - (lb_re - 1.0) * lam_im) / den
        b_re, b_im = p["s5_b_re"][l, d], p["s5_b_im"][l, d]
        bb_re = q_re[..., None] * b_re - q_im[..., None] * b_im
        bb_im = q_re[..., None] * b_im + q_im[..., None] * b_re
        bu_re = jnp.einsum("gpc,btgc->btgp", bb_re, uf)
        bu_im = jnp.einsum("gpc,btgc->btgp", bb_im, uf)
        first, last = (0, t - 1) if d == 0 else (t - 1, 0)
        s_re0, s_im0 = s0_re[:, d], s0_im[:, d]
        bu_re = bu_re.at[:, first].add(lb_re * s_re0 - lb_im * s_im0)
        bu_im = bu_im.at[:, first].add(lb_re * s_im0 + lb_im * s_re0)
        a_re = jnp.broadcast_to(lb_re[None, None], (1, t, S5_GROUPS, S5_STATE))
        a_im = jnp.broadcast_to(lb_im[None, None], (1, t, S5_GROUPS, S5_STATE))
        _, _, s_re, s_im = lax.associative_scan(_complex_affine_combine, (a_re, a_im, bu_re, bu_im),
                                                reverse=(d == 1), axis=1)
        y = y + (jnp.einsum("gcp,btgp->btgc", p["s5_c_re"][l, d], s_re)
                 - jnp.einsum("gcp,btgp->btgc", p["s5_c_im"][l, d], s_im))
        fin_re.append(s_re[:, last])
        fin_im.append(s_im[:, last])
    y = jax.nn.gelu(y.reshape(bsz, t, S5_WIDTH))
    return y.astype(u.dtype), jnp.stack(fin_re, axis=1), jnp.stack(fin_im, axis=1)


def _mixing(h, grid, s_rwkv, s_ssd, s_re, s_im, p, l):
    z = h @ p["w_in"][l]
    z_a, z_b, z_c, z_g = _split(z, [RWKV_COLS, SSD_COLS, S5_WIDTH, 3 * D_MODEL])
    y_a, st_a = _rwkv7_mixer(z_a, grid, s_rwkv, p, l)
    y_b, st_b = _ssd_mixer(z_b, s_ssd, p, l)
    y_c, st_re, st_im = _s5_mixer(z_c, s_re, s_im, p, l)
    g_a, g_b, g_c = jnp.split(jax.nn.sigmoid(z_g), 3, axis=-1)
    glu_val, glu_gate = jnp.split(y_c @ p["w_proj_c"][l], 2, axis=-1)
    merged = (g_a * (y_a @ p["w_proj_a"][l]) + g_b * (y_b @ p["w_proj_b"][l])
              + g_c * (glu_val * jax.nn.sigmoid(glu_gate)))
    return merged @ p["w_out"][l], st_a, st_b, st_re, st_im


def _trunk(x, cond, grid, st_rwkv, st_ssd, st_re, st_im, p):
    new_a, new_b, new_re, new_im = [], [], [], []
    for l in range(DEPTH):
        mod = (jax.nn.silu(cond) @ p["w_mod"][l] + p["b_mod"][l])[:, None, :]
        sh1, sc1, g1, sh2, sc2, g2, sh3, sc3, g3 = jnp.split(mod, N_MOD, axis=-1)
        h = _rmsnorm(x, p["norm_g"][l, 0]) * (1.0 + sc1) + sh1
        x = x + 0.5 * g1 * _swiglu(h, p["ffn_w_in"][l, 0], p["ffn_w_out"][l, 0])
        h = _rmsnorm(x, p["norm_g"][l, 1]) * (1.0 + sc2) + sh2
        m, sa, sb, sre, sim = _mixing(h, grid, st_rwkv[:, l], st_ssd[:, l], st_re[:, l], st_im[:, l], p, l)
        x = x + g2 * m
        h = _rmsnorm(x, p["norm_g"][l, 2]) * (1.0 + sc3) + sh3
        x = x + 0.5 * g3 * _swiglu(h, p["ffn_w_in"][l, 1], p["ffn_w_out"][l, 1])
        new_a.append(sa)
        new_b.append(sb)
        new_re.append(sre)
        new_im.append(sim)
    y = _rmsnorm(x, p["final_norm_g"])
    return y, jnp.stack(new_a, axis=1), jnp.stack(new_b, axis=1), jnp.stack(new_re, axis=1), jnp.stack(new_im, axis=1)


def setup_inputs(seed: int = 0) -> dict:
    key = jax.random.key(seed)
    ks = iter(jax.random.split(key, 64))

    def nrm(shape, scale):
        return scale * jax.random.normal(next(ks), shape, jnp.float32)

    def uni(shape, lo, hi):
        return jax.random.uniform(next(ks), shape, jnp.float32, lo, hi)

    ld = (DEPTH, N_DIR)
    dt_ssd = jnp.exp(uni(ld + (SSD_HEADS,), math.log(1e-3), math.log(1e-1)))
    lam_shape = ld + (S5_GROUPS, S5_STATE)
    return {
        "x_prompt": nrm((BATCH, SEQ, D_MODEL), 1.0),
        "x_sample": nrm((DEC_BATCH, DEC_SEQ, D_MODEL), 1.0),
        "state_rwkv": nrm((DEC_BATCH, DEPTH, N_DIR, RWKV_HEADS, RWKV_HEAD, RWKV_HEAD), 0.3),
        "state_ssd": nrm((DEC_BATCH, DEPTH, N_DIR, SSD_HEADS, SSD_HEAD, SSD_STATE), 0.1),
        "state_s5_re": nrm((DEC_BATCH, DEPTH, N_DIR, S5_GROUPS, S5_STATE), 0.3),
        "state_s5_im": nrm((DEC_BATCH, DEPTH, N_DIR, S5_GROUPS, S5_STATE), 0.3),
        "c": nrm((DEC_BATCH, D_MODEL), 1.0),
        "c_ctx": nrm((D_MODEL,), 1.0),
        "w_mod": nrm((DEPTH, D_MODEL, N_MOD * D_MODEL), 0.5 * D_MODEL ** -0.5),
        "b_mod": nrm((DEPTH, N_MOD * D_MODEL), 0.01),
        "norm_g": 1.0 + nrm((DEPTH, 3, D_MODEL), 0.02),
        "ffn_w_in": nrm((DEPTH, 2, D_MODEL, 2 * D_FF), D_MODEL ** -0.5),
        "ffn_w_out": nrm((DEPTH, 2, D_FF, D_MODEL), D_FF ** -0.5),
        "w_in": nrm((DEPTH, D_MODEL, D_IN), D_MODEL ** -0.5),
        "rwkv_mu": uni((DEPTH, RWKV_COLS), 0.0, 1.0),
        "rwkv_w0": uni(ld + (RWKV_WIDTH,), -6.0, -1.0),
        "rwkv_w2": nrm(ld + (RWKV_DECAY_RANK, RWKV_WIDTH), 0.1 * RWKV_DECAY_RANK ** -0.5),
        "rwkv_a0": nrm(ld + (RWKV_WIDTH,), 0.1),
        "rwkv_a2": nrm(ld + (RWKV_AICL_RANK, RWKV_WIDTH), 0.5 * RWKV_AICL_RANK ** -0.5),
        "rwkv_g2": nrm((DEPTH, RWKV_GATE_RANK, RWKV_WIDTH), RWKV_GATE_RANK ** -0.5),
        "rwkv_k_k": 0.85 + nrm((DEPTH, RWKV_WIDTH), 0.02),
        "rwkv_k_a": 1.0 + nrm((DEPTH, RWKV_WIDTH), 0.02),
        "rwkv_r_k": nrm((DEPTH, RWKV_HEADS, RWKV_HEAD), 0.1),
        "rwkv_ln_g": 1.0 + nrm((DEPTH, RWKV_WIDTH), 0.02),
        "rwkv_ln_b": nrm((DEPTH, RWKV_WIDTH), 0.01),
        "w_proj_a": nrm((DEPTH, RWKV_WIDTH, D_MODEL), RWKV_WIDTH ** -0.5),
        "ssd_conv_w": nrm((DEPTH, SSD_CONV, SSD_XBC), SSD_CONV ** -0.5),
        "ssd_conv_b": nrm((DEPTH, SSD_XBC), 0.01),
        "ssd_dt_bias": dt_ssd + jnp.log(-jnp.expm1(-dt_ssd)),
        "ssd_a_log": jnp.log(uni(ld + (SSD_HEADS,), 1.0, 16.0)),
        "ssd_d": 1.0 + nrm((DEPTH, SSD_HEADS), 0.1),
        "ssd_norm_g": 1.0 + nrm((DEPTH, SSD_WIDTH), 0.02),
        "w_proj_b": nrm((DEPTH, SSD_WIDTH, D_MODEL), SSD_WIDTH ** -0.5),
        "s5_lambda_re": -0.5 + nrm(lam_shape, 0.01),
        "s5_lambda_im": jnp.pi * jnp.arange(S5_STATE, dtype=jnp.float32) + nrm(lam_shape, 0.01),
        "s5_log_dt": uni(ld + (S5_GROUPS,), math.log(1e-3), math.log(1e-1)),
        "s5_b_re": nrm(ld + (S5_GROUPS, S5_STATE, S5_GROUP), (2 * S5_GROUP) ** -0.5),
        "s5_b_im": nrm(ld + (S5_GROUPS, S5_STATE, S5_GROUP), (2 * S5_GROUP) ** -0.5),
        "s5_c_re": nrm(ld + (S5_GROUPS, S5_GROUP, S5_STATE), (2 * S5_STATE) ** -0.5),
        "s5_c_im": nrm(ld + (S5_GROUPS, S5_GROUP, S5_STATE), (2 * S5_STATE) ** -0.5),
        "s5_d": nrm((DEPTH, S5_WIDTH), 1.0),
        "w_proj_c": nrm((DEPTH, S5_WIDTH, 2 * D_MODEL), S5_WIDTH ** -0.5),
        "w_out": nrm((DEPTH, D_MODEL, D_MODEL), D_MODEL ** -0.5),
        "final_norm_g": 1.0 + nrm((D_MODEL,), 0.02),
    }


def reference(x_prompt, x_sample, state_rwkv, state_ssd, state_s5_re, state_s5_im, c,
              c_ctx, w_mod, b_mod, norm_g, ffn_w_in, ffn_w_out, w_in,
              rwkv_mu, rwkv_w0, rwkv_w2, rwkv_a0, rwkv_a2, rwkv_g2, rwkv_k_k, rwkv_k_a, rwkv_r_k,
              rwkv_ln_g, rwkv_ln_b, w_proj_a,
              ssd_conv_w, ssd_conv_b, ssd_dt_bias, ssd_a_log, ssd_d, ssd_norm_g, w_proj_b,
              s5_lambda_re, s5_lambda_im, s5_log_dt, s5_b_re, s5_b_im, s5_c_re, s5_c_im, s5_d, w_proj_c,
              w_out, final_norm_g):
    p = {
        "w_mod": w_mod, "b_mod": b_mod, "norm_g": norm_g, "ffn_w_in": ffn_w_in, "ffn_w_out": ffn_w_out,
        "w_in": w_in, "rwkv_mu": rwkv_mu, "rwkv_w0": rwkv_w0, "rwkv_w2": rwkv_w2, "rwkv_a0": rwkv_a0,
        "rwkv_a2": rwkv_a2, "rwkv_g2": rwkv_g2, "rwkv_k_k": rwkv_k_k, "rwkv_k_a": rwkv_k_a,
        "rwkv_r_k": rwkv_r_k, "rwkv_ln_g": rwkv_ln_g, "rwkv_ln_b": rwkv_ln_b, "w_proj_a": w_proj_a,
        "ssd_conv_w": ssd_conv_w, "ssd_conv_b": ssd_conv_b, "ssd_dt_bias": ssd_dt_bias,
        "ssd_a_log": ssd_a_log, "ssd_d": ssd_d, "ssd_norm_g": ssd_norm_g, "w_proj_b": w_proj_b,
        "s5_lambda_re": s5_lambda_re, "s5_lambda_im": s5_lambda_im, "s5_log_dt": s5_log_dt,
        "s5_b_re": s5_b_re, "s5_b_im": s5_b_im, "s5_c_re": s5_c_re, "s5_c_im": s5_c_im, "s5_d": s5_d,
        "w_proj_c": w_proj_c, "w_out": w_out, "final_norm_g": final_norm_g,
    }
    bp = x_prompt.shape[0]
    f32 = jnp.float32
    y_prompt, new_rwkv, new_ssd, new_re, new_im = _trunk(
        x_prompt, c_ctx[None, :], False,
        jnp.zeros((bp, DEPTH, N_DIR, RWKV_HEADS, RWKV_HEAD, RWKV_HEAD), f32),
        jnp.zeros((bp, DEPTH, N_DIR, SSD_HEADS, SSD_HEAD, SSD_STATE), f32),
        jnp.zeros((bp, DEPTH, N_DIR, S5_GROUPS, S5_STATE), f32),
        jnp.zeros((bp, DEPTH, N_DIR, S5_GROUPS, S5_STATE), f32), p)
    y_sample, _, _, _, _ = _trunk(x_sample, c, True, state_rwkv, state_ssd, state_s5_re, state_s5_im, p)
    return (y_prompt, y_sample, new_rwkv, new_ssd, new_re, new_im)
```

```cpp
#ifndef CPU_EMU
#include <hip/hip_runtime.h>
#endif
#include <cstdio>
#include <cstdint>
#include <cmath>

#ifdef CFG_SMALL
constexpr int D = 512, BATCH = 2, SEQ = 128, DEC_BATCH = 2, DEC_SEQ = 256, RW = 256, SW = 256, CW = 256, FF = 384;
#else
constexpr int D = 2048, BATCH = 32, SEQ = 256, DEC_BATCH = 4, DEC_SEQ = 2048, RW = 1024, SW = 1024, CW = 1024, FF = 5504;
#endif
constexpr int DEPTH = 2, GRID_W = 64, NMOD = 9;
#ifndef REP_S5
#define REP_S5 1
#endif
#ifndef REP_RS
#define REP_RS 1
#endif
#ifndef REP_CONV
#define REP_CONV 1
#endif
#ifndef REP_ELT
#define REP_ELT 1
#endif
constexpr int RH = RW / 64, RCOLS = 3 * RW + 256;
constexpr int SH = SW / 64, SG = 2, SN = 128, SXBC = SW + 2 * SG * SN, SCOLS = SW + SXBC + SH, SHG = SH / SG;
constexpr int CG = CW / 16, CP = 64;
constexpr int DIN = RCOLS + SCOLS + CW + 3 * D;
constexpr int MC = BATCH * SEQ, ML = DEC_BATCH * DEC_SEQ, M = MC + ML, NCOND = 1 + DEC_BATCH;
constexpr int ZB_LD = ((SCOLS + 255) / 256) * 256;
constexpr int NZ_MIX = RCOLS + ZB_LD + CW, NZ = NZ_MIX + 3 * D;
constexpr int LRN = 5 * RW;
constexpr float EPS = 1e-6f, RWKV_LN_EPS = 64e-5f;
constexpr int S5L = 32, S5K = S5L * 16, S5N1 = S5K + 256, MCH = ((M / S5L + 255) / 256) * 256, S5MT = MCH / 256, S5NT1 = S5N1 / 256, S5NT2 = S5K / 256;
static_assert(S5K % 256 == 0 && SEQ % S5L == 0 && DEC_SEQ % S5L == 0 && M % S5L == 0, "s5 chunking");
static_assert(RCOLS % 256 == 0 && CW % 256 == 0 && D % 256 == 0 && FF % 128 == 0 && MC % 256 == 0 && ML % 256 == 0 && DEC_SEQ % 256 == 0 && LRN % 256 == 0, "tile shapes");
static_assert(RW % 256 == 0 && SW % 256 == 0 && DEC_SEQ % GRID_W == 0 && SHG >= 1, "shapes");

enum In { I_XP = 0, I_XS, I_SRWKV, I_SSSD, I_SRE, I_SIM, I_C, I_CCTX, I_WMOD, I_BMOD, I_NORMG, I_FWIN, I_FWOUT, I_WIN, I_RMU, I_RW0, I_RW2, I_RA0, I_RA2, I_RG2,
          I_RKK, I_RKA, I_RRK, I_RLNG, I_RLNB, I_PA, I_SCW, I_SCB, I_SDTB, I_SALOG, I_SD, I_SNG, I_PB, I_CLRE, I_CLIM, I_CLDT, I_CBRE, I_CBIM, I_CCRE, I_CCIM, I_CD, I_PC, I_WOUT, I_FNG, N_IN };
static_assert(N_IN == 44, "44 inputs");

constexpr size_t OUT_Y = 0;
constexpr size_t OUT_RWKV = (size_t)M * D;
constexpr size_t OUT_SSD = OUT_RWKV + (size_t)BATCH * DEPTH * 2 * RH * 64 * 64;
constexpr size_t OUT_RE = OUT_SSD + (size_t)BATCH * DEPTH * 2 * SH * 64 * SN;
constexpr size_t OUT_IM = OUT_RE + (size_t)BATCH * DEPTH * 2 * CG * CP;
constexpr size_t OUT_END = OUT_IM + (size_t)BATCH * DEPTH * 2 * CG * CP;

constexpr size_t al256(size_t x) { return (x + 255) & ~(size_t)255; }
constexpr size_t WS_CTL = 0, CTL_BYTES = 1u << 20;
constexpr size_t WS_MOD = WS_CTL + CTL_BYTES;
constexpr size_t WS_X = al256(WS_MOD + (size_t)DEPTH * NCOND * NMOD * D * 4);
constexpr size_t WS_H = al256(WS_X + (size_t)M * D * 2);
constexpr size_t WS_FIT = al256(WS_H + (size_t)M * D * 2);
constexpr size_t WS_FOT = al256(WS_FIT + (size_t)2 * 2 * FF * D * 2);
constexpr size_t WS_WIT = al256(WS_FOT + (size_t)2 * D * FF * 2);
constexpr size_t WS_PAT = al256(WS_WIT + (size_t)NZ * D * 2);
constexpr size_t WS_PBT = al256(WS_PAT + (size_t)D * RW * 2);
constexpr size_t WS_PCT = al256(WS_PBT + (size_t)D * SW * 2);
constexpr size_t WS_WOT = al256(WS_PCT + (size_t)2 * D * CW * 2);
constexpr size_t WS_LRT = al256(WS_WOT + (size_t)D * D * 2);
constexpr size_t WS_ZA = al256(WS_LRT + (size_t)LRN * 256 * 2);
constexpr size_t WS_ZB = al256(WS_ZA + (size_t)M * RCOLS * 2);
constexpr size_t WS_UG = al256(WS_ZB + (size_t)M * ZB_LD * 2);
constexpr size_t WS_XS = al256(WS_UG + (size_t)CG * MCH * S5K * 2);
constexpr size_t WS_KK = WS_XS + (size_t)M * 3 * RW * 2;
constexpr size_t WS_LRI = al256(WS_KK + (size_t)M * RW * 2);
constexpr size_t WS_XBC = al256(WS_LRI + (size_t)M * 256 * 2);
constexpr size_t WS_DT = al256(WS_XBC + (size_t)M * SXBC * 2);
constexpr size_t WS_OMD = al256(WS_DT + (size_t)2 * M * SH * 4);
constexpr size_t WS_KD = WS_OMD + (size_t)2 * M * RW * 2;
constexpr size_t WS_BB = WS_KD + (size_t)2 * M * RW * 2;
constexpr size_t WS_GG = al256(WS_BB + (size_t)2 * M * RW * 2);
constexpr size_t WS_O = al256(WS_GG + (size_t)M * RW * 2);
constexpr size_t WS_YSSD = al256(WS_O + (size_t)2 * M * RW * 2);
constexpr size_t S5W_L = (size_t)CG * S5N1 * S5K * 2, S5F_L = (size_t)CG * S5K * 256 * 2;
constexpr size_t WS_S5W = al256(WS_YSSD + (size_t)2 * M * SW * 2);
constexpr size_t WS_S5F = al256(WS_S5W + DEPTH * S5W_L);
constexpr size_t WS_YL = al256(WS_S5F + DEPTH * S5F_L);
constexpr size_t WS_SE = al256(WS_YL + (size_t)CG * MCH * S5K * 2);
constexpr size_t WS_SIN = al256(WS_SE + (size_t)CG * MCH * 256 * 4);
constexpr size_t WS_END = al256(WS_SIN + (size_t)CG * MCH * 256 * 2);
constexpr size_t WS_ACT = WS_ZA;
constexpr size_t WS_YA = WS_ZA, WS_YB = WS_YA + (size_t)M * RW * 2, WS_YC = WS_YB + (size_t)M * SW * 2;
constexpr size_t WS_MRG = WS_XS, WS_MRGB = WS_H, WS_ZG = WS_OMD;
constexpr size_t WS_H3 = WS_MRG;
static_assert((size_t)M * FF * 2 <= WS_UG - WS_ZA, "ACT overlay");
static_assert((size_t)M * (RW + SW + CW) * 2 <= WS_ZB - WS_ZA || RW + SW + CW <= RCOLS, "Y overlay");
static_assert((size_t)M * D * 4 <= WS_LRI - WS_XS, "MRG overlay");
static_assert((size_t)M * 3 * D * 2 <= WS_GG - WS_OMD, "ZG overlay");
static_assert(WS_KK % 16 == 0 && WS_KD % 16 == 0 && WS_BB % 16 == 0 && WS_YB % 16 == 0 && WS_YC % 16 == 0, "alignment");
#ifndef CFG_SMALL
static_assert(WS_END <= 1442840576ull, "workspace budget (4 x largest input)");
#endif

#ifdef CPU_EMU
#define GAS
#define LAS
#define CAS
#define DEV inline
#define VM_WAIT() do {} while (0)
#define LDS_WAIT() do {} while (0)
#define CFENCE() do {} while (0)
static inline float __uint_as_float(unsigned u) { float f; memcpy(&f, &u, 4); return f; }
static inline unsigned __float_as_uint(float f) { unsigned u; memcpy(&u, &f, 4); return u; }
#define RFL(x) (x)
#define WAVE_SYNC() emu::wave_barrier()
#else
#define GAS __attribute__((address_space(1)))
#define LAS __attribute__((address_space(3)))
#define CAS __attribute__((address_space(4)))
#define DEV __device__ __forceinline__
#define VM_WAIT() asm volatile("s_waitcnt vmcnt(0)" ::: "memory")
#define LDS_WAIT() asm volatile("s_waitcnt lgkmcnt(0)" ::: "memory")
#define CFENCE() asm volatile("" ::: "memory")
#define RFL(x) __builtin_amdgcn_readfirstlane(x)
#define WAVE_SYNC() __builtin_amdgcn_wave_barrier()
#endif
typedef unsigned short bf16_t;
typedef float f32x4 __attribute__((ext_vector_type(4)));
typedef float f32x2 __attribute__((ext_vector_type(2)));
typedef unsigned u32x4 __attribute__((ext_vector_type(4)));
typedef unsigned u32x2 __attribute__((ext_vector_type(2)));
typedef short bf16x8 __attribute__((ext_vector_type(8)));
constexpr int NWAVES = 8, NTHREADS = 512, LDS_MAIN_BYTES = 131072;

#ifdef CPU_EMU
DEV unsigned f2bf(float f) { unsigned u = __float_as_uint(f); return (u + 0x7fffu + ((u >> 16) & 1u)) >> 16; }
DEV unsigned pk2(float lo, float hi) { return f2bf(lo) | (f2bf(hi) << 16); }
#else
typedef __bf16 hwbf16x2 __attribute__((ext_vector_type(2)));
typedef float hwf32x2 __attribute__((ext_vector_type(2)));
DEV unsigned pk2(float lo, float hi) { const hwbf16x2 v = __builtin_convertvector((hwf32x2){lo, hi}, hwbf16x2); return __builtin_bit_cast(unsigned, v); }
DEV unsigned f2bf(float f) { return (unsigned)__builtin_bit_cast(unsigned short, (__bf16)f); }
#endif
DEV float bflo(unsigned w) { return __uint_as_float(w << 16); }
DEV float bfhi(unsigned w) { return __uint_as_float(w & 0xffff0000u); }
DEV float bf1(bf16_t h) { return __uint_as_float(((unsigned)h) << 16); }
DEV void unpack8(const u32x4 v, float (&f)[8]) { f[0] = bflo(v.x); f[1] = bfhi(v.x); f[2] = bflo(v.y); f[3] = bfhi(v.y); f[4] = bflo(v.z); f[5] = bfhi(v.z); f[6] = bflo(v.w); f[7] = bfhi(v.w); }
DEV u32x4 pack8(const float (&f)[8]) { u32x4 o; o.x = pk2(f[0], f[1]); o.y = pk2(f[2], f[3]); o.z = pk2(f[4], f[5]); o.w = pk2(f[6], f[7]); return o; }
DEV u32x4 ld8(const bf16_t* p) { return *(const u32x4*)p; }
DEV void st8(bf16_t* p, const u32x4 v) { *(u32x4*)p = v; }
#ifdef CPU_EMU
DEV float frcp_(float x) { return 1.0f / x; }
#else
DEV float frcp_(float x) { return __builtin_amdgcn_rcpf(x); }
#endif
DEV float sigmoidf_(float x) { return frcp_(1.0f + __expf(-x)); }
DEV float siluf_(float x) { return x * sigmoidf_(x); }
DEV float softplusf_(float x) { return x > 20.f ? x : log1pf(expf(x)); }
DEV float geluf_(float x) { const float u = 0.7978845608028654f * (x + 0.044715f * x * x * x); return x * sigmoidf_(2.0f * u); }
DEV float wave_sum(float v) {
#pragma unroll
    for (int o = 1; o < 64; o <<= 1) v += __shfl_xor(v, o);
    return v;
}
#ifdef CPU_EMU
template <int MASK> DEV float xor_dpp(float v) { return __shfl_xor(v, MASK); }
DEV float red8(float v) { v += __shfl_xor(v, 1); v += __shfl_xor(v, 2); v += __shfl_xor(v, 4); return v; }
#else
template <int CTRL, int BANK> DEV float dpp_mov(float old, float v) {
    if constexpr (BANK == 0xF) return __builtin_bit_cast(float, __builtin_amdgcn_update_dpp(0, __builtin_bit_cast(int, v), CTRL, 0xF, 0xF, true));
    else return __builtin_bit_cast(float, __builtin_amdgcn_update_dpp(__builtin_bit_cast(int, old), __builtin_bit_cast(int, v), CTRL, 0xF, BANK, false)); }
template <int MASK> DEV float xor_dpp(float v) {
    if constexpr (MASK == 1) return dpp_mov<0xB1, 0xF>(v, v);
    else if constexpr (MASK == 2) return dpp_mov<0x4E, 0xF>(v, v);
    else if constexpr (MASK == 4) { float t = dpp_mov<0x104, 0x5>(v, v); return dpp_mov<0x114, 0xA>(t, v); }
    else { static_assert(MASK == 8, "xor_dpp mask"); return dpp_mov<0x128, 0xF>(v, v); }
}
DEV float red8(float v) { v += xor_dpp<1>(v); v += xor_dpp<2>(v); v += dpp_mov<0x141, 0xF>(v, v); return v; }
#endif
DEV int cond_of_row(int row) { return row < MC ? 0 : 1 + (row - MC) / DEC_SEQ; }

namespace pg8 {
#define PG8_LAS LAS
constexpr int BM = 256, BK = 64, HALF = 128, HTB = HALF * BK * 2, STAGE_BYTES = 8 * HTB, NXCD = 8, WGM = 8;
DEV int lds_byte(int r, int c) { const int st = (r >> 4) * 2 + (c >> 5), rr = r & 15, cc = c & 31, ob = rr * 64 + cc * 2; return st * 1024 + (ob ^ (((ob >> 9) & 1) << 5)); }
DEV void stage_rc(int b, int& R, int& C) { const int st = b / 1024, sb = b % 1024, swz = sb ^ (((sb >> 9) & 1) << 5); R = (st >> 1) * 16 + swz / 64; C = (st & 1) * 32 + (swz % 64) / 2; }
DEV int perm32(int rho) { const int n = rho >> 4, i = rho & 15; return 8 * (i >> 2) + 4 * n + (i & 3); }
struct Unit { int pm, pn; };
struct Gemm { const bf16_t* A; const bf16_t* Bt; int M, N, K; };
struct StaticOrder {
    int nM, nN, nwg, G, c;
    DEV void init(int M_, int N_, int G_, int c_) { nM = M_ / BM; nN = N_ / BM; nwg = nM * nN; G = G_; c = c_; }
    DEV bool next(int i, Unit& u) const {
        const long L = (long)i * G + c; if (L >= nwg) return false;
        int wgid = (int)L; { const int q = nwg / NXCD, r = nwg % NXCD, xcd = wgid % NXCD, off = wgid / NXCD; wgid = (xcd < r ? xcd * (q + 1) : r * (q + 1) + (xcd - r) * q) + off; }
        const int nig = WGM * nN, gid = wgid / nig, fm = gid * WGM, gsz = (nM - fm) < WGM ? (nM - fm) : WGM;
        u.pm = fm + ((wgid % nig) % gsz); u.pn = (wgid % nig) / gsz; return true;
    }
    DEV void a_ready(const Unit&) const {}
    DEV void done(const Unit&) const {}
};
#ifdef CPU_EMU
template <class Epi, class Sched, bool ALIGN_EPI = false, bool SP2 = false>
inline void gemm_phase(unsigned char* lds, const int tid, const Gemm g, const Sched& S, const Epi& E) {
    const int wid = tid >> 6, lane = tid & 63, wr = wid >> 2, wc = wid & 3, fr = lane & 15, fq = lane >> 4;
    Unit u;
    for (int i = 0; S.next(i, u); ++i) {
        f32x4 acc[2][2][4][2];
        for (int ai = 0; ai < 2; ++ai) for (int bj = 0; bj < 2; ++bj) for (int m = 0; m < 4; ++m) for (int n = 0; n < 2; ++n) for (int j = 0; j < 4; ++j) {
            const int row = 256 * u.pm + 128 * ai + 64 * wr + 16 * m + fr;
            const int col = 256 * u.pn + 128 * bj + 32 * wc + (Epi::PERM ? (8 * fq + 4 * n + j) : (16 * n + 4 * fq + j));
            const bf16_t* a = g.A + (size_t)row * g.K; const bf16_t* b = g.Bt + (size_t)col * g.K; float s = 0.f;
            for (int k = 0; k < g.K; ++k) s += bf1(a[k]) * bf1(b[k]);
            acc[ai][bj][m][n][j] = s;
        }
        E(acc, u, wr, wc, fr, fq);
    }
}
#else
template <class Epi, class Sched, bool ALIGN_EPI = false, bool SP2 = false>
__device__ __forceinline__ void gemm_phase(PG8_LAS unsigned char* lds, const int tid, const Gemm g, const Sched& S, const Epi& E) {
    const int wid = __builtin_amdgcn_readfirstlane(tid >> 6), lane = tid & 63, wr = wid >> 2, wc = wid & 3, fr = lane & 15, fq = lane >> 4;
    const int K = g.K, nt = K / BK;
    unsigned voffA[2], voffB[2];
#pragma unroll
    for (int i = 0; i < 2; ++i) { int R, C; stage_rc(tid * 16 + i * 8192, R, C); const int Rb = Epi::PERM ? ((R & ~31) + perm32(R & 31)) : R;
        voffA[i] = (unsigned)(R * K + C) * 2u; voffB[i] = (unsigned)(Rb * K + C) * 2u; }
    const size_t kstep = (size_t)(BK * 2);
    const size_t hstep = (size_t)HALF * K * 2;
    const size_t tstep = 2 * hstep;
    const unsigned ldsw = (unsigned)wid * 1024u;
    const int aoff = lds_byte(wr * 64 + fr, fq * 8), boff = lds_byte(wc * 32 + fr, fq * 8);
#define PG8_SA(b, h) (((b) * 2 + (h)) * HTB)
#define PG8_SB(b, h) ((4 + (b) * 2 + (h)) * HTB)
#define PG8_STAGE(bufoff, gbase, voff) do { _Pragma("unroll") for (int _i = 0; _i < 2; ++_i) \
        __builtin_amdgcn_global_load_lds((const unsigned*)((const char*)(gbase) + (voff)[_i]), (PG8_LAS unsigned*)(lds + (bufoff) + ldsw + _i * 8192), 16, 0, 0); } while (0)
#define PG8_LDA(dst, b, h) do { _Pragma("unroll") for (int m = 0; m < 4; ++m) _Pragma("unroll") for (int k = 0; k < 2; ++k) dst[m][k] = *(const PG8_LAS bf16x8*)(lds + PG8_SA(b, h) + aoff + m * 2048 + k * 1024); } while (0)
#define PG8_LDB(dst, b, h) do { _Pragma("unroll") for (int n = 0; n < 2; ++n) _Pragma("unroll") for (int k = 0; k < 2; ++k) dst[n][k] = *(const PG8_LAS bf16x8*)(lds + PG8_SB(b, h) + boff + n * 2048 + k * 1024); } while (0)
#define PG8_MMA(ai, bj, At, Bt) do { __builtin_amdgcn_s_setprio(1); _Pragma("unroll") for (int m = 0; m < 4; ++m) _Pragma("unroll") for (int n = 0; n < 2; ++n) _Pragma("unroll") for (int k = 0; k < 2; ++k) \
        acc[ai][bj][m][n] = __builtin_amdgcn_mfma_f32_16x16x32_bf16(Bt[n][k], At[m][k], acc[ai][bj][m][n], 0, 0, 0); __builtin_amdgcn_s_setprio(0); } while (0)
#define PG8_WAIT_V(n) asm volatile("s_waitcnt vmcnt(" #n ")" ::: "memory")
#define PG8_WAIT_L(n) asm volatile("s_waitcnt lgkmcnt(" #n ")" ::: "memory")
#define PG8_BAR __builtin_amdgcn_s_barrier()
#define PG8_SCHED __builtin_amdgcn_sched_barrier(0)
    Unit cur, nxt; int ui = 0;
    if (!S.next(0, cur)) return;
    f32x4 acc[2][2][4][2];
#pragma unroll
    for (int a = 0; a < 2; ++a)
#pragma unroll
        for (int b = 0; b < 2; ++b)
#pragma unroll
            for (int m = 0; m < 4; ++m)
#pragma unroll
                for (int n = 0; n < 2; ++n) acc[a][b][m][n] = (f32x4){0.f, 0.f, 0.f, 0.f};
    bf16x8 At[4][2], B0[2][2], B1[2][2];
    const char* cA = (const char*)g.A + (size_t)cur.pm * tstep; const char* cB = (const char*)g.Bt + (size_t)cur.pn * tstep;
    S.a_ready(cur);
    if constexpr (SP2) {
        PG8_STAGE(PG8_SB(0, 0), cB, voffB); PG8_STAGE(PG8_SB(0, 1), cB + hstep, voffB); PG8_STAGE(PG8_SA(0, 0), cA, voffA); PG8_STAGE(PG8_SA(0, 1), cA + hstep, voffA);
        if (wr == 1) PG8_BAR;
        PG8_WAIT_V(2); PG8_BAR;
        PG8_STAGE(PG8_SB(1, 0), cB + kstep, voffB); PG8_STAGE(PG8_SA(1, 0), cA + kstep, voffA); PG8_STAGE(PG8_SB(1, 1), cB + hstep + kstep, voffB);
        PG8_WAIT_V(6); PG8_BAR;
    } else {
        PG8_STAGE(PG8_SB(0, 0), cB, voffB); PG8_STAGE(PG8_SA(0, 0), cA, voffA); PG8_STAGE(PG8_SB(0, 1), cB + hstep, voffB); PG8_STAGE(PG8_SA(0, 1), cA + hstep, voffA);
        if (wr == 1) PG8_BAR;
        PG8_WAIT_V(4); PG8_BAR;
        PG8_STAGE(PG8_SB(1, 0), cB + kstep, voffB); PG8_STAGE(PG8_SA(1, 0), cA + kstep, voffA); PG8_STAGE(PG8_SB(1, 1), cB + hstep + kstep, voffB);
        PG8_WAIT_V(6); PG8_BAR;
    }
    for (;;) {
        const bool has_next = S.next(ui + 1, nxt);
        const char* nA = has_next ? (const char*)g.A + (size_t)nxt.pm * tstep : cA; const char* nB = has_next ? (const char*)g.Bt + (size_t)nxt.pn * tstep : cB;
        for (int t = 0; t < nt; t += 2) {
            const bool last = (t == nt - 2);
            const char* a1 = cA + (size_t)(t + 1) * kstep;
            const char* a2 = last ? nA : cA + (size_t)(t + 2) * kstep; const char* b2 = last ? nB : cB + (size_t)(t + 2) * kstep;
            const char* a3 = a2 + kstep; const char* b3 = b2 + kstep;
            if (last && has_next) S.a_ready(nxt);
            if constexpr (SP2) {
            PG8_LDB(B0, 0, 0); PG8_LDB(B1, 0, 1); PG8_SCHED; PG8_LDA(At, 0, 0); PG8_STAGE(PG8_SA(1, 1), a1 + hstep, voffA);
            PG8_WAIT_V(8); PG8_WAIT_L(0); PG8_BAR; PG8_MMA(0, 0, At, B0); PG8_MMA(0, 1, At, B1); PG8_BAR; PG8_SCHED;
            PG8_LDA(At, 0, 1); PG8_STAGE(PG8_SB(0, 0), b2, voffB); PG8_STAGE(PG8_SB(0, 1), b2 + hstep, voffB); PG8_STAGE(PG8_SA(0, 0), a2, voffA);
            PG8_WAIT_V(8); PG8_WAIT_L(0); PG8_BAR; PG8_MMA(1, 0, At, B0); PG8_MMA(1, 1, At, B1); PG8_BAR; PG8_SCHED;
            PG8_LDB(B0, 1, 0); PG8_LDB(B1, 1, 1); PG8_SCHED; PG8_LDA(At, 1, 0); PG8_STAGE(PG8_SA(0, 1), a2 + hstep, voffA);
            PG8_WAIT_V(8); PG8_WAIT_L(0); PG8_BAR; PG8_MMA(0, 0, At, B0); PG8_MMA(0, 1, At, B1); PG8_BAR; PG8_SCHED;
            PG8_LDA(At, 1, 1); PG8_STAGE(PG8_SB(1, 0), b3, voffB); PG8_STAGE(PG8_SB(1, 1), b3 + hstep, voffB); PG8_STAGE(PG8_SA(1, 0), a3, voffA);
            PG8_WAIT_V(8); PG8_WAIT_L(0); PG8_BAR; PG8_MMA(1, 0, At, B0); PG8_MMA(1, 1, At, B1); PG8_BAR; PG8_SCHED;
            } else {
            PG8_LDB(B0, 0, 0); PG8_SCHED; PG8_LDA(At, 0, 0); PG8_STAGE(PG8_SA(1, 1), a1 + hstep, voffA);
            PG8_WAIT_L(8); PG8_BAR; PG8_WAIT_L(0); PG8_MMA(0, 0, At, B0); PG8_BAR; PG8_SCHED;
            PG8_LDB(B1, 0, 1); PG8_STAGE(PG8_SB(0, 0), b2, voffB);
            PG8_BAR; PG8_WAIT_L(0); PG8_MMA(0, 1, At, B1); PG8_BAR;
            PG8_LDA(At, 0, 1); PG8_STAGE(PG8_SA(0, 0), a2, voffA);
            PG8_BAR; PG8_WAIT_L(0); PG8_MMA(1, 0, At, B0); PG8_BAR; PG8_SCHED;
            PG8_STAGE(PG8_SB(0, 1), b2 + hstep, voffB);
            PG8_WAIT_V(6); PG8_BAR; PG8_MMA(1, 1, At, B1); PG8_BAR;
            PG8_LDB(B0, 1, 0); PG8_SCHED; PG8_LDA(At, 1, 0); PG8_STAGE(PG8_SA(0, 1), a2 + hstep, voffA);
            PG8_WAIT_L(8); PG8_BAR; PG8_WAIT_L(0); PG8_MMA(0, 0, At, B0); PG8_BAR; PG8_SCHED;
            PG8_LDB(B1, 1, 1); PG8_STAGE(PG8_SB(1, 0), b3, voffB);
            PG8_BAR; PG8_WAIT_L(0); PG8_MMA(0, 1, At, B1); PG8_BAR;
            PG8_LDA(At, 1, 1); PG8_STAGE(PG8_SA(1, 0), a3, voffA);
            PG8_BAR; PG8_WAIT_L(0); PG8_MMA(1, 0, At, B0); PG8_BAR; PG8_SCHED;
            PG8_STAGE(PG8_SB(1, 1), b3 + hstep, voffB);
            PG8_WAIT_V(6); PG8_BAR; PG8_MMA(1, 1, At, B1); PG8_BAR;
            }
        }
        if constexpr (ALIGN_EPI) { if (wr == 0) PG8_BAR; }
        E(acc, cur, wr, wc, fr, fq); S.done(cur);
        if (!has_next) break;
#pragma unroll
        for (int a = 0; a < 2; ++a)
#pragma unroll
            for (int b = 0; b < 2; ++b)
#pragma unroll
                for (int m = 0; m < 4; ++m)
#pragma unroll
                    for (int n = 0; n < 2; ++n) acc[a][b][m][n] = (f32x4){0.f, 0.f, 0.f, 0.f};
        cur = nxt; cA = nA; cB = nB; ++ui;
        if constexpr (ALIGN_EPI) { if (wr == 1) PG8_BAR; }
    }
    PG8_WAIT_V(0);
    if constexpr (!ALIGN_EPI) { if (wr == 0) PG8_BAR; }
    PG8_BAR;
#undef PG8_SA
#undef PG8_SB
#undef PG8_STAGE
#undef PG8_LDA
#undef PG8_LDB
#undef PG8_MMA
#undef PG8_WAIT_V
#undef PG8_WAIT_L
#undef PG8_BAR
#undef PG8_SCHED
}
#endif
}
#ifndef PG8_SP2
#define PG8_SP2 true
#endif
#ifndef PG8_ALIGN
#define PG8_ALIGN true
#endif
DEV void wg_sync() { __syncthreads(); }
#define PR(v4, h) ((f32x2){(v4)[2 * (h)], (v4)[2 * (h) + 1]})
typedef f32x4 Acc[2][2][4][2];
#define UNROLL _Pragma("unroll")

#define EPI_ROWS(...) _Pragma("unroll") for (int ai = 0; ai < 2; ++ai) _Pragma("unroll") for (int m = 0; m < 4; ++m) { const int row = u.pm * 256 + ai * 128 + wr * 64 + m * 16 + fr; __VA_ARGS__ }

#define EPI_ROW_OF(ai, m) (u.pm * 256 + (ai) * 128 + wr * 64 + (m) * 16 + fr)
#define EPI_M(...) _Pragma("unroll") for (int m = 0; m < 4; ++m) { const int row = EPI_ROW_OF(ai, m); __VA_ARGS__ }
#define EPI_AI _Pragma("unroll") for (int ai = 0; ai < 2; ++ai)
struct EpiSwiglu {
    static constexpr bool PERM = true, AFTER_DRAIN = false;
    bf16_t* act;
    DEV void operator()(const Acc& acc, const pg8::Unit& u, int wr, int wc, int fr, int fq) const {
        const int col = u.pn * 128 + wc * 32 + 8 * fq;
        EPI_ROWS({ float o[8]; UNROLL for (int j = 0; j < 8; ++j) { const float gv = acc[ai][0][m][j >> 2][j & 3], uv = acc[ai][1][m][j >> 2][j & 3]; o[j] = siluf_(gv) * uv; }
            st8(act + (size_t)row * FF + col, pack8(o)); })
    }
};
struct EpiResid {
    static constexpr bool PERM = true, AFTER_DRAIN = false;
    float* X; const float* gate; float scale;
    DEV void operator()(const Acc& acc, const pg8::Unit& u, int wr, int wc, int fr, int fq) const {
        const int cidx = cond_of_row(u.pm * 256); UNROLL for (int bj = 0; bj < 2; ++bj) { const int col = u.pn * 256 + bj * 128 + wc * 32 + 8 * fq;
            const f32x4 g0 = *(const f32x4*)(gate + (size_t)cidx * NMOD * D + col) * scale, g1 = *(const f32x4*)(gate + (size_t)cidx * NMOD * D + col + 4) * scale;
            f32x4 x0[4], x1[4];
            EPI_AI { EPI_M({ const float* p = X + (size_t)row * D + col; x0[m] = *(const f32x4*)p; x1[m] = *(const f32x4*)(p + 4); }) EPI_M({ float* p = X + (size_t)row * D + col; *(f32x4*)p = x0[m] + g0 * acc[ai][bj][m][0]; *(f32x4*)(p + 4) = x1[m] + g1 * acc[ai][bj][m][1]; }) } }
    }
};
#ifdef CPU_EMU
static int emu_pass = 0;
#endif
constexpr int LDS_NORM_P = 131072, LDS_NORM_S = LDS_NORM_P + 4096;
constexpr size_t CTL_NORM_CNT = 16384, CTL_NORM_SLOTS = 131072;
template <bool FINAL, bool HALFSC, bool FIRSTX = false> struct EpiResidNorm {
    static constexpr bool PERM = true, AFTER_DRAIN = false; static constexpr float scale = HALFSC ? 0.5f : 1.0f;
    bf16_t* X; const float* gate;
    const float* ng; const float* msh;
    bf16_t* H; float* out;
    float* slots; unsigned* cnt; LAS unsigned char* lds; const float* xp; const float* xs;
    DEV void operator()(Acc& acc, const pg8::Unit& u_, int wr, int wc, int fr, int fq) const {
        pg8::Unit u = u_;
#ifndef CPU_EMU
        asm volatile("" : "+s"(u.pm), "+s"(u.pn));
#endif
        const int cidx = cond_of_row(u.pm * 256);
        UNROLL for (int bj = 0; bj < 2; ++bj) { const int col = u.pn * 256 + bj * 128 + wc * 32 + 8 * fq;
            const f32x4 g0 = *(const f32x4*)(gate + (size_t)cidx * NMOD * D + col) * scale, g1 = *(const f32x4*)(gate + (size_t)cidx * NMOD * D + col + 4) * scale;
            f32x4 x0[4], x1[4];
#ifdef CPU_EMU
            const bool f32src = FIRSTX && emu_pass == 0;
#else
            constexpr bool f32src = FIRSTX;
#endif
            const float* Xin = u.pm * 256 < MC ? xp : xs - (size_t)MC * D;
#ifdef CPU_EMU
#define RN_UPD(b0_, b1_) do { const f32x4 a0 = emu_pass ? (b0_) : (b0_) + g0 * acc[ai][bj][m][0], a1 = emu_pass ? (b1_) : (b1_) + g1 * acc[ai][bj][m][1]; acc[ai][bj][m][0] = a0; acc[ai][bj][m][1] = a1; } while (0)
#else
#define RN_UPD(b0_, b1_) do { const f32x4 a0 = (b0_) + g0 * acc[ai][bj][m][0], a1 = (b1_) + g1 * acc[ai][bj][m][1]; acc[ai][bj][m][0] = a0; acc[ai][bj][m][1] = a1; \
                asm volatile("" : "+v"(acc[ai][bj][m][0]), "+v"(acc[ai][bj][m][1])); } while (0)
#endif
            if (f32src) {
                EPI_AI { EPI_M({ const unsigned eo = (unsigned)row * D + (unsigned)col; x0[m] = *(const f32x4*)((const char*)Xin + eo * 4u); x1[m] = *(const f32x4*)((const char*)Xin + eo * 4u + 16u); })
                         EPI_M({ (void)row; RN_UPD(x0[m], x1[m]); }) CFENCE(); }
            } else {
                u32x4 xq[2][4];
                EPI_AI { EPI_M({ const unsigned eo = (unsigned)row * D + (unsigned)col; xq[ai][m] = *(const u32x4*)((const char*)X + eo * 2u); }) }
                EPI_AI { EPI_M({ (void)row; const u32x4 q = xq[ai][m]; const f32x4 b0 = (f32x4){bflo(q.x), bfhi(q.x), bflo(q.y), bfhi(q.y)}, b1 = (f32x4){bflo(q.z), bfhi(q.z), bflo(q.w), bfhi(q.w)}; RN_UPD(b0, b1); }) }
                CFENCE();
            }
#undef RN_UPD
        }
        LAS float* P = (LAS float*)(lds + LDS_NORM_P); LAS float* S = (LAS float*)(lds + LDS_NORM_S);
        UNROLL for (int ai = 0; ai < 2; ++ai) UNROLL for (int m = 0; m < 4; ++m) { float s = 0.f;
            UNROLL for (int bj = 0; bj < 2; ++bj) UNROLL for (int n = 0; n < 2; ++n) { const f32x4 a = acc[ai][bj][m][n]; s += (a.x * a.x + a.y * a.y) + (a.z * a.z + a.w * a.w); }
            s += __shfl_xor(s, 16); s += __shfl_xor(s, 32); if (fq == 0) P[wc * 256 + ai * 128 + wr * 64 + m * 16 + fr] = s; }
        wg_sync();
        const int wid = wr * 4 + wc, t = wid * 64 + fq * 16 + fr;
        if (wid < 4) {
            const float s = (P[t] + P[256 + t]) + (P[512 + t] + P[768 + t]); float* slot = slots + ((size_t)u.pm * 256 + t) * 8 + u.pn;
#ifdef CPU_EMU
            *slot = s;
#else
            __hip_atomic_store((unsigned*)slot, __float_as_uint(s), __ATOMIC_RELAXED, __HIP_MEMORY_SCOPE_AGENT);
            VM_WAIT();
            if (fq * 16 + fr == 0) (void)__hip_atomic_fetch_add(cnt + 64 * u.pm, 1u, __ATOMIC_RELAXED, __HIP_MEMORY_SCOPE_AGENT);
#endif
        }
#ifdef CPU_EMU
        if (emu_pass == 0) {
            UNROLL for (int bj = 0; bj < 2; ++bj) { const int col = u.pn * 256 + bj * 128 + wc * 32 + 8 * fq; EPI_ROWS({ const f32x4 a0 = acc[ai][bj][m][0], a1 = acc[ai][bj][m][1]; float o[8] = {a0.x, a0.y, a0.z, a0.w, a1.x, a1.y, a1.z, a1.w}; st8(X + (size_t)row * D + col, pack8(o)); }) }
            wg_sync(); wg_sync(); return; }
#else
        if (wid == 0) {
            unsigned sp = 0u; while ((unsigned)RFL((int)__hip_atomic_load(cnt + 64 * u.pm, __ATOMIC_RELAXED, __HIP_MEMORY_SCOPE_AGENT)) < 32u) { __builtin_amdgcn_s_sleep(1); if (++sp > (1u << 17)) break; }
            __builtin_amdgcn_fence(__ATOMIC_ACQUIRE, "agent"); VM_WAIT(); }
#endif
        wg_sync();
        if (wid < 4) { const float* sl = slots + ((size_t)u.pm * 256 + t) * 8; float v[8];
#ifdef CPU_EMU
            UNROLL for (int j = 0; j < 8; ++j) v[j] = sl[j];
#else
            UNROLL for (int j = 0; j < 8; ++j) v[j] = __uint_as_float(__hip_atomic_load((const unsigned*)sl + j, __ATOMIC_RELAXED, __HIP_MEMORY_SCOPE_AGENT));
#endif
            S[t] = rsqrtf((((v[0] + v[1]) + (v[2] + v[3])) + ((v[4] + v[5]) + (v[6] + v[7]))) * (1.0f / D) + EPS); }
        wg_sync();
        UNROLL for (int bj = 0; bj < 2; ++bj) { int col = u.pn * 256 + bj * 128 + wc * 32 + 8 * fq;
#ifndef CPU_EMU
            asm volatile("" : "+v"(col));
#endif
            f32x4 gm0 = *(const f32x4*)(ng + col), gm1 = *(const f32x4*)(ng + col + 4), sh0 = (f32x4){0.f, 0.f, 0.f, 0.f}, sh1 = sh0;
            if (!FINAL) { const float* ms = msh + (size_t)cidx * NMOD * D + col; gm0 = gm0 * (*(const f32x4*)(ms + D) + 1.0f); gm1 = gm1 * (*(const f32x4*)(ms + D + 4) + 1.0f); sh0 = *(const f32x4*)ms; sh1 = *(const f32x4*)(ms + 4); }
            EPI_ROWS({ const float rs = S[ai * 128 + wr * 64 + m * 16 + fr]; const f32x4 a0 = acc[ai][bj][m][0], a1 = acc[ai][bj][m][1];
                if (!FINAL) {
                    const unsigned eo = (unsigned)row * D + (unsigned)col;
#ifndef CPU_EMU
                    { float xo[8] = {a0.x, a0.y, a0.z, a0.w, a1.x, a1.y, a1.z, a1.w}; *(u32x4*)((char*)X + eo * 2u) = pack8(xo); }
#endif
                    const f32x4 y0 = a0 * rs * gm0 + sh0, y1 = a1 * rs * gm1 + sh1; float o[8] = {y0.x, y0.y, y0.z, y0.w, y1.x, y1.y, y1.z, y1.w};
                    *(u32x4*)((char*)H + eo * 2u) = pack8(o); }
                else { const unsigned bo = ((unsigned)row * D + (unsigned)col) * 4u; *(f32x4*)((char*)out + bo) = a0 * rs * gm0; *(f32x4*)((char*)out + bo + 16u) = a1 * rs * gm1; }
                CFENCE(); }) }
    }
};
struct EpiZ {
    static constexpr bool PERM = true, AFTER_DRAIN = false;
    bf16_t *za, *zb;
    DEV void operator()(const Acc& acc, const pg8::Unit& u, int wr, int wc, int fr, int fq) const {
        int c0 = u.pn * 256; bf16_t* base; int ld; if (c0 < RCOLS) { base = za; ld = RCOLS; } else { base = zb; ld = ZB_LD; c0 -= RCOLS; }
        UNROLL for (int bj = 0; bj < 2; ++bj) { const int col = c0 + bj * 128 + wc * 32 + 8 * fq;
            EPI_ROWS({ float o[8]; UNROLL for (int j = 0; j < 8; ++j) o[j] = acc[ai][bj][m][j >> 2][j & 3];
                st8(base + (size_t)row * ld + col, pack8(o)); }) }
    }
};
struct EpiZC {
    static constexpr bool PERM = true, AFTER_DRAIN = false;
    bf16_t* ug;
    DEV void operator()(const Acc& acc, const pg8::Unit& u, int wr, int wc, int fr, int fq) const {
        UNROLL for (int bj = 0; bj < 2; ++bj) { const int col = u.pn * 256 + bj * 128 + wc * 32 + 8 * fq, g = col >> 4, cl = col & 15;
            EPI_ROWS({ float o[8]; UNROLL for (int j = 0; j < 8; ++j) o[j] = acc[ai][bj][m][j >> 2][j & 3];
                st8(ug + ((size_t)g * MCH + row / S5L) * S5K + (row % S5L) * 16 + cl, pack8(o)); }) }
    }
};
DEV u32x2 pack_gate8(const float (&g)[8]) { unsigned q[8]; UNROLL for (int j = 0; j < 8; ++j) q[j] = (unsigned)(g[j] * 255.0f + 0.5f);
    u32x2 o; o.x = q[0] | (q[1] << 8) | (q[2] << 16) | (q[3] << 24); o.y = q[4] | (q[5] << 8) | (q[6] << 16) | (q[7] << 24); return o; }
DEV void unpack_gate8(const u32x2 w, float (&g)[8]) { UNROLL for (int j = 0; j < 4; ++j) { g[j] = (float)((w.x >> (8 * j)) & 255u) * (1.0f / 255.0f); g[4 + j] = (float)((w.y >> (8 * j)) & 255u) * (1.0f / 255.0f); } }
typedef unsigned char gate8_t;
struct EpiGate {
    static constexpr bool PERM = true, AFTER_DRAIN = false;
    gate8_t* zg;
    DEV void operator()(const Acc& acc, const pg8::Unit& u, int wr, int wc, int fr, int fq) const { UNROLL for (int bj = 0; bj < 2; ++bj) { const int col = u.pn * 256 + bj * 128 + wc * 32 + 8 * fq;
            EPI_ROWS({ float o[8]; UNROLL for (int j = 0; j < 8; ++j) o[j] = sigmoidf_(acc[ai][bj][m][j >> 2][j & 3]);
                *(u32x2*)(zg + (size_t)row * 3 * D + col) = pack_gate8(o); }) }
    }
};
struct EpiLRw {
    static constexpr bool PERM = true, AFTER_DRAIN = false;
    bf16_t* omd; const float* w0;
    DEV void operator()(const Acc& acc, const pg8::Unit& u, int wr, int wc, int fr, int fq) const {
        UNROLL for (int bj = 0; bj < 2; ++bj) { const int n = u.pn * 256 + bj * 128 + wc * 32 + 8 * fq, d = n / RW, c = n % RW;
            const f32x4 b0 = *(const f32x4*)(w0 + n), b1 = *(const f32x4*)(w0 + n + 4);
            EPI_ROWS({ float o[8];
                UNROLL for (int j = 0; j < 4; ++j) { const float r0 = 0.6065306597126334f * sigmoidf_(b0[j] + acc[ai][bj][m][0][j]), r1 = 0.6065306597126334f * sigmoidf_(b1[j] + acc[ai][bj][m][1][j]); o[j] = 1.0f - __expf(-r0); o[4 + j] = 1.0f - __expf(-r1); }
                st8(omd + ((size_t)d * M + row) * RW + c, pack8(o)); }) }
    }
};
struct EpiLRa {
    static constexpr bool PERM = true, AFTER_DRAIN = false;
    bf16_t *kd, *bb; const bf16_t *xs, *kk; const float *a0, *ka;
    DEV void operator()(const Acc& acc, const pg8::Unit& u, int wr, int wc, int fr, int fq) const {
        UNROLL for (int bj = 0; bj < 2; ++bj) { const int n = u.pn * 256 + bj * 128 + wc * 32 + 8 * fq, d = n / RW, c = n % RW;
            const f32x4 b0 = *(const f32x4*)(a0 + n), b1 = *(const f32x4*)(a0 + n + 4), k0 = *(const f32x4*)(ka + c), k1 = *(const f32x4*)(ka + c + 4);
            u32x4 kq[4], kkq[4];
            EPI_AI { EPI_M({ kq[m] = ld8(xs + (size_t)row * 3 * RW + RW + c); kkq[m] = ld8(kk + (size_t)row * RW + c); }) EPI_M({ float kv[8], kkv[8], o1[8], o2[8]; unpack8(kq[m], kv); unpack8(kkq[m], kkv);
                        UNROLL for (int j = 0; j < 4; ++j) { const float a_0 = sigmoidf_(b0[j] + acc[ai][bj][m][0][j]), a_1 = sigmoidf_(b1[j] + acc[ai][bj][m][1][j]);
                            o1[j] = kv[j] * (1.0f + (a_0 - 1.0f) * k0[j]); o2[j] = kkv[j] * a_0; o1[4 + j] = kv[4 + j] * (1.0f + (a_1 - 1.0f) * k1[j]); o2[4 + j] = kkv[4 + j] * a_1; }
                        st8(kd + ((size_t)d * M + row) * RW + c, pack8(o1)); st8(bb + ((size_t)d * M + row) * RW + c, pack8(o2)); }) } }
    }
};
struct EpiLRg {
    static constexpr bool PERM = true, AFTER_DRAIN = false;
    bf16_t* gg;
    DEV void operator()(const Acc& acc, const pg8::Unit& u, int wr, int wc, int fr, int fq) const {
        UNROLL for (int bj = 0; bj < 2; ++bj) { const int c = u.pn * 256 + bj * 128 + wc * 32 + 8 * fq;
            EPI_ROWS({ float o[8]; UNROLL for (int j = 0; j < 8; ++j) o[j] = acc[ai][bj][m][j >> 2][j & 3];
                st8(gg + (size_t)row * RW + c, pack8(o)); }) }
    }
};
template <bool FIRST> struct EpiProjAB {
    static constexpr bool PERM = true, AFTER_DRAIN = false;
    bf16_t* mrg; const gate8_t* zg; int goff;
    DEV void operator()(const Acc& acc, const pg8::Unit& u, int wr, int wc, int fr, int fq) const { UNROLL for (int bj = 0; bj < 2; ++bj) { const int col = u.pn * 256 + bj * 128 + wc * 32 + 8 * fq;
            u32x2 gq[4]; u32x4 mq[4];
            EPI_AI { EPI_M({ gq[m] = *(const u32x2*)(zg + (size_t)row * 3 * D + goff + col); if (!FIRST) mq[m] = ld8(mrg + (size_t)row * D + col); else mq[m] = (u32x4){0u, 0u, 0u, 0u}; }) EPI_M({ float g[8], r[8]; unpack_gate8(gq[m], g); unpack8(mq[m], r);
                        UNROLL for (int j = 0; j < 4; ++j) { r[j] += g[j] * acc[ai][bj][m][0][j]; r[4 + j] += g[4 + j] * acc[ai][bj][m][1][j]; }
                        st8(mrg + (size_t)row * D + col, pack8(r)); }) } }
    }
};
struct EpiProjC {
    static constexpr bool PERM = true, AFTER_DRAIN = false;
    const bf16_t* mrg; bf16_t* mrgb; const gate8_t* zg;
    DEV void operator()(const Acc& acc, const pg8::Unit& u, int wr, int wc, int fr, int fq) const {
        const int col = u.pn * 128 + wc * 32 + 8 * fq; u32x2 gq[4]; u32x4 mq[4];
        EPI_AI { EPI_M({ gq[m] = *(const u32x2*)(zg + (size_t)row * 3 * D + 2 * D + col); mq[m] = ld8(mrg + (size_t)row * D + col); }) EPI_M({ float g[8], r[8]; unpack_gate8(gq[m], g); unpack8(mq[m], r); float o[8];
                    UNROLL for (int j = 0; j < 4; ++j) { o[j] = r[j] + g[j] * acc[ai][0][m][0][j] * sigmoidf_(acc[ai][1][m][0][j]); o[4 + j] = r[4 + j] + g[4 + j] * acc[ai][0][m][1][j] * sigmoidf_(acc[ai][1][m][1][j]); }
                    st8(mrgb + (size_t)row * D + col, pack8(o)); }) }
    }
};
template <int NT> struct BatchOrder {
    int G, c;
    DEV bool next(int i, pg8::Unit& u) const { const long id = (long)i * G + c; if (id >= (long)CG * S5MT * NT) return false;
        const int g = (int)(id / (S5MT * NT)), r = (int)(id % (S5MT * NT)); u.pm = g * S5MT + r / NT; u.pn = g * NT + r % NT; return true; }
    DEV void a_ready(const pg8::Unit&) const {}
    DEV void done(const pg8::Unit&) const {}
};
struct PanelOrder {
    int G, c;
    DEV bool next(int i, pg8::Unit& u) const { const int L = i * G + c; if (L >= (M / 256) * (D / 256)) return false;
        const int x = L & 7, o = L >> 3; u.pm = ((o >> 5) * 8 + x) * 4 + (o & 3); u.pn = (o & 31) >> 2; return true; }
    DEV void a_ready(const pg8::Unit&) const {}
    DEV void done(const pg8::Unit&) const {}
};
struct ProjCOrder {
    pg8::StaticOrder base;
    DEV bool next(int i, pg8::Unit& u) const { if (!base.next(i >> 1, u)) return false; u.pn = 2 * u.pn + (i & 1); return true; }
    DEV void a_ready(const pg8::Unit&) const {}
    DEV void done(const pg8::Unit&) const {}
};
struct EpiS5a {
    static constexpr bool PERM = true, AFTER_DRAIN = false;
    bf16_t* yl; float* se;
    DEV void operator()(const Acc& acc, const pg8::Unit& u, int wr, int wc, int fr, int fq) const {
        const int g = u.pn / S5NT1, ni = u.pn % S5NT1, rbase = (u.pm % S5MT) * 256;
        UNROLL for (int bj = 0; bj < 2; ++bj) { const int col = ni * 256 + bj * 128 + wc * 32 + 8 * fq;
            EPI_ROWS({ const int r = rbase + (row - u.pm * 256);
                if (ni < S5NT2) { float o[8]; UNROLL for (int j = 0; j < 8; ++j) o[j] = acc[ai][bj][m][j >> 2][j & 3]; st8(yl + ((size_t)g * MCH + r) * S5K + col, pack8(o)); }
                else { float* p = se + ((size_t)g * MCH + r) * 256 + (col - S5K); *(f32x4*)p = acc[ai][bj][m][0]; *(f32x4*)(p + 4) = acc[ai][bj][m][1]; } }) }
    }
};
struct EpiS5b {
    static constexpr bool PERM = true, AFTER_DRAIN = false;
    const bf16_t *yl, *ug; bf16_t* yc; const float* dsk;
    DEV void operator()(const Acc& acc, const pg8::Unit& u, int wr, int wc, int fr, int fq) const {
        const int g = u.pn / S5NT2, ni = u.pn % S5NT2, rbase = (u.pm % S5MT) * 256;
        UNROLL for (int bj = 0; bj < 2; ++bj) { const int col = ni * 256 + bj * 128 + wc * 32 + 8 * fq, t = col >> 4, cl = col & 15;
            const f32x4 d0 = *(const f32x4*)(dsk + g * 16 + cl), d1 = *(const f32x4*)(dsk + g * 16 + cl + 4);
            u32x4 aq[4], uq[4];
            EPI_AI { EPI_M({ const int r = rbase + (row - u.pm * 256); const size_t off = ((size_t)g * MCH + (r < M / S5L ? r : 0)) * S5K + col; aq[m] = ld8(yl + off); uq[m] = ld8(ug + off); }) EPI_M({ const int r = rbase + (row - u.pm * 256);
                        if (r < M / S5L) { float a[8], uu[8], o[8]; unpack8(aq[m], a); unpack8(uq[m], uu);
                            UNROLL for (int j = 0; j < 4; ++j) { o[j] = geluf_(d0[j] * uu[j] + a[j] + acc[ai][bj][m][0][j]); o[4 + j] = geluf_(d1[j] * uu[4 + j] + a[4 + j] + acc[ai][bj][m][1][j]); }
                            st8(yc + ((size_t)r * S5L + t) * CW + g * 16 + cl, pack8(o)); } }) } }
    }
};

#ifndef CPU_EMU
#define XB_TMO      128
#define XB_XCNT(j)  (256  + 64 * (j))
#define XB_XSUB(j)  (1280 + 64 * (j))
#define XB_XGEN(j)  (2304 + 64 * (j))
#define XB_TOP      3328
#define XB_TOPGEN   3392
#define XCD_BAR_WORDS 3456
#define XB_SPIN_CAP (1u << 18)
__device__ __forceinline__ unsigned xb_ld(unsigned* p)              { return __hip_atomic_load(p, __ATOMIC_RELAXED, __HIP_MEMORY_SCOPE_AGENT); }
__device__ __forceinline__ unsigned xb_add(unsigned* p, unsigned v) { return __hip_atomic_fetch_add(p, v, __ATOMIC_RELAXED, __HIP_MEMORY_SCOPE_AGENT); }
__device__ __forceinline__ unsigned xb_xcc_id() { return (unsigned)__builtin_amdgcn_s_getreg((3 << 11) | 20) & 0xFu; }
#define XB_SPIN(cond, bar) do { unsigned _sp = 0; while (cond) { __builtin_amdgcn_s_sleep(1); \
    if ((++_sp & 255u) == 0u) { if (xb_ld(&(bar)[XB_TMO])) break; if (_sp > XB_SPIN_CAP) { atomicAdd(&(bar)[XB_TMO], 1u); break; } } } } while (0)
struct XcdBarrier { unsigned* bar; unsigned x; volatile LAS unsigned* st; };
__device__ __forceinline__ XcdBarrier xcd_barrier_post(unsigned* bar, volatile LAS unsigned* st) {
    XcdBarrier b; b.bar = bar; b.x = xb_xcc_id(); b.st = st;
    if (threadIdx.x == 0) (void)xb_add(&bar[XB_XCNT(b.x)], 1u);
    return b;
}
__device__ __forceinline__ void xcd_barrier_complete(unsigned* bar, unsigned x, unsigned& nloc, unsigned& nx) {
    const unsigned G = gridDim.x * gridDim.y * gridDim.z;
    unsigned sum, cnt, mine, sp = 0u;
    for (;;) {
        sum = 0u; cnt = 0u; mine = 0u;
#pragma unroll
        for (unsigned j = 0; j < 16; ++j) { const unsigned c = xb_ld(&bar[XB_XCNT(j)]); sum += c; cnt += (c > 0u) ? 1u : 0u; mine = (j == x) ? c : mine; }
        if (sum == G) break;
        __builtin_amdgcn_s_sleep(1);
        if ((++sp & 255u) == 0u) { if (xb_ld(&bar[XB_TMO])) break; if (sp > XB_SPIN_CAP) { atomicAdd(&bar[XB_TMO], 1u); break; } }
    }
    nloc = mine > 0u ? mine : 1u; nx = cnt > 0u ? cnt : 1u;
}
__device__ __forceinline__ void xcd_barrier(const XcdBarrier& b) {
    asm volatile("s_waitcnt vmcnt(0)" ::: "memory");
    __syncthreads();
    if (threadIdx.x == 0) {
        unsigned* bar = b.bar;
        __builtin_amdgcn_s_waitcnt(0);
        unsigned nloc = b.st[0], nx = b.st[1];
        if (nloc == 0u) { xcd_barrier_complete(bar, b.x, nloc, nx); b.st[0] = nloc; b.st[1] = nx; }
        const unsigned old = xb_add(&bar[XB_XSUB(b.x)], 1u);
        const unsigned gen = old / nloc;
        if (old + 1u == (gen + 1u) * nloc) {
            __builtin_amdgcn_fence(__ATOMIC_RELEASE, "agent");
            asm volatile("s_waitcnt vmcnt(0)" ::: "memory");
            const unsigned og = xb_add(&bar[XB_TOP], 1u);
            const unsigned tg = og / nx;
            if (og + 1u == (tg + 1u) * nx) xb_add(&bar[XB_TOPGEN], 1u);
            else XB_SPIN(xb_ld(&bar[XB_TOPGEN]) == tg, bar);
            __builtin_amdgcn_fence(__ATOMIC_ACQUIRE, "agent");
            xb_add(&bar[XB_XGEN(b.x)], 1u);
            asm volatile("s_waitcnt vmcnt(0)" ::: "memory");
        } else {
            XB_SPIN(xb_ld(&bar[XB_XGEN(b.x)]) == gen, bar);
            __builtin_amdgcn_fence(__ATOMIC_ACQUIRE, "agent");
            asm volatile("s_waitcnt vmcnt(0)" ::: "memory");
        }
    }
    __syncthreads();
}
#endif

constexpr int LDS_MAIN = 131072;
constexpr int LDS_MISC = 143360;
constexpr int LDS_BYTES = 147456;
struct Args { const float* in[N_IN]; float* out; unsigned char* ws; int ph_lo, ph_hi; };
struct Ctx {
    const Args CAS* a; LAS unsigned char* lds; int tid, lane, wave, bid, G;
    DEV const float* in(int i) const { return a->in[i]; }
    DEV float* out() const { return a->out; }
    template <class T> DEV T* ws(size_t off) const { return (T*)(a->ws + off); }
    DEV int gw() const { return wave * G + bid; }
    DEV int ngw() const { return G * NWAVES; }
};


struct Span2 { int a0, a1, b0, b1; };
DEV int cdiv_pos(long a, long b) { return a <= 0 ? 0 : (int)((a + b - 1) / b); }
DEV Span2 balanced_span(int w, int parts, int n0, long c0, int n1, long c1) {
    const long total = n0 * c0 + n1 * c1, tgt = (total + parts - 1) / parts, lo = (long)w * tgt, hi = lo + tgt, base = n0 * c0;
    Span2 s; s.a0 = cdiv_pos(lo, c0); s.a1 = cdiv_pos(hi, c0); if (s.a0 > n0) s.a0 = n0; if (s.a1 > n0) s.a1 = n0;
    s.b0 = cdiv_pos(lo - base, c1); s.b1 = cdiv_pos(hi - base, c1); if (s.b0 > n1) s.b0 = n1; if (s.b1 > n1) s.b1 = n1;
    return s;
}

DEV void phase_pro(const Ctx& c) {
    constexpr int NB = NMOD * D / 256, NITEM = DEPTH * NB, KW = D / NWAVES;
    LAS float* S = (LAS float*)c.lds;
    LAS float* P = (LAS float*)(c.lds + NCOND * D * 4);
    bool have = false;
    const int gstride = c.G >= 256 ? 128 : c.G;
    for (int it = c.bid; it < NITEM && c.bid < gstride; it += gstride) {
        if (!have) { for (int i = c.tid; i < NCOND * D; i += NTHREADS) { const int r = i / D, k = i % D; const float v = r == 0 ? c.in(I_CCTX)[k] : c.in(I_C)[(size_t)(r - 1) * D + k]; S[i] = siluf_(v); } have = true; wg_sync(); }
        const int l = it / NB, cb = it % NB;
        const float* W = c.in(I_WMOD) + (size_t)l * D * NMOD * D + (size_t)cb * 256 + c.lane * 4;
        f32x4 acc[NCOND];
#pragma unroll
        for (int r = 0; r < NCOND; ++r) acc[r] = (f32x4){0.f, 0.f, 0.f, 0.f};
        constexpr int GU = 16;
        static_assert(KW % GU == 0, "mod GEMV unroll");
        for (int k = c.wave * KW; k < (c.wave + 1) * KW; k += GU) { f32x4 w[GU];
#pragma unroll
            for (int q = 0; q < GU; ++q) w[q] = *(const f32x4*)(W + (size_t)(k + q) * NMOD * D);
#pragma unroll
            for (int q = 0; q < GU; ++q) {
#pragma unroll
                for (int r = 0; r < NCOND; ++r) acc[r] += w[q] * S[r * D + k + q]; } }
#pragma unroll
        for (int r = 0; r < NCOND; ++r) *(LAS f32x4*)(P + (c.wave * NCOND + r) * 256 + c.lane * 4) = acc[r];
        wg_sync();
        for (int i = c.tid; i < NCOND * 256; i += NTHREADS) { const int r = i / 256, n = i % 256; float s = c.in(I_BMOD)[(size_t)l * NMOD * D + cb * 256 + n];
#pragma unroll
            for (int w = 0; w < NWAVES; ++w) s += P[(w * NCOND + r) * 256 + n];
            c.ws<float>(WS_MOD)[((size_t)l * NCOND + r) * NMOD * D + cb * 256 + n] = s; }
        wg_sync();
    }
}

template <class MapF> DEV void cvt_item(const float* W, int ldw, int K, bf16_t* WT, LAS float* scr, int item, int nblk, int lane, MapF colmap) {
    const int kb = item / nblk, nb = item % nblk, k0 = 64 * kb, n0 = 64 * nb;
    const int r = lane >> 4, c4 = (lane & 15) * 4, col = colmap(n0 + c4);
    f32x4 v[16];
#pragma unroll
    for (int i = 0; i < 16; ++i) v[i] = col >= 0 ? *(const f32x4*)(W + (size_t)(k0 + 4 * i + r) * ldw + col) : (f32x4){0.f, 0.f, 0.f, 0.f};
#pragma unroll
    for (int i = 0; i < 16; ++i) { LAS float* d = scr + (4 * i + r) * 65 + c4; d[0] = v[i].x; d[1] = v[i].y; d[2] = v[i].z; d[3] = v[i].w; }
    LDS_WAIT(); CFENCE(); WAVE_SYNC();
    const int ch = lane & 7;
#pragma unroll
    for (int j = 0; j < 8; ++j) { const int n = (lane >> 3) + 8 * j; const LAS float* s = scr + (8 * ch) * 65 + n;
        u32x4 o; o.x = pk2(s[0 * 65], s[1 * 65]); o.y = pk2(s[2 * 65], s[3 * 65]); o.z = pk2(s[4 * 65], s[5 * 65]); o.w = pk2(s[6 * 65], s[7 * 65]);
        *(u32x4*)(WT + (size_t)(n0 + n) * K + k0 + 8 * ch) = o; }
    LDS_WAIT(); CFENCE(); WAVE_SYNC();
}
DEV void s5_build(const Ctx& c, int l, int g) {
    LAS float* POW = (LAS float*)c.lds;
    LAS float* BBv = POW + 2 * (S5L + 1) * 64 * 2;
    LAS float* KT = BBv + 2 * 64 * 16 * 2;
    static_assert((2 * (S5L + 1) * 64 * 2 + 2 * 64 * 16 * 2 + 2 * S5L * 256) * 4 <= LDS_MAIN_BYTES, "s5_build LDS");
    for (int e = c.tid; e < 2 * (S5L + 1) * 64; e += NTHREADS) { const int d = e / ((S5L + 1) * 64), m = (e / 64) % (S5L + 1), p = e % 64;
        const size_t gp = ((size_t)(l * 2 + d) * CG + g) * CP + p; const float delta = expf(c.in(I_CLDT)[(size_t)(l * 2 + d) * CG + g]);
        const float rho = c.in(I_CLRE)[gp] * delta, th = c.in(I_CLIM)[gp] * delta, mag = expf((float)m * rho);
        POW[e * 2] = mag * cosf((float)m * th); POW[e * 2 + 1] = mag * sinf((float)m * th); }
    for (int e = c.tid; e < 2 * 64 * 16; e += NTHREADS) { const int d = e / 1024, p = (e / 16) % 64, k = e % 16;
        const size_t gp = ((size_t)(l * 2 + d) * CG + g) * CP + p; const float lre = c.in(I_CLRE)[gp], lim = c.in(I_CLIM)[gp], delta = expf(c.in(I_CLDT)[(size_t)(l * 2 + d) * CG + g]);
        const float mag = expf(lre * delta), lbr = mag * cosf(lim * delta), lbi = mag * sinf(lim * delta), den = lre * lre + lim * lim;
        const float qr = ((lbr - 1.0f) * lre + lbi * lim) / den, qi = (lbi * lre - (lbr - 1.0f) * lim) / den;
        const float br = c.in(I_CBRE)[gp * 16 + k], bi = c.in(I_CBIM)[gp * 16 + k];
        BBv[e * 2] = qr * br - qi * bi; BBv[e * 2 + 1] = qr * bi + qi * br; }
    wg_sync();
    static_assert(NTHREADS == 2 * 16 * 16, "s5_build: one thread per (direction, output channel, input channel)");
    {
        const int d = c.tid >> 8, cc = (c.tid >> 4) & 15, k = c.tid & 15;
        const float* cre = c.in(I_CCRE) + (((size_t)(l * 2 + d) * CG + g) * 16 + cc) * CP; const float* cim = c.in(I_CCIM) + (((size_t)(l * 2 + d) * CG + g) * 16 + cc) * CP;
        float acc[S5L];
#pragma unroll
        for (int m = 0; m < S5L; ++m) acc[m] = 0.f;
#pragma unroll 2
        for (int p = 0; p < 64; ++p) { const float cr = cre[p], ci = cim[p], br = BBv[((d * 64 + p) * 16 + k) * 2], bi = BBv[((d * 64 + p) * 16 + k) * 2 + 1];
            const float wr = cr * br - ci * bi, wi = cr * bi + ci * br;
#pragma unroll
            for (int m = 0; m < S5L; ++m) { const f32x2 pw = *(const LAS f32x2*)(POW + ((d * (S5L + 1) + m) * 64 + p) * 2); acc[m] += wr * pw.x - wi * pw.y; } }
#pragma unroll
        for (int m = 0; m < S5L; ++m) KT[((d * S5L + m) * 16 + cc) * 16 + k] = acc[m];
    }
    wg_sync();
    bf16_t* W = c.ws<bf16_t>(WS_S5W + (size_t)l * S5W_L) + (size_t)g * S5N1 * S5K; bf16_t* F = c.ws<bf16_t>(WS_S5F + (size_t)l * S5F_L) + (size_t)g * S5K * 256;
    for (int e = c.tid; e < S5K * (S5K / 8); e += NTHREADS) { const int n = e / (S5K / 8), kc = e % (S5K / 8), t = n >> 4, cc = n & 15, j = kc >> 1, k0 = (kc & 1) * 8; float o[8];
#pragma unroll
        for (int q = 0; q < 8; ++q) o[q] = (j <= t ? KT[((0 * S5L + (t - j)) * 16 + cc) * 16 + k0 + q] : 0.f) + (j >= t ? KT[((1 * S5L + (j - t)) * 16 + cc) * 16 + k0 + q] : 0.f);
        st8(W + (size_t)n * S5K + kc * 8, pack8(o)); }
    for (int e = c.tid; e < 256 * (S5K / 8); e += NTHREADS) { const int q = e / (S5K / 8), kc = e % (S5K / 8), d = q >> 7, im = (q >> 6) & 1, p = q & 63, j = kc >> 1, k0 = (kc & 1) * 8, m = d ? j : S5L - 1 - j;
        const float pr = POW[((d * (S5L + 1) + m) * 64 + p) * 2], pi = POW[((d * (S5L + 1) + m) * 64 + p) * 2 + 1]; float o[8];
#pragma unroll
        for (int x = 0; x < 8; ++x) { const float br = BBv[((d * 64 + p) * 16 + k0 + x) * 2], bi = BBv[((d * 64 + p) * 16 + k0 + x) * 2 + 1]; o[x] = im ? (pr * bi + pi * br) : (pr * br - pi * bi); }
        st8(W + (size_t)(S5K + q) * S5K + kc * 8, pack8(o)); }
    for (int e = c.tid; e < S5K * 32; e += NTHREADS) { const int n = e / 32, qc = e % 32, t = n >> 4, cc = n & 15, q0 = qc * 8, d = q0 >> 7, im = (q0 >> 6) & 1, p0 = q0 & 63, m = d ? S5L - t : t + 1;
        const float* cre = c.in(I_CCRE) + (((size_t)(l * 2 + d) * CG + g) * 16 + cc) * CP + p0; const float* cim = c.in(I_CCIM) + (((size_t)(l * 2 + d) * CG + g) * 16 + cc) * CP + p0; float o[8];
#pragma unroll
        for (int x = 0; x < 8; ++x) { const float pr = POW[((d * (S5L + 1) + m) * 64 + p0 + x) * 2], pi = POW[((d * (S5L + 1) + m) * 64 + p0 + x) * 2 + 1]; o[x] = im ? -(cre[x] * pi + cim[x] * pr) : (cre[x] * pr - cim[x] * pi); }
        st8(F + (size_t)n * 256 + q0, pack8(o)); }
    wg_sync();
}
constexpr int CI_FI = (D / 64) * (2 * FF / 64), CI_FO = (FF / 64) * (D / 64), CI_WIM = (D / 64) * (NZ_MIX / 64), CI_WIG = (D / 64) * (3 * D / 64), CI_PA = (RW / 64) * (D / 64), CI_PB = (SW / 64) * (D / 64), CI_PC = (CW / 64) * (2 * D / 64), CI_WO = (D / 64) * (D / 64), CI_LR = 5 * 4 * (RW / 64);
constexpr int CONV_NE = CI_FI + CI_FO + CI_WIM + CI_LR, CONV_NL = CI_WIG + CI_PA + CI_PB + CI_PC + CI_WO + CI_FI + CI_FO;
static_assert((2 * FF) % 64 == 0 && NZ % 64 == 0 && NZ_MIX % 64 == 0 && FF % 64 == 0 && 8 * 16640 <= LDS_MISC && (LRN * 256) % 4096 == 0, "conversion tiles");
DEV void conv_one(const Ctx& c, int l, bool late, int r, LAS float* scr) {
    auto ident = [](int n) { return n; };
    auto ffmap = [](int n) { return ((n >> 7) & 1) * FF + (n >> 8) * 128 + (n & 127); };
    auto pcmap = [](int n) { return ((n >> 7) & 1) * D + (n >> 8) * 128 + (n & 127); };
    auto wimap = [](int n) { return n < RCOLS + SCOLS ? n : (n < RCOLS + ZB_LD ? -1 : n - (ZB_LD - SCOLS)); };
    if (!late) {
        if (r < CI_FI) { cvt_item(c.in(I_FWIN) + (size_t)(l * 2) * D * 2 * FF, 2 * FF, D, c.ws<bf16_t>(WS_FIT), scr, r, 2 * FF / 64, c.lane, ffmap); return; } r -= CI_FI;
        if (r < CI_FO) { cvt_item(c.in(I_FWOUT) + (size_t)(l * 2) * FF * D, D, FF, c.ws<bf16_t>(WS_FOT), scr, r, D / 64, c.lane, ident); return; } r -= CI_FO;
        if (r < CI_WIM) { cvt_item(c.in(I_WIN) + (size_t)l * D * DIN, DIN, D, c.ws<bf16_t>(WS_WIT), scr, (r / (NZ_MIX / 64)) * (NZ / 64) + r % (NZ_MIX / 64), NZ / 64, c.lane, wimap); return; } r -= CI_WIM;
        { const int blk = r / (4 * (RW / 64)), kb = (r / (RW / 64)) % 4, nb = r % (RW / 64);
          const bool data = blk < 2 ? kb == 0 : (blk < 4 ? kb == 1 : kb >= 2);
          const float* src = blk < 2 ? c.in(I_RW2) + (size_t)(l * 2 + blk) * 64 * RW : (blk < 4 ? c.in(I_RA2) + (size_t)(l * 2 + blk - 2) * 64 * RW - (size_t)64 * RW : c.in(I_RG2) + (size_t)l * 128 * RW - (size_t)128 * RW);
          auto zmap = [](int) { return -1; };
          if (data) cvt_item(src, RW, 256, c.ws<bf16_t>(WS_LRT) + (size_t)blk * RW * 256, scr, kb * (RW / 64) + nb, RW / 64, c.lane, ident);
          else cvt_item(src, RW, 256, c.ws<bf16_t>(WS_LRT) + (size_t)blk * RW * 256, scr, kb * (RW / 64) + nb, RW / 64, c.lane, zmap); }
        return;
    }
    if (r < CI_WIG) { cvt_item(c.in(I_WIN) + (size_t)l * D * DIN, DIN, D, c.ws<bf16_t>(WS_WIT), scr, (r / (3 * D / 64)) * (NZ / 64) + NZ_MIX / 64 + r % (3 * D / 64), NZ / 64, c.lane, wimap); return; } r -= CI_WIG;
    if (r < CI_PA) { cvt_item(c.in(I_PA) + (size_t)l * RW * D, D, RW, c.ws<bf16_t>(WS_PAT), scr, r, D / 64, c.lane, ident); return; } r -= CI_PA;
    if (r < CI_PB) { cvt_item(c.in(I_PB) + (size_t)l * SW * D, D, SW, c.ws<bf16_t>(WS_PBT), scr, r, D / 64, c.lane, ident); return; } r -= CI_PB;
    if (r < CI_PC) { cvt_item(c.in(I_PC) + (size_t)l * CW * 2 * D, 2 * D, CW, c.ws<bf16_t>(WS_PCT), scr, r, 2 * D / 64, c.lane, pcmap); return; } r -= CI_PC;
    if (r < CI_WO) { cvt_item(c.in(I_WOUT) + (size_t)l * D * D, D, D, c.ws<bf16_t>(WS_WOT), scr, r, D / 64, c.lane, ident); return; } r -= CI_WO;
    if (r < CI_FI) { cvt_item(c.in(I_FWIN) + (size_t)(l * 2 + 1) * D * 2 * FF, 2 * FF, D, c.ws<bf16_t>(WS_FIT) + (size_t)2 * FF * D, scr, r, 2 * FF / 64, c.lane, ffmap); return; } r -= CI_FI;
    cvt_item(c.in(I_FWOUT) + (size_t)(l * 2 + 1) * FF * D, D, FF, c.ws<bf16_t>(WS_FOT) + (size_t)D * FF, scr, r, D / 64, c.lane, ident);
}

DEV void phase_norm(const Ctx& c, int l, int j) {
    constexpr int NV = D / 256;
    const float* X = c.ws<float>(WS_X); bf16_t* H = c.ws<bf16_t>(WS_H);
    for (int row = c.gw(); row < M; row += c.ngw()) {
        const float* xrow = (l == 0 && j == 0) ? (row < MC ? c.in(I_XP) + (size_t)row * D : c.in(I_XS) + (size_t)(row - MC) * D) : X + (size_t)row * D;
        const f32x4* xr = (const f32x4*)xrow + c.lane; f32x4 v[NV]; float ss = 0.f;
#pragma unroll
        for (int i = 0; i < NV; ++i) { v[i] = xr[64 * i]; ss += (v[i].x * v[i].x + v[i].y * v[i].y) + (v[i].z * v[i].z + v[i].w * v[i].w); }
        const float rstd = rsqrtf(wave_sum(ss) * (1.0f / D) + EPS);
        const float* mod = c.ws<float>(WS_MOD) + ((size_t)l * NCOND + cond_of_row(row)) * NMOD * D;
        const f32x4* sh = (const f32x4*)(mod + (size_t)(3 * j) * D) + c.lane; const f32x4* sc = (const f32x4*)(mod + (size_t)(3 * j + 1) * D) + c.lane;
        const f32x4* g = (const f32x4*)(c.in(I_NORMG) + (size_t)(l * 3 + j) * D) + c.lane;
        u32x2* o = (u32x2*)(H + (size_t)row * D) + c.lane;
#pragma unroll
        for (int i = 0; i < NV; ++i) { const f32x4 y = v[i] * rstd * g[64 * i] * (sc[64 * i] + 1.0f) + sh[64 * i]; u32x2 w; w.x = pk2(y.x, y.y); w.y = pk2(y.z, y.w); o[64 * i] = w; }
    }
}
DEV void phase_final(const Ctx& c) {
    constexpr int NV = D / 256;
    const float* X = c.ws<float>(WS_X);
    for (int row = c.gw(); row < M; row += c.ngw()) {
        const f32x4* xr = (const f32x4*)(X + (size_t)row * D) + c.lane; f32x4 v[NV]; float ss = 0.f;
#pragma unroll
        for (int i = 0; i < NV; ++i) { v[i] = xr[64 * i]; ss += (v[i].x * v[i].x + v[i].y * v[i].y) + (v[i].z * v[i].z + v[i].w * v[i].w); }
        const float rstd = rsqrtf(wave_sum(ss) * (1.0f / D) + EPS);
        const f32x4* g = (const f32x4*)c.in(I_FNG) + c.lane; f32x4* o = (f32x4*)(c.out() + OUT_Y + (size_t)row * D) + c.lane;
#pragma unroll
        for (int i = 0; i < NV; ++i) o[64 * i] = v[i] * rstd * g[64 * i];
    }
}

DEV void acc8(float (&a)[8], const bf16_t* p, float w) { float f[8]; unpack8(ld8(p), f);
#pragma unroll
    for (int j = 0; j < 8; ++j) a[j] += w * f[j]; }
DEV void phase_prep(const Ctx& c, int l) {
    const bf16_t* ZA = c.ws<bf16_t>(WS_ZA); const bf16_t* ZB = c.ws<bf16_t>(WS_ZB);
    bf16_t* XS = c.ws<bf16_t>(WS_XS); bf16_t* KK = c.ws<bf16_t>(WS_KK); bf16_t* LRI = c.ws<bf16_t>(WS_LRI); bf16_t* XBC = c.ws<bf16_t>(WS_XBC); float* DT = c.ws<float>(WS_DT);
    for (int it = c.gw(); it < 2 * M; it += c.ngw()) {
        if (it < M) {
            const int row = it; int nbr[4]; float wn;
            if (row < MC) { const int t = row % SEQ; nbr[0] = t > 0 ? row - 1 : -1; nbr[1] = t < SEQ - 1 ? row + 1 : -1; nbr[2] = -1; nbr[3] = -1; wn = 0.5f; }
            else { const int t = (row - MC) % DEC_SEQ, gy = t / GRID_W, gx = t % GRID_W; nbr[0] = gy > 0 ? row - GRID_W : -1; nbr[1] = gy < DEC_SEQ / GRID_W - 1 ? row + GRID_W : -1; nbr[2] = gx > 0 ? row - 1 : -1; nbr[3] = gx < GRID_W - 1 ? row + 1 : -1; wn = 0.25f; }
            constexpr int NCH = RCOLS / 8, NIT = (NCH + 63) / 64;
            struct PrepLd { u32x4 z, n[4]; f32x4 mu0, mu1; };
            auto issue = [&](int i, PrepLd& L) { const int ch = c.lane + 64 * i; const int col = ch < NCH ? 8 * ch : 0;
                L.z = ld8(ZA + (size_t)row * RCOLS + col);
#pragma unroll
                for (int q = 0; q < 4; ++q) L.n[q] = nbr[q] >= 0 ? ld8(ZA + (size_t)nbr[q] * RCOLS + col) : (u32x4){0u, 0u, 0u, 0u};
                const float* mu = c.in(I_RMU) + (size_t)l * RCOLS + col; L.mu0 = *(const f32x4*)mu; L.mu1 = *(const f32x4*)(mu + 4); };
            auto finish = [&](int i, const PrepLd& L) {
                const int ch = c.lane + 64 * i; const bool act = ch < NCH; const int col = act ? 8 * ch : 0;
                float z[8], nb[8], xs[8], f[8];
                unpack8(L.z, z);
#pragma unroll
                for (int j = 0; j < 8; ++j) nb[j] = 0.f;
#pragma unroll
                for (int q = 0; q < 4; ++q) { unpack8(L.n[q], f);
#pragma unroll
                    for (int j = 0; j < 8; ++j) nb[j] += wn * f[j]; }
                const float mu[8] = {L.mu0.x, L.mu0.y, L.mu0.z, L.mu0.w, L.mu1.x, L.mu1.y, L.mu1.z, L.mu1.w};
#pragma unroll
                for (int j = 0; j < 8; ++j) xs[j] = z[j] + mu[j] * (nb[j] - z[j]);
                float kv[8], ssq = 0.f; const bool isk = act && col >= RW && col < 2 * RW;
                if (isk) { const float* kkw = c.in(I_RKK) + (size_t)l * RW + (col - RW);
#pragma unroll
                    for (int j = 0; j < 8; ++j) { kv[j] = xs[j] * kkw[j]; ssq += kv[j] * kv[j]; } }
                else {
#pragma unroll
                    for (int j = 0; j < 8; ++j) kv[j] = 0.f; }
                ssq = red8(ssq);
                if (act) {
                    if (col < 3 * RW) { st8(XS + (size_t)row * 3 * RW + col, pack8(xs));
                        if (isk) { const float rn = rsqrtf(ssq + 1e-12f);
#pragma unroll
                            for (int j = 0; j < 8; ++j) kv[j] *= rn;
                            st8(KK + (size_t)row * RW + (col - RW), pack8(kv)); } }
                    else { const int cc = col - 3 * RW; float o[8];
#pragma unroll
                        for (int j = 0; j < 8; ++j) o[j] = cc < 64 ? tanhf(xs[j]) : (cc < 128 ? xs[j] : sigmoidf_(xs[j]));
                        st8(LRI + (size_t)row * 256 + cc, pack8(o)); }
                } };
            PrepLd LA, LB; issue(0, LA);
#pragma unroll 1
            for (int i = 0; i < NIT; i += 2) {
                if (i + 1 < NIT) issue(i + 1, LB);
                finish(i, LA);
                if (i + 2 < NIT) issue(i + 2, LA);
                if (i + 1 < NIT) finish(i + 1, LB);
            }
        } else {
            const int row = it - M; int t, T; if (row < MC) { t = row % SEQ; T = SEQ; } else { t = (row - MC) % DEC_SEQ; T = DEC_SEQ; }
            constexpr int NCH = SXBC / 8, NIT = (NCH + 63) / 64;
            struct TapLd { u32x4 t[5]; };
            auto issue = [&](int i, TapLd& L) { const int ch = c.lane + 64 * i; const int col = ch < NCH ? 8 * ch : 0;
#pragma unroll
                for (int q = 0; q < 5; ++q) { const int tt = t + q - 2; L.t[q] = (tt >= 0 && tt < T) ? ld8(ZB + (size_t)(row + q - 2) * ZB_LD + SW + col) : (u32x4){0u, 0u, 0u, 0u}; } };
            auto finish = [&](int i, const TapLd& L) { const int ch = c.lane + 64 * i; if (ch >= NCH) return; const int col = 8 * ch; float a[8];
                const float* cb = c.in(I_SCB) + (size_t)l * SXBC + col;
#pragma unroll
                for (int j = 0; j < 8; ++j) a[j] = cb[j];
#pragma unroll
                for (int q = 0; q < 5; ++q) { float f[8]; unpack8(L.t[q], f);
                    const float* cw = c.in(I_SCW) + ((size_t)l * 5 + q) * SXBC + col;
#pragma unroll
                    for (int j = 0; j < 8; ++j) a[j] += cw[j] * f[j]; }
#pragma unroll
                for (int j = 0; j < 8; ++j) a[j] = siluf_(a[j]);
                st8(XBC + (size_t)row * SXBC + col, pack8(a)); };
            TapLd LA, LB; issue(0, LA);
#pragma unroll 1
            for (int i = 0; i < NIT; i += 2) {
                if (i + 1 < NIT) issue(i + 1, LB);
                finish(i, LA);
                if (i + 2 < NIT) issue(i + 2, LA);
                if (i + 1 < NIT) finish(i + 1, LB);
            }
            if (c.lane < SH) { const float raw = bf1(ZB[(size_t)row * ZB_LD + SW + SXBC + c.lane]);
#pragma unroll
                for (int d = 0; d < 2; ++d) DT[((size_t)d * M + row) * SH + c.lane] = softplusf_(raw + c.in(I_SDTB)[(size_t)(l * 2 + d) * SH + c.lane]); }
        }
    }
}

constexpr int TB = 32;
static_assert(SEQ % TB == 0 && DEC_SEQ % TB == 0, "scan block");
DEV void rwkv_chain(const Ctx& c, int l, bool lat, int b, int h, int d) {
    const int T = lat ? DEC_SEQ : SEQ, row0 = lat ? MC + b * DEC_SEQ : b * SEQ, nblk = T / TB;
    const bf16_t* XS = c.ws<bf16_t>(WS_XS); const bf16_t* KK = c.ws<bf16_t>(WS_KK);
    const bf16_t* OMD = c.ws<bf16_t>(WS_OMD) + (size_t)d * M * RW; const bf16_t* KD = c.ws<bf16_t>(WS_KD) + (size_t)d * M * RW; const bf16_t* BB = c.ws<bf16_t>(WS_BB) + (size_t)d * M * RW;
    bf16_t* O = c.ws<bf16_t>(WS_O) + (size_t)d * M * RW;
    LAS float* VEC = (LAS float*)c.lds;
    LAS float* OUTS = (LAS float*)(c.lds + 2 * TB * 6 * 64 * 4);
    const int vrow = c.tid >> 3, cg = c.tid & 7;
    f32x2 s2[4];
    if (lat) { const float* s0 = c.in(I_SRWKV) + ((((size_t)b * DEPTH + l) * 2 + d) * RH + h) * 4096 + vrow * 64 + cg * 8;
#pragma unroll
        for (int j = 0; j < 4; ++j) s2[j] = (f32x2){s0[2 * j], s0[2 * j + 1]}; }
    else {
#pragma unroll
        for (int j = 0; j < 4; ++j) s2[j] = (f32x2){0.f, 0.f}; }
    u32x4 stg[3];
    auto gload = [&](int blk) {
#pragma unroll
        for (int q = 0; q < 3; ++q) { const int task = c.tid + NTHREADS * q, i = task / 48, rem = task % 48, vec = rem >> 3, cc = rem & 7;
            const int st = blk * TB + i, row = row0 + (d ? T - 1 - st : st); const size_t hc = (size_t)h * 64 + cc * 8;
            const bf16_t* p = vec == 0 ? XS + (size_t)row * 3 * RW + hc : vec == 1 ? OMD + (size_t)row * RW + hc : vec == 2 ? KD + (size_t)row * RW + hc : vec == 3 ? BB + (size_t)row * RW + hc : vec == 4 ? KK + (size_t)row * RW + hc : XS + (size_t)row * 3 * RW + 2 * RW + hc;
            stg[q] = ld8(p); } };
    auto lstore = [&](int buf) {
#pragma unroll
        for (int q = 0; q < 3; ++q) { const int task = c.tid + NTHREADS * q, i = task / 48, rem = task % 48, vec = rem >> 3, cc = rem & 7; float f[8]; unpack8(stg[q], f);
            if (vec == 1) {
#pragma unroll
                for (int j = 0; j < 8; ++j) f[j] = 1.0f - f[j]; }
            LAS float* dst = VEC + ((buf * TB + i) * 6 + vec) * 64 + cc * 8; *(LAS f32x4*)dst = (f32x4){f[0], f[1], f[2], f[3]}; *(LAS f32x4*)(dst + 4) = (f32x4){f[4], f[5], f[6], f[7]}; } };
    gload(0); lstore(0); wg_sync();
    for (int blk = 0; blk < nblk; ++blk) {
        const int buf = blk & 1;
        if (blk + 1 < nblk) gload(blk + 1);
        struct RwOps { f32x4 r0, r1, w0, w1, k0, k1, b0, b1, q0, q1; float vv; };
#define RW_LOAD(X, i_) do { const LAS float* V_ = VEC + (buf * TB + (i_)) * 6 * 64 + cg * 8; \
            X.r0 = *(const LAS f32x4*)(V_); X.r1 = *(const LAS f32x4*)(V_ + 4); X.w0 = *(const LAS f32x4*)(V_ + 64); X.w1 = *(const LAS f32x4*)(V_ + 68); X.k0 = *(const LAS f32x4*)(V_ + 128); X.k1 = *(const LAS f32x4*)(V_ + 132); \
            X.b0 = *(const LAS f32x4*)(V_ + 192); X.b1 = *(const LAS f32x4*)(V_ + 196); X.q0 = *(const LAS f32x4*)(V_ + 256); X.q1 = *(const LAS f32x4*)(V_ + 260); X.vv = VEC[((buf * TB + (i_)) * 6 + 5) * 64 + vrow]; } while (0)
#define RW_STEP(X, i_) do { \
            f32x2 a2 = s2[0] * PR(X.q0, 0); a2 = s2[1] * PR(X.q0, 1) + a2; a2 = s2[2] * PR(X.q1, 0) + a2; a2 = s2[3] * PR(X.q1, 1) + a2; \
            const float skk = red8(a2.x + a2.y); const f32x2 v2 = (f32x2){X.vv, X.vv}, n2 = (f32x2){-skk, -skk}; \
            s2[0] = s2[0] * PR(X.w0, 0) + (n2 * PR(X.b0, 0) + v2 * PR(X.k0, 0)); s2[1] = s2[1] * PR(X.w0, 1) + (n2 * PR(X.b0, 1) + v2 * PR(X.k0, 1)); \
            s2[2] = s2[2] * PR(X.w1, 0) + (n2 * PR(X.b1, 0) + v2 * PR(X.k1, 0)); s2[3] = s2[3] * PR(X.w1, 1) + (n2 * PR(X.b1, 1) + v2 * PR(X.k1, 1)); \
            f32x2 o2 = s2[0] * PR(X.r0, 0); o2 = s2[1] * PR(X.r0, 1) + o2; o2 = s2[2] * PR(X.r1, 0) + o2; o2 = s2[3] * PR(X.r1, 1) + o2; \
            const float o = red8(o2.x + o2.y); if (cg == 0) OUTS[(i_) * 64 + vrow] = o; } while (0)
        static_assert(TB % 2 == 0, "paired steps");
        RwOps A, B; RW_LOAD(A, 0);
#pragma unroll 1
        for (int i = 0; i < TB; i += 2) {
            RW_LOAD(B, i + 1); RW_STEP(A, i);
            if (i + 2 < TB) RW_LOAD(A, i + 2);
            RW_STEP(B, i + 1);
        }
#undef RW_STEP
#undef RW_LOAD
        wg_sync();
        { const int i = c.tid >> 4, c4 = (c.tid & 15) * 4, st = blk * TB + i, row = row0 + (d ? T - 1 - st : st); const f32x4 v = *(const LAS f32x4*)(OUTS + i * 64 + c4);
          u32x2 w; w.x = pk2(v.x, v.y); w.y = pk2(v.z, v.w); *(u32x2*)(O + (size_t)row * RW + h * 64 + c4) = w; }
        if (blk + 1 < nblk) lstore(buf ^ 1);
        wg_sync();
    }
    if (!lat) { float* o = c.out() + OUT_RWKV + ((((size_t)b * DEPTH + l) * 2 + d) * RH + h) * 4096 + vrow * 64 + cg * 8;
        *(f32x4*)o = (f32x4){s2[0].x, s2[0].y, s2[1].x, s2[1].y}; *(f32x4*)(o + 4) = (f32x4){s2[2].x, s2[2].y, s2[3].x, s2[3].y}; }
}
typedef _Float16 h2_t __attribute__((ext_vector_type(2)));
#ifdef CPU_EMU
DEV h2_t hfma2(h2_t a, h2_t b, h2_t c) { h2_t r; r.x = (_Float16)((float)a.x * (float)b.x + (float)c.x); r.y = (_Float16)((float)a.y * (float)b.y + (float)c.y); return r; }
DEV float hdot2(h2_t a, h2_t b, float c) { return (float)a.x * (float)b.x + ((float)a.y * (float)b.y + c); }
#else
DEV h2_t hfma2(h2_t a, h2_t b, h2_t c) { return __builtin_elementwise_fma(a, b, c); }
DEV float hdot2(h2_t a, h2_t b, float c) { return __builtin_amdgcn_fdot2(a, b, c, false); }
#endif
DEV unsigned pkh2(float lo, float hi) { h2_t v; v.x = (_Float16)lo; v.y = (_Float16)hi; return __builtin_bit_cast(unsigned, v); }
DEV h2_t ash2(unsigned w) { return __builtin_bit_cast(h2_t, w); }
constexpr int TBH = 64;
static_assert(DEC_SEQ % TBH == 0 && 2 * TBH * 6 * 64 * 2 + (TBH + 1) * 64 * 4 <= LDS_MISC, "half rwkv chain blocks");
DEV void rwkv_chain_h(const Ctx& c, int l, int b, int h, int d) {
    constexpr int T = DEC_SEQ, nblk = T / TBH; const int row0 = MC + b * DEC_SEQ;
    const bf16_t* XS = c.ws<bf16_t>(WS_XS); const bf16_t* KK = c.ws<bf16_t>(WS_KK);
    const bf16_t* OMD = c.ws<bf16_t>(WS_OMD) + (size_t)d * M * RW; const bf16_t* KD = c.ws<bf16_t>(WS_KD) + (size_t)d * M * RW; const bf16_t* BB = c.ws<bf16_t>(WS_BB) + (size_t)d * M * RW;
    bf16_t* O = c.ws<bf16_t>(WS_O) + (size_t)d * M * RW;
    LAS unsigned* VEC = (LAS unsigned*)c.lds;
    LAS float* OUTS = (LAS float*)(c.lds + 2 * TBH * 6 * 64 * 2);
    const int vrow = c.tid >> 3, cg = c.tid & 7;
    h2_t s2[4];
    { const float* s0 = c.in(I_SRWKV) + ((((size_t)b * DEPTH + l) * 2 + d) * RH + h) * 4096 + vrow * 64 + cg * 8;
#pragma unroll
      for (int j = 0; j < 4; ++j) s2[j] = ash2(pkh2(s0[2 * j], s0[2 * j + 1])); }
    constexpr int NQ = TBH * 48 / NTHREADS; static_assert(TBH * 48 % NTHREADS == 0, "staging tasks");
    u32x4 stg[NQ];
    auto gload = [&](int blk) {
#pragma unroll
        for (int q = 0; q < NQ; ++q) { const int task = c.tid + NTHREADS * q, i = task / 48, rem = task % 48, vec = rem >> 3, cc = rem & 7;
            const int st = blk * TBH + i, row = row0 + (d ? T - 1 - st : st); const size_t hc = (size_t)h * 64 + cc * 8;
            const bf16_t* p = vec == 0 ? XS + (size_t)row * 3 * RW + hc : vec == 1 ? OMD + (size_t)row * RW + hc : vec == 2 ? KD + (size_t)row * RW + hc : vec == 3 ? BB + (size_t)row * RW + hc : vec == 4 ? KK + (size_t)row * RW + hc : XS + (size_t)row * 3 * RW + 2 * RW + hc;
            stg[q] = ld8(p); } };
    auto lstore = [&](int buf) {
#pragma unroll
        for (int q = 0; q < NQ; ++q) { const int task = c.tid + NTHREADS * q, i = task / 48, rem = task % 48, vec = rem >> 3, cc = rem & 7; float f[8]; unpack8(stg[q], f);
            if (vec == 1) {
#pragma unroll
                for (int j = 0; j < 8; ++j) f[j] = 1.0f - f[j]; }
            u32x4 o; o.x = pkh2(f[0], f[1]); o.y = pkh2(f[2], f[3]); o.z = pkh2(f[4], f[5]); o.w = pkh2(f[6], f[7]);
            *(LAS u32x4*)(VEC + ((buf * TBH + i) * 6 + vec) * 32 + cc * 4) = o; } };
    gload(0); lstore(0); wg_sync();
    for (int blk = 0; blk < nblk; ++blk) {
        const int buf = blk & 1;
        if (blk + 1 < nblk) gload(blk + 1);
        struct RwH { u32x4 r, w, k, b, q; unsigned vv; };
#define RH_LOAD(X, i_) do { const LAS unsigned* V_ = VEC + (buf * TBH + (i_)) * 6 * 32 + cg * 4; \
            X.r = *(const LAS u32x4*)(V_); X.w = *(const LAS u32x4*)(V_ + 32); X.k = *(const LAS u32x4*)(V_ + 64); X.b = *(const LAS u32x4*)(V_ + 96); X.q = *(const LAS u32x4*)(V_ + 128); \
            X.vv = ((const LAS unsigned short*)(VEC + ((buf * TBH + (i_)) * 6 + 5) * 32))[vrow]; } while (0)
#define RH_STEP(X, i_) do { \
            float sa = hdot2(s2[0], ash2(X.q.x), 0.f); sa = hdot2(s2[1], ash2(X.q.y), sa); sa = hdot2(s2[2], ash2(X.q.z), sa); sa = hdot2(s2[3], ash2(X.q.w), sa); \
            const float skk = red8(sa); const h2_t n2 = ash2(pkh2(-skk, -skk)), v2 = ash2(X.vv | (X.vv << 16)); \
            s2[0] = hfma2(s2[0], ash2(X.w.x), hfma2(v2, ash2(X.k.x), n2 * ash2(X.b.x))); s2[1] = hfma2(s2[1], ash2(X.w.y), hfma2(v2, ash2(X.k.y), n2 * ash2(X.b.y))); \
            s2[2] = hfma2(s2[2], ash2(X.w.z), hfma2(v2, ash2(X.k.z), n2 * ash2(X.b.z))); s2[3] = hfma2(s2[3], ash2(X.w.w), hfma2(v2, ash2(X.k.w), n2 * ash2(X.b.w))); \
            float o = hdot2(s2[0], ash2(X.r.x), 0.f); o = hdot2(s2[1], ash2(X.r.y), o); o = hdot2(s2[2], ash2(X.r.z), o); o = hdot2(s2[3], ash2(X.r.w), o); \
            o = red8(o); OUTS[cg == 0 ? (i_) * 64 + vrow : TBH * 64 + (c.tid & 63)] = o; } while (0)
        RwH A, B; RH_LOAD(A, 0);
#pragma unroll 1
        for (int i = 0; i < TBH; i += 2) {
            RH_LOAD(B, i + 1); RH_STEP(A, i);
            RH_LOAD(A, i + 2);
            RH_STEP(B, i + 1);
        }
#undef RH_STEP
#undef RH_LOAD
        wg_sync();
#pragma unroll
        for (int e = 0; e < TBH / 32; ++e) { const int i = (c.tid >> 4) + 32 * e, c4 = (c.tid & 15) * 4, st = blk * TBH + i, row = row0 + (d ? T - 1 - st : st); const f32x4 v = *(const LAS f32x4*)(OUTS + i * 64 + c4);
          u32x2 w; w.x = pk2(v.x, v.y); w.y = pk2(v.z, v.w); *(u32x2*)(O + (size_t)row * RW + h * 64 + c4) = w; }
        if (blk + 1 < nblk) lstore(buf ^ 1);
        wg_sync();
    }
}
DEV void ssd_chain(const Ctx& c, int l, bool lat, int b, int h, int d) {
    const int T = lat ? DEC_SEQ : SEQ, row0 = lat ? MC + b * DEC_SEQ : b * SEQ, nblk = T / TB, g = h / SHG;
    const bf16_t* XBC = c.ws<bf16_t>(WS_XBC); const float* DT = c.ws<float>(WS_DT) + (size_t)d * M * SH; bf16_t* Y = c.ws<bf16_t>(WS_YSSD) + (size_t)d * M * SW;
    const float aneg = -expf(c.in(I_SALOG)[(size_t)(l * 2 + d) * SH + h]);
    constexpr int BCS = 320;
    LAS float* BC = (LAS float*)c.lds;
    LAS float* XD = BC + 2 * TB * BCS;
    LAS float* DC = XD + 2 * TB * 64;
    LAS float* OUTS = DC + 2 * TB;
    const int p = c.tid >> 3, ng = c.tid & 7;
    f32x2 s2[8];
    if (lat) { const float* s0 = c.in(I_SSSD) + (((((size_t)b * DEPTH + l) * 2 + d) * SH + h) * 64 + p) * SN + ng * 16;
#pragma unroll
        for (int j = 0; j < 8; ++j) s2[j] = (f32x2){s0[2 * j], s0[2 * j + 1]}; }
    else {
#pragma unroll
        for (int j = 0; j < 8; ++j) s2[j] = (f32x2){0.f, 0.f}; }
    u32x4 stg[3]; float dtv = 0.f;
    auto rowof = [&](int blk, int i) { const int st = blk * TB + i; return row0 + (d ? T - 1 - st : st); };
    auto gload = [&](int blk) {
#pragma unroll
        for (int q = 0; q < 2; ++q) { const int task = c.tid + NTHREADS * q, i = task >> 5, cc = task & 31, row = rowof(blk, i);
            stg[q] = ld8(XBC + (size_t)row * SXBC + SW + (cc < 16 ? g * SN + cc * 8 : SG * SN + g * SN + (cc - 16) * 8)); }
        if (c.tid < TB * 8) { const int i = c.tid >> 3, cc = c.tid & 7, row = rowof(blk, i); stg[2] = ld8(XBC + (size_t)row * SXBC + h * 64 + cc * 8); dtv = DT[(size_t)row * SH + h]; } };
    auto lstore = [&](int buf) {
#pragma unroll
        for (int q = 0; q < 2; ++q) { const int task = c.tid + NTHREADS * q, i = task >> 5, cc = task & 31; float f[8]; unpack8(stg[q], f);
            LAS float* dst = BC + (buf * TB + i) * BCS + (cc >> 1) * 20 + (cc & 1) * 8; *(LAS f32x4*)dst = (f32x4){f[0], f[1], f[2], f[3]}; *(LAS f32x4*)(dst + 4) = (f32x4){f[4], f[5], f[6], f[7]}; }
        if (c.tid < TB * 8) { const int i = c.tid >> 3, cc = c.tid & 7; float f[8]; unpack8(stg[2], f);
            LAS float* dst = XD + (buf * TB + i) * 64 + cc * 8; *(LAS f32x4*)dst = (f32x4){f[0] * dtv, f[1] * dtv, f[2] * dtv, f[3] * dtv}; *(LAS f32x4*)(dst + 4) = (f32x4){f[4] * dtv, f[5] * dtv, f[6] * dtv, f[7] * dtv};
            if (cc == 0) DC[buf * TB + i] = expf(dtv * aneg); } };
    gload(0); lstore(0); wg_sync();
    for (int blk = 0; blk < nblk; ++blk) {
        const int buf = blk & 1;
        if (blk + 1 < nblk) gload(blk + 1);
        struct SsOps { f32x4 bv[4], cv[4]; float xd, dec; };
#define SS_LOAD(X, i_) do { const LAS float* Bp_ = BC + (buf * TB + (i_)) * BCS + ng * 20; \
            _Pragma("unroll") for (int q_ = 0; q_ < 4; ++q_) { X.bv[q_] = *(const LAS f32x4*)(Bp_ + 4 * q_); X.cv[q_] = *(const LAS f32x4*)(Bp_ + 160 + 4 * q_); } \
            X.xd = XD[(buf * TB + (i_)) * 64 + p]; X.dec = DC[buf * TB + (i_)]; } while (0)
#define SS_STEP(X, i_) do { const f32x2 xd2 = (f32x2){X.xd, X.xd}, dec2 = (f32x2){X.dec, X.dec}; f32x2 y2 = (f32x2){0.f, 0.f}; \
            _Pragma("unroll") for (int q_ = 0; q_ < 4; ++q_) { _Pragma("unroll") for (int hh = 0; hh < 2; ++hh) { s2[2 * q_ + hh] = s2[2 * q_ + hh] * dec2 + xd2 * PR(X.bv[q_], hh); y2 = s2[2 * q_ + hh] * PR(X.cv[q_], hh) + y2; } } \
            const float y = red8(y2.x + y2.y); if (ng == 0) OUTS[(i_) * 64 + p] = y; } while (0)
        SsOps A, B; SS_LOAD(A, 0);
#pragma unroll 1
        for (int i = 0; i < TB; i += 2) {
            SS_LOAD(B, i + 1); SS_STEP(A, i);
            if (i + 2 < TB) SS_LOAD(A, i + 2);
            SS_STEP(B, i + 1);
        }
#undef SS_STEP
#undef SS_LOAD
        wg_sync();
        { const int i = c.tid >> 4, c4 = (c.tid & 15) * 4, row = rowof(blk, i); const f32x4 v = *(const LAS f32x4*)(OUTS + i * 64 + c4);
          u32x2 w; w.x = pk2(v.x, v.y); w.y = pk2(v.z, v.w); *(u32x2*)(Y + (size_t)row * SW + h * 64 + c4) = w; }
        if (blk + 1 < nblk) lstore(buf ^ 1);
        wg_sync();
    }
    if (!lat) { float* o = c.out() + OUT_SSD + (((((size_t)b * DEPTH + l) * 2 + d) * SH + h) * 64 + p) * SN + ng * 16;
#pragma unroll
        for (int q = 0; q < 4; ++q) *(f32x4*)(o + 4 * q) = (f32x4){s2[2 * q].x, s2[2 * q].y, s2[2 * q + 1].x, s2[2 * q + 1].y}; }
}
DEV void s5_carry(const Ctx& c, int l, bool lat, int b, int g, int d) {
    const int T = lat ? DEC_SEQ : SEQ, nch = T / S5L, r0 = (lat ? MC + b * DEC_SEQ : b * SEQ) / S5L, p = c.lane;
    const float* SE = c.ws<float>(WS_SE) + (size_t)g * MCH * 256 + d * 128; bf16_t* SIN = c.ws<bf16_t>(WS_SIN) + (size_t)g * MCH * 256 + d * 128;
    const size_t gp = ((size_t)(l * 2 + d) * CG + g) * CP + p; const float delta = expf(c.in(I_CLDT)[(size_t)(l * 2 + d) * CG + g]);
    const float rho = c.in(I_CLRE)[gp] * delta * (float)S5L, th = c.in(I_CLIM)[gp] * delta * (float)S5L, mag = expf(rho), lr = mag * cosf(th), li = mag * sinf(th);
    float sr = 0.f, si = 0.f;
    if (lat) { const size_t so = (((size_t)b * DEPTH + l) * 2 + d) * CG * CP + (size_t)g * CP + p; sr = c.in(I_SRE)[so]; si = c.in(I_SIM)[so]; }
    constexpr int UB = 4; static_assert((SEQ / S5L) % UB == 0 && (DEC_SEQ / S5L) % UB == 0, "carry unroll");
    for (int cb = 0; cb < nch; cb += UB) {
        float er[UB], ei[UB];
#pragma unroll
        for (int q = 0; q < UB; ++q) { const int ch = d ? nch - 1 - (cb + q) : cb + q; er[q] = SE[(size_t)(r0 + ch) * 256 + p]; ei[q] = SE[(size_t)(r0 + ch) * 256 + 64 + p]; }
#pragma unroll
        for (int q = 0; q < UB; ++q) { const int ch = d ? nch - 1 - (cb + q) : cb + q; bf16_t* o = SIN + (size_t)(r0 + ch) * 256;
            o[p] = (bf16_t)f2bf(sr); o[64 + p] = (bf16_t)f2bf(si);
            const float nr = lr * sr - li * si + er[q], ni = lr * si + li * sr + ei[q]; sr = nr; si = ni; }
    }
    if (!lat) { const size_t so = (((size_t)b * DEPTH + l) * 2 + d) * CG * CP + (size_t)g * CP + p; c.out()[OUT_RE + so] = sr; c.out()[OUT_IM + so] = si; }
}
#ifdef CPU_EMU
#define MFMA16(a, b, c) emu_mfma16(a, b, c)
#else
#define MFMA16(a, b, c) __builtin_amdgcn_mfma_f32_16x16x32_bf16(a, b, c, 0, 0, 0)
#endif
constexpr int SCH = 64;
static_assert(SEQ % SCH == 0 && DEC_SEQ % SCH == 0 && SN == 128, "ssd chunking");
DEV void ssd_mfma_chain(const Ctx& c, int l, bool lat, int b, int h, int d) {
    const int T = lat ? DEC_SEQ : SEQ, row0 = lat ? MC + b * DEC_SEQ : b * SEQ, nch = T / SCH, g = h / SHG;
    const bf16_t* XBC = c.ws<bf16_t>(WS_XBC); const float* DT = c.ws<float>(WS_DT) + (size_t)d * M * SH; bf16_t* Y = c.ws<bf16_t>(WS_YSSD) + (size_t)d * M * SW;
    const float aneg = -expf(c.in(I_SALOG)[(size_t)(l * 2 + d) * SH + h]);
    constexpr int LDC = 136, LDX = 72;
    LAS bf16_t* Cs = (LAS bf16_t*)c.lds;
    LAS bf16_t* Bs = Cs + 64 * LDC;
    LAS bf16_t* Sb = Bs + 64 * LDC;
    LAS bf16_t* Bt = Sb + 64 * LDC;
    LAS bf16_t* Xt = Bt + 128 * LDX;
    LAS bf16_t* Xdt = Xt + 64 * LDX;
    LAS bf16_t* Ms = Xdt + 64 * LDX;
    LAS bf16_t* Ys = Ms + 64 * LDX;
    LAS bf16_t* Xs = Ys + 64 * LDX;
    LAS float* CUM = (LAS float*)(Xs + 64 * LDX);
    LAS float* DTV = CUM + 64;
    LAS float* WEND = DTV + 64;
    const int w = c.wave, lane = c.lane, r = lane & 15, q = lane >> 4;
    auto rowof = [&](int st) { return row0 + (d ? T - 1 - st : st); };
    f32x4 accS[4];
#pragma unroll
    for (int j = 0; j < 4; ++j) { const int ti = 4 * w + j, pt = ti >> 3, nt = ti & 7, p = 16 * pt + r, n0 = 16 * nt + 4 * q;
        accS[j] = lat ? *(const f32x4*)(c.in(I_SSSD) + (((((size_t)b * DEPTH + l) * 2 + d) * SH + h) * 64 + p) * SN + n0) : (f32x4){0.f, 0.f, 0.f, 0.f};
        u32x2 o; o.x = pk2(accS[j][0], accS[j][1]); o.y = pk2(accS[j][2], accS[j][3]); *(LAS u32x2*)(Sb + p * LDC + n0) = o; }
    u32x4 cR[2], bR[2], xR; float dtj = 0.f;
    auto prefetch = [&](int ck) {
#pragma unroll
        for (int e = 0; e < 2; ++e) { const int id = c.tid + NTHREADS * e, j = id >> 4, nc = (id & 15) * 8; const size_t ro = (size_t)rowof(ck * SCH + j) * SXBC + SW;
            cR[e] = ld8(XBC + ro + SG * SN + g * SN + nc); bR[e] = ld8(XBC + ro + g * SN + nc); }
        { const int j = c.tid >> 3, pc = (c.tid & 7) * 8; xR = ld8(XBC + (size_t)rowof(ck * SCH + j) * SXBC + h * 64 + pc); }
        dtj = DT[(size_t)rowof(ck * SCH + lane) * SH + h]; };
    prefetch(0);
    for (int ck = 0; ck < nch; ++ck) {
        float cum = dtj * aneg;
#pragma unroll
        for (int off = 1; off < 64; off <<= 1) { const float t = __shfl(cum, lane >= off ? lane - off : lane); if (lane >= off) cum += t; }
        const float cumL = __shfl(cum, 63), wend = dtj * __expf(cumL - cum), decL = __expf(cumL);
        if (w == 0) { CUM[lane] = cum; DTV[lane] = dtj; WEND[lane] = wend; }
#pragma unroll
        for (int e = 0; e < 2; ++e) { const int id = c.tid + NTHREADS * e, j = id >> 4, nc = (id & 15) * 8; *(LAS u32x4*)(Cs + j * LDC + nc) = cR[e]; *(LAS u32x4*)(Bs + j * LDC + nc) = bR[e]; }
        { const int j = c.tid >> 3, pc = (c.tid & 7) * 8; *(LAS u32x4*)(Xs + j * LDX + pc) = xR; }
        wg_sync();
#pragma unroll
        for (int e = 0; e < 2; ++e) { const int id = c.tid + NTHREADS * e, n = id & 127, s0 = (id >> 7) * 8; unsigned short v[8];
#pragma unroll
            for (int k = 0; k < 8; ++k) v[k] = Bs[(s0 + k) * LDC + n];
            u32x4 o; o.x = v[0] | ((unsigned)v[1] << 16); o.y = v[2] | ((unsigned)v[3] << 16); o.z = v[4] | ((unsigned)v[5] << 16); o.w = v[6] | ((unsigned)v[7] << 16); *(LAS u32x4*)(Bt + n * LDX + s0) = o; }
        { const int p = c.tid & 63, s0 = (c.tid >> 6) * 8; unsigned short v[8]; float f[8];
#pragma unroll
            for (int k = 0; k < 8; ++k) { v[k] = Xs[(s0 + k) * LDX + p]; f[k] = bf1(v[k]) * WEND[s0 + k]; }
            u32x4 o; o.x = v[0] | ((unsigned)v[1] << 16); o.y = v[2] | ((unsigned)v[3] << 16); o.z = v[4] | ((unsigned)v[5] << 16); o.w = v[6] | ((unsigned)v[7] << 16); *(LAS u32x4*)(Xt + p * LDX + s0) = o;
            *(LAS u32x4*)(Xdt + p * LDX + s0) = pack8(f); }
        wg_sync();
        if (ck + 1 < nch) prefetch(ck + 1);
#pragma unroll
        for (int e = 0; e < 2; ++e) { const int ti = 2 * w + e, tt = ti >> 2, st = ti & 3; f32x4 acc = (f32x4){0.f, 0.f, 0.f, 0.f};
            if (st <= tt) {
#pragma unroll
                for (int ks = 0; ks < 4; ++ks) acc = MFMA16(*(const LAS bf16x8*)(Bs + (16 * st + r) * LDC + 32 * ks + 8 * q), *(const LAS bf16x8*)(Cs + (16 * tt + r) * LDC + 32 * ks + 8 * q), acc); }
            const int t = 16 * tt + r, s0 = 16 * st + 4 * q; const float ct = CUM[t]; float v[4];
#pragma unroll
            for (int i = 0; i < 4; ++i) v[i] = s0 + i <= t ? acc[i] * __expf(ct - CUM[s0 + i]) * DTV[s0 + i] : 0.f;
            u32x2 o; o.x = pk2(v[0], v[1]); o.y = pk2(v[2], v[3]); *(LAS u32x2*)(Ms + t * LDX + s0) = o; }
        wg_sync();
#pragma unroll
        for (int e = 0; e < 2; ++e) { const int ti = 2 * w + e, tt = ti >> 2, pt = ti & 3; f32x4 a1 = (f32x4){0.f, 0.f, 0.f, 0.f}, a2 = a1;
#pragma unroll
            for (int ks = 0; ks < 2; ++ks) a1 = MFMA16(*(const LAS bf16x8*)(Xt + (16 * pt + r) * LDX + 32 * ks + 8 * q), *(const LAS bf16x8*)(Ms + (16 * tt + r) * LDX + 32 * ks + 8 * q), a1);
#pragma unroll
            for (int ks = 0; ks < 4; ++ks) a2 = MFMA16(*(const LAS bf16x8*)(Sb + (16 * pt + r) * LDC + 32 * ks + 8 * q), *(const LAS bf16x8*)(Cs + (16 * tt + r) * LDC + 32 * ks + 8 * q), a2);
            const int t = 16 * tt + r; const float ec = __expf(CUM[t]); u32x2 o; o.x = pk2(a1[0] + ec * a2[0], a1[1] + ec * a2[1]); o.y = pk2(a1[2] + ec * a2[2], a1[3] + ec * a2[3]); *(LAS u32x2*)(Ys + t * LDX + 16 * pt + 4 * q) = o; }
#pragma unroll
        for (int j = 0; j < 4; ++j) { const int ti = 4 * w + j, pt = ti >> 3, nt = ti & 7; accS[j] = accS[j] * decL;
#pragma unroll
            for (int ks = 0; ks < 2; ++ks) accS[j] = MFMA16(*(const LAS bf16x8*)(Bt + (16 * nt + r) * LDX + 32 * ks + 8 * q), *(const LAS bf16x8*)(Xdt + (16 * pt + r) * LDX + 32 * ks + 8 * q), accS[j]); }
        wg_sync();
#pragma unroll
        for (int j = 0; j < 4; ++j) { const int ti = 4 * w + j, pt = ti >> 3, nt = ti & 7; u32x2 o; o.x = pk2(accS[j][0], accS[j][1]); o.y = pk2(accS[j][2], accS[j][3]); *(LAS u32x2*)(Sb + (16 * pt + r) * LDC + 16 * nt + 4 * q) = o; }
        { const int t = c.tid >> 3, pc = (c.tid & 7) * 8; *(u32x4*)(Y + (size_t)rowof(ck * SCH + t) * SW + h * 64 + pc) = *(const LAS u32x4*)(Ys + t * LDX + pc); }
    }
    if (!lat) {
#pragma unroll
        for (int j = 0; j < 4; ++j) { const int ti = 4 * w + j, pt = ti >> 3, nt = ti & 7; *(f32x4*)(c.out() + OUT_SSD + (((((size_t)b * DEPTH + l) * 2 + d) * SH + h) * 64 + 16 * pt + r) * SN + 16 * nt + 4 * q) = accS[j]; } }
    wg_sync();
}
constexpr int TQ = 8;
static_assert(SEQ % TQ == 0 && (BATCH * RH * 2) % 4 == 0 && (BATCH * SH * 2) % 4 == 0, "quad scan shapes");
DEV void rwkv_quad(const Ctx& c, int l, int q) {
    constexpr int T = SEQ, nblk = T / TQ;
    const bf16_t* XS = c.ws<bf16_t>(WS_XS); const bf16_t* KK = c.ws<bf16_t>(WS_KK); const bf16_t* OMD = c.ws<bf16_t>(WS_OMD); const bf16_t* KD = c.ws<bf16_t>(WS_KD); const bf16_t* BB = c.ws<bf16_t>(WS_BB); bf16_t* O = c.ws<bf16_t>(WS_O);
    LAS float* VEC = (LAS float*)c.lds;
    LAS float* OUTS = VEC + 2 * 4 * TQ * 6 * 64;
    const int sg = c.tid >> 7, tg = c.tid & 127, rg = tg >> 3, cg = tg & 7;
    f32x2 s2[4][4];
#pragma unroll
    for (int rr = 0; rr < 4; ++rr)
#pragma unroll
        for (int j = 0; j < 4; ++j) s2[rr][j] = (f32x2){0.f, 0.f};
    u32x4 stg[3];
    auto gload = [&](int blk) {
#pragma unroll
        for (int qq = 0; qq < 3; ++qq) { const int task = c.tid + NTHREADS * qq, cq = task / (TQ * 48), rem = task % (TQ * 48), i = rem / 48, vec = (rem % 48) >> 3, cc = rem & 7;
            const int ch = 4 * q + cq, b = ch / (RH * 2), h = (ch >> 1) % RH, d = ch & 1, st = blk * TQ + i, row = b * SEQ + (d ? T - 1 - st : st); const size_t hc = (size_t)h * 64 + cc * 8, dm = (size_t)d * M * RW;
            const bf16_t* p = vec == 0 ? XS + (size_t)row * 3 * RW + hc : vec == 1 ? OMD + dm + (size_t)row * RW + hc : vec == 2 ? KD + dm + (size_t)row * RW + hc : vec == 3 ? BB + dm + (size_t)row * RW + hc : vec == 4 ? KK + (size_t)row * RW + hc : XS + (size_t)row * 3 * RW + 2 * RW + hc;
            stg[qq] = ld8(p); } };
    auto lstore = [&](int buf) {
#pragma unroll
        for (int qq = 0; qq < 3; ++qq) { const int task = c.tid + NTHREADS * qq, cq = task / (TQ * 48), rem = task % (TQ * 48), i = rem / 48, vec = (rem % 48) >> 3, cc = rem & 7; float f[8]; unpack8(stg[qq], f);
            if (vec == 1) {
#pragma unroll
                for (int j = 0; j < 8; ++j) f[j] = 1.0f - f[j]; }
            LAS float* dst = VEC + ((((buf * 4 + cq) * TQ + i) * 6 + vec) * 64) + cc * 8; *(LAS f32x4*)dst = (f32x4){f[0], f[1], f[2], f[3]}; *(LAS f32x4*)(dst + 4) = (f32x4){f[4], f[5], f[6], f[7]}; } };
    gload(0); lstore(0); wg_sync();
    for (int blk = 0; blk < nblk; ++blk) {
        const int buf = blk & 1;
        if (blk + 1 < nblk) gload(blk + 1);
#pragma unroll 1
        for (int i = 0; i < TQ; ++i) {
            const LAS float* V = VEC + ((buf * 4 + sg) * TQ + i) * 6 * 64;
            const f32x4 r0 = *(const LAS f32x4*)(V + cg * 8), r1 = *(const LAS f32x4*)(V + cg * 8 + 4), w0 = *(const LAS f32x4*)(V + 64 + cg * 8), w1 = *(const LAS f32x4*)(V + 68 + cg * 8), k0 = *(const LAS f32x4*)(V + 128 + cg * 8), k1 = *(const LAS f32x4*)(V + 132 + cg * 8),
                        b0 = *(const LAS f32x4*)(V + 192 + cg * 8), b1 = *(const LAS f32x4*)(V + 196 + cg * 8), q0 = *(const LAS f32x4*)(V + 256 + cg * 8), q1 = *(const LAS f32x4*)(V + 260 + cg * 8), v4 = *(const LAS f32x4*)(V + 320 + rg * 4);
            float skk[4];
#pragma unroll
            for (int rr = 0; rr < 4; ++rr) { f32x2 a2 = s2[rr][0] * PR(q0, 0); a2 = s2[rr][1] * PR(q0, 1) + a2; a2 = s2[rr][2] * PR(q1, 0) + a2; a2 = s2[rr][3] * PR(q1, 1) + a2; skk[rr] = a2.x + a2.y; }
#pragma unroll
            for (int rr = 0; rr < 4; ++rr) skk[rr] = red8(skk[rr]);
            float o[4];
#pragma unroll
            for (int rr = 0; rr < 4; ++rr) { const f32x2 v2 = (f32x2){v4[rr], v4[rr]}, n2 = (f32x2){-skk[rr], -skk[rr]};
                s2[rr][0] = s2[rr][0] * PR(w0, 0) + (n2 * PR(b0, 0) + v2 * PR(k0, 0)); s2[rr][1] = s2[rr][1] * PR(w0, 1) + (n2 * PR(b0, 1) + v2 * PR(k0, 1));
                s2[rr][2] = s2[rr][2] * PR(w1, 0) + (n2 * PR(b1, 0) + v2 * PR(k1, 0)); s2[rr][3] = s2[rr][3] * PR(w1, 1) + (n2 * PR(b1, 1) + v2 * PR(k1, 1));
                f32x2 o2 = s2[rr][0] * PR(r0, 0); o2 = s2[rr][1] * PR(r0, 1) + o2; o2 = s2[rr][2] * PR(r1, 0) + o2; o2 = s2[rr][3] * PR(r1, 1) + o2; o[rr] = o2.x + o2.y; }
#pragma unroll
            for (int rr = 0; rr < 4; ++rr) o[rr] = red8(o[rr]);
            if (cg == 0) *(LAS f32x4*)(OUTS + (sg * TQ + i) * 64 + rg * 4) = (f32x4){o[0], o[1], o[2], o[3]};
        }
        wg_sync();
        { const int cq = c.tid >> 7, i = (c.tid >> 4) & 7, c4 = (c.tid & 15) * 4, ch = 4 * q + cq, b = ch / (RH * 2), h = (ch >> 1) % RH, d = ch & 1, st = blk * TQ + i, row = b * SEQ + (d ? T - 1 - st : st);
          const f32x4 v = *(const LAS f32x4*)(OUTS + (cq * TQ + i) * 64 + c4); u32x2 w; w.x = pk2(v.x, v.y); w.y = pk2(v.z, v.w); *(u32x2*)(O + ((size_t)d * M + row) * RW + h * 64 + c4) = w; }
        if (blk + 1 < nblk) lstore(buf ^ 1);
        wg_sync();
    }
    { const int ch = 4 * q + sg, b = ch / (RH * 2), h = (ch >> 1) % RH, d = ch & 1;
#pragma unroll
      for (int rr = 0; rr < 4; ++rr) { float* o = c.out() + OUT_RWKV + ((((size_t)b * DEPTH + l) * 2 + d) * RH + h) * 4096 + (rg * 4 + rr) * 64 + cg * 8;
          *(f32x4*)o = (f32x4){s2[rr][0].x, s2[rr][0].y, s2[rr][1].x, s2[rr][1].y}; *(f32x4*)(o + 4) = (f32x4){s2[rr][2].x, s2[rr][2].y, s2[rr][3].x, s2[rr][3].y}; } }
}
DEV void ssd_quad(const Ctx& c, int l, int q) {
    constexpr int T = SEQ, nblk = T / TQ, BCS = 320;
    const bf16_t* XBC = c.ws<bf16_t>(WS_XBC); const float* DT = c.ws<float>(WS_DT); bf16_t* Y = c.ws<bf16_t>(WS_YSSD);
    LAS float* BC = (LAS float*)c.lds;
    LAS float* XD = BC + 2 * 4 * TQ * BCS;
    LAS float* DC = XD + 2 * 4 * TQ * 64;
    LAS float* OUTS = DC + 2 * 4 * TQ;
    const int sg = c.tid >> 7, tg = c.tid & 127, pg = tg >> 3, ng = tg & 7;
    f32x2 s2[4][8];
#pragma unroll
    for (int rr = 0; rr < 4; ++rr)
#pragma unroll
        for (int j = 0; j < 8; ++j) s2[rr][j] = (f32x2){0.f, 0.f};
    u32x4 stg[3]; float dtv = 0.f, anegv = 0.f;
    auto chain_of = [&](int cq, int& b, int& h, int& d) { const int ch = 4 * q + cq; b = ch / (SH * 2); h = (ch >> 1) % SH; d = ch & 1; };
    auto gload = [&](int blk) {
#pragma unroll
        for (int qq = 0; qq < 2; ++qq) { const int task = c.tid + NTHREADS * qq, cq = task >> 8, i = (task >> 5) & 7, cc = task & 31; int b, h, d; chain_of(cq, b, h, d); const int g = h / SHG, st = blk * TQ + i, row = b * SEQ + (d ? T - 1 - st : st);
            stg[qq] = ld8(XBC + (size_t)row * SXBC + SW + (cc < 16 ? g * SN + cc * 8 : SG * SN + g * SN + (cc - 16) * 8)); }
        if (c.tid < 4 * TQ * 8) { const int cq = c.tid >> 6, i = (c.tid >> 3) & 7, cc = c.tid & 7; int b, h, d; chain_of(cq, b, h, d); const int st = blk * TQ + i, row = b * SEQ + (d ? T - 1 - st : st);
            stg[2] = ld8(XBC + (size_t)row * SXBC + h * 64 + cc * 8); dtv = DT[((size_t)d * M + row) * SH + h]; anegv = -expf(c.in(I_SALOG)[(size_t)(l * 2 + d) * SH + h]); } };
    auto lstore = [&](int buf) {
#pragma unroll
        for (int qq = 0; qq < 2; ++qq) { const int task = c.tid + NTHREADS * qq, cq = task >> 8, i = (task >> 5) & 7, cc = task & 31; float f[8]; unpack8(stg[qq], f);
            LAS float* dst = BC + ((buf * 4 + cq) * TQ + i) * BCS + (cc >> 1) * 20 + (cc & 1) * 8; *(LAS f32x4*)dst = (f32x4){f[0], f[1], f[2], f[3]}; *(LAS f32x4*)(dst + 4) = (f32x4){f[4], f[5], f[6], f[7]}; }
        if (c.tid < 4 * TQ * 8) { const int cq = c.tid >> 6, i = (c.tid >> 3) & 7, cc = c.tid & 7; float f[8]; unpack8(stg[2], f);
            LAS float* dst = XD + ((buf * 4 + cq) * TQ + i) * 64 + cc * 8; *(LAS f32x4*)dst = (f32x4){f[0] * dtv, f[1] * dtv, f[2] * dtv, f[3] * dtv}; *(LAS f32x4*)(dst + 4) = (f32x4){f[4] * dtv, f[5] * dtv, f[6] * dtv, f[7] * dtv};
            if (cc == 0) DC[(buf * 4 + cq) * TQ + i] = expf(dtv * anegv); } };
    gload(0); lstore(0); wg_sync();
    for (int blk = 0; blk < nblk; ++blk) {
        const int buf = blk & 1;
        if (blk + 1 < nblk) gload(blk + 1);
#pragma unroll 1
        for (int i = 0; i < TQ; ++i) {
            const LAS float* Bp = BC + ((buf * 4 + sg) * TQ + i) * BCS + ng * 20; f32x4 bv[4], cv[4];
#pragma unroll
            for (int k = 0; k < 4; ++k) { bv[k] = *(const LAS f32x4*)(Bp + 4 * k); cv[k] = *(const LAS f32x4*)(Bp + 160 + 4 * k); }
            const f32x4 xd4 = *(const LAS f32x4*)(XD + ((buf * 4 + sg) * TQ + i) * 64 + pg * 4); const float dec = DC[(buf * 4 + sg) * TQ + i]; const f32x2 dec2 = (f32x2){dec, dec};
            float y[4];
#pragma unroll
            for (int rr = 0; rr < 4; ++rr) { const f32x2 xd2 = (f32x2){xd4[rr], xd4[rr]}; f32x2 y2 = (f32x2){0.f, 0.f};
#pragma unroll
                for (int k = 0; k < 4; ++k) {
#pragma unroll
                    for (int hh = 0; hh < 2; ++hh) { s2[rr][2 * k + hh] = s2[rr][2 * k + hh] * dec2 + xd2 * PR(bv[k], hh); y2 = s2[rr][2 * k + hh] * PR(cv[k], hh) + y2; } }
                y[rr] = y2.x + y2.y; }
#pragma unroll
            for (int rr = 0; rr < 4; ++rr) y[rr] = red8(y[rr]);
            if (ng == 0) *(LAS f32x4*)(OUTS + (sg * TQ + i) * 64 + pg * 4) = (f32x4){y[0], y[1], y[2], y[3]};
        }
        wg_sync();
        { const int cq = c.tid >> 7, i = (c.tid >> 4) & 7, c4 = (c.tid & 15) * 4; int b, h, d; chain_of(cq, b, h, d); const int st = blk * TQ + i, row = b * SEQ + (d ? T - 1 - st : st);
          const f32x4 v = *(const LAS f32x4*)(OUTS + (cq * TQ + i) * 64 + c4); u32x2 w; w.x = pk2(v.x, v.y); w.y = pk2(v.z, v.w); *(u32x2*)(Y + ((size_t)d * M + row) * SW + h * 64 + c4) = w; }
        if (blk + 1 < nblk) lstore(buf ^ 1);
        wg_sync();
    }
    { int b, h, d; chain_of(sg, b, h, d);
#pragma unroll
      for (int rr = 0; rr < 4; ++rr) { float* o = c.out() + OUT_SSD + (((((size_t)b * DEPTH + l) * 2 + d) * SH + h) * 64 + pg * 4 + rr) * SN + ng * 16;
#pragma unroll
          for (int k = 0; k < 4; ++k) *(f32x4*)(o + 4 * k) = (f32x4){s2[rr][2 * k].x, s2[rr][2 * k].y, s2[rr][2 * k + 1].x, s2[rr][2 * k + 1].y}; } }
}
struct PoolSpan { int i0, i1; };
DEV PoolSpan pool_span(long lo, long hi, long base, int n, long cost) { PoolSpan s; s.i0 = cdiv_pos(lo - base, cost); s.i1 = cdiv_pos(hi - base, cost); if (s.i0 > n) s.i0 = n; if (s.i1 > n) s.i1 = n; return s; }
#ifndef CONV_CF0
#define CONV_CF0 80
#endif
#ifndef CONV_CF1
#define CONV_CF1 44
#endif
DEV int wq_pull(const Ctx& c, unsigned* head) {
    volatile LAS unsigned* slot = (volatile LAS unsigned*)(c.lds + LDS_MISC) + 4;
    if (c.tid == 0) {
#ifdef CPU_EMU
        *slot = (*head)++;
#else
        *slot = __hip_atomic_fetch_add(head, 1u, __ATOMIC_RELAXED, __HIP_MEMORY_SCOPE_AGENT);
#endif
    }
    wg_sync(); const int it = (int)*slot; wg_sync(); return it;
}
DEV void phase_conv_early(const Ctx& c, int l) {
    LAS float* scr = (LAS float*)(c.lds + c.wave * 16640); unsigned* head = (unsigned*)(c.a->ws + WS_CTL) + 8192 + 256 * 2 * DEPTH;
    constexpr int nchunk = (CONV_NE + 63) / 64;
    for (int ch = wq_pull(c, head); ch < nchunk; ch = wq_pull(c, head)) { for (int k = 0; k < 8; ++k) { const int r = ch * 64 + k * 8 + c.wave; if (r < CONV_NE) conv_one(c, l, false, r, scr); } wg_sync(); }
}
DEV void phase_scan(const Ctx& c, int l) {
    for (int rep = 0; rep < REP_RS; ++rep) {
        constexpr int NLR = DEC_BATCH * RH * 2, NQR = BATCH * RH * 2 / 4, NLS = DEC_BATCH * SH * 2, NCS4 = BATCH * SH * 2 / 4, NTOT = NLR + NQR + NLS + NCS4;
        (void)NTOT;
        unsigned* head = (unsigned*)(c.a->ws + WS_CTL) + 8192 + 256 * (l * 2 + rep);
        constexpr int CONV_CH = 64; const int nconv = CONV_NL + (l + 1 < DEPTH ? CONV_NE : 0), nchunk = (nconv + CONV_CH - 1) / CONV_CH;
        int ncf = l + 1 < DEPTH ? CONV_CF0 : CONV_CF1; if (ncf > c.G / 2) ncf = c.G / 2;
        LAS float* scr = (LAS float*)(c.lds + c.wave * 16640);
#define CONV_POOL() for (int ch = wq_pull(c, head + 192); ch < nchunk; ch = wq_pull(c, head + 192)) { \
            for (int k = 0; k < CONV_CH / NWAVES; ++k) { const int r = ch * CONV_CH + k * NWAVES + c.wave; if (r < nconv) { if (r < CONV_NL) conv_one(c, l, true, r, scr); else conv_one(c, l + 1, false, r - CONV_NL, scr); } } wg_sync(); }
        if (rep == 0 && c.bid >= c.G - ncf) { CONV_POOL() }
        for (int it = c.bid; it < NLR; it += c.G) rwkv_chain_h(c, l, it / (RH * 2), (it >> 1) % RH, it & 1);
        for (int it = wq_pull(c, head); it < NQR; it = wq_pull(c, head)) rwkv_quad(c, l, it);
        for (int it = wq_pull(c, head + 64); it < NLS; it = wq_pull(c, head + 64)) ssd_mfma_chain(c, l, true, it / (SH * 2), (it >> 1) % SH, it & 1);
        for (int it = wq_pull(c, head + 128); it < NCS4; it = wq_pull(c, head + 128)) {
#pragma unroll 1
            for (int k = 0; k < 4; ++k) { const int i = 4 * it + k; ssd_mfma_chain(c, l, false, i / (SH * 2), (i >> 1) % SH, i & 1); } }
        if (rep == 0) { CONV_POOL() }
#undef CONV_POOL
    }
    for (int rep = 0; rep < REP_S5; ++rep)
    {
        const Span2 sp = balanced_span(c.gw(), c.ngw(), DEC_BATCH * CG * 2, DEC_SEQ, BATCH * CG * 2, SEQ);
        for (int i = sp.a0; i < sp.a1; ++i) s5_carry(c, l, true, i / (CG * 2), (i >> 1) % CG, i & 1);
        for (int i = sp.b0; i < sp.b1; ++i) s5_carry(c, l, false, i / (CG * 2), (i >> 1) % CG, i & 1);
    }
}

DEV void phase_post(const Ctx& c, int l) {
    const bf16_t* XS = c.ws<bf16_t>(WS_XS); const bf16_t* O = c.ws<bf16_t>(WS_O); const bf16_t* GG = c.ws<bf16_t>(WS_GG);
    const bf16_t* XBC = c.ws<bf16_t>(WS_XBC); const bf16_t* ZB = c.ws<bf16_t>(WS_ZB); const bf16_t* YS = c.ws<bf16_t>(WS_YSSD);
    bf16_t* YA = c.ws<bf16_t>(WS_YA); bf16_t* YB = c.ws<bf16_t>(WS_YB);
    for (int it = c.gw(); it < 2 * M; it += c.ngw()) {
        if (it < M) {
            const int row = it; constexpr int NCH = RW / 8, NIT = (NCH + 63) / 64;
            struct PostLd { u32x4 o0, o1, r, k, v, g; };
            auto issue = [&](int i, PostLd& L) { const int ch = c.lane + 64 * i; const int col = ch < NCH ? 8 * ch : 0;
                L.o0 = ld8(O + (size_t)row * RW + col); L.o1 = ld8(O + ((size_t)M + row) * RW + col);
                L.r = ld8(XS + (size_t)row * 3 * RW + col); L.k = ld8(XS + (size_t)row * 3 * RW + RW + col); L.v = ld8(XS + (size_t)row * 3 * RW + 2 * RW + col); L.g = ld8(GG + (size_t)row * RW + col); };
            auto finish = [&](int i, const PostLd& L) {
                const int ch = c.lane + 64 * i; const bool act = ch < NCH; const int col = act ? 8 * ch : 0, h = col / 64;
                float o[8], t[8], r[8], k[8], v[8], g[8];
                unpack8(L.o0, o); unpack8(L.o1, t); unpack8(L.r, r); unpack8(L.k, k); unpack8(L.v, v); unpack8(L.g, g);
                const float* rk = c.in(I_RRK) + ((size_t)l * RH + h) * 64 + (col & 63); const float* lg = c.in(I_RLNG) + (size_t)l * RW + col; const float* lb = c.in(I_RLNB) + (size_t)l * RW + col;
                float sm = 0.f, bn = 0.f;
#pragma unroll
                for (int j = 0; j < 8; ++j) { o[j] += t[j]; sm += o[j]; bn += r[j] * k[j] * rk[j]; }
                const float mu = red8(sm) * (1.0f / 64.0f); bn = red8(bn); float vq = 0.f;
#pragma unroll
                for (int j = 0; j < 8; ++j) { o[j] -= mu; vq += o[j] * o[j]; }
                const float rstd = rsqrtf(red8(vq) * (1.0f / 64.0f) + RWKV_LN_EPS);
#pragma unroll
                for (int j = 0; j < 8; ++j) o[j] = (o[j] * rstd * lg[j] + lb[j] + bn * v[j]) * g[j];
                if (act) st8(YA + (size_t)row * RW + col, pack8(o)); };
            PostLd LA, LB; issue(0, LA);
#pragma unroll 1
            for (int i = 0; i < NIT; i += 2) {
                if (i + 1 < NIT) issue(i + 1, LB);
                finish(i, LA);
                if (i + 2 < NIT) issue(i + 2, LA);
                if (i + 1 < NIT) finish(i + 1, LB);
            }
        } else {
            const int row = it - M; constexpr int NCH = SW / 8, NIT = (NCH + 63) / 64; float y[NIT][8]; float ss = 0.f;
#pragma unroll
            for (int i = 0; i < NIT; ++i) {
                const int ch = c.lane + 64 * i; const bool act = ch < NCH; const int col = act ? 8 * ch : 0; float x[8], a[8], b[8], z[8];
                unpack8(ld8(XBC + (size_t)row * SXBC + col), x); unpack8(ld8(YS + (size_t)row * SW + col), a); unpack8(ld8(YS + ((size_t)M + row) * SW + col), b); unpack8(ld8(ZB + (size_t)row * ZB_LD + col), z);
                const float dsk = c.in(I_SD)[(size_t)l * SH + col / 64];
#pragma unroll
                for (int j = 0; j < 8; ++j) { const float v = act ? (dsk * x[j] + a[j] + b[j]) * siluf_(z[j]) : 0.f; y[i][j] = v; ss += v * v; }
            }
            const float rstd = rsqrtf(wave_sum(ss) * (1.0f / SW) + EPS);
#pragma unroll
            for (int i = 0; i < NIT; ++i) { const int ch = c.lane + 64 * i; if (ch < NCH) { const int col = 8 * ch; const float* g = c.in(I_SNG) + (size_t)l * SW + col; float o[8];
#pragma unroll
                for (int j = 0; j < 8; ++j) o[j] = y[i][j] * rstd * g[j];
                st8(YB + (size_t)row * SW + col, pack8(o)); } }
        }
    }
}

constexpr int PH_PER_LAYER = 18, NPH = 2 + DEPTH * PH_PER_LAYER;
template <class Epi> DEV void run_gemm(const Ctx& c, const bf16_t* A, const bf16_t* Bt, int N, int K, const Epi& E) {
#ifndef CPU_EMU
    asm volatile("" : "+s"(K));
#endif
    pg8::Gemm g{A, Bt, M, N, K}; pg8::StaticOrder S; S.init(M, N, c.G, c.bid);
    pg8::gemm_phase<Epi, pg8::StaticOrder, PG8_ALIGN, PG8_SP2>(c.lds, c.tid, g, S, E);
}
template <class Epi, int NT> DEV void run_gemm_batched(const Ctx& c, const bf16_t* A, const bf16_t* Bt, int K, const Epi& E) {
#ifndef CPU_EMU
    asm volatile("" : "+s"(K));
#endif
    pg8::Gemm g{A, Bt, 0, 0, K}; BatchOrder<NT> S{c.G, c.bid};
    pg8::gemm_phase<Epi, BatchOrder<NT>, PG8_ALIGN, PG8_SP2>(c.lds, c.tid, g, S, E);
}
template <class Epi> DEV void run_gemm_projc(const Ctx& c, const bf16_t* A, const bf16_t* Bt, int K, const Epi& E) {
#ifndef CPU_EMU
    asm volatile("" : "+s"(K));
#endif
    pg8::Gemm g{A, Bt, M, 2 * D, K}; ProjCOrder S; S.base.init(M, D, c.G, c.bid);
    pg8::gemm_phase<Epi, ProjCOrder, PG8_ALIGN, PG8_SP2>(c.lds, c.tid, g, S, E);
}
template <class Epi> DEV void run_gemm_norm(const Ctx& c, const bf16_t* A, const bf16_t* Bt, int K, const Epi& E) {
#ifndef CPU_EMU
    asm volatile("" : "+s"(K));
    static_assert(PG8_ALIGN && M / 256 == 64 && D / 256 == 8, "fused norm: aligned epilogue, 64 x 8 units");
    pg8::Gemm g{A, Bt, M, D, K}; PanelOrder S{c.G, c.bid};
    pg8::gemm_phase<Epi, PanelOrder, PG8_ALIGN, PG8_SP2>(c.lds, c.tid, g, S, E);
#else
    pg8::Gemm g{A, Bt, M, D, K}; pg8::StaticOrder S; S.init(M, D, c.G, c.bid);
    pg8::gemm_phase<Epi, pg8::StaticOrder, PG8_ALIGN, PG8_SP2>(c.lds, c.tid, g, S, E);
#endif
}
#define NORM_CNT(l, j) ((unsigned*)(c.a->ws + WS_CTL) + CTL_NORM_CNT + (size_t)((l) * 3 + (j)) * 4096)
#define NORM_SLOTS() ((float*)(c.a->ws + WS_CTL) + CTL_NORM_SLOTS)
#ifdef CPU_EMU
#define GRID_BAR() do {} while (0)
#else
#define GRID_BAR() xcd_barrier(bar)
#endif
#ifdef CPU_EMU
inline void mega_body(const Args& args, unsigned char* lds_base)
#else
__global__ void __launch_bounds__(NTHREADS, 2) mega_fwd(Args args)
#endif
{
#ifndef CPU_EMU
    extern __shared__ __attribute__((aligned(16))) unsigned char lds_base[];
#endif
#ifndef CPU_EMU
    volatile LAS unsigned* MISC = (volatile LAS unsigned*)((LAS unsigned char*)lds_base + LDS_MISC);
    if (threadIdx.x < 16) MISC[threadIdx.x] = 0u;
    __syncthreads();
    XcdBarrier bar = xcd_barrier_post((unsigned*)(args.ws + WS_CTL) + 4096, MISC + 8);
    const int wave_s = __builtin_amdgcn_readfirstlane(threadIdx.x >> 6);
#define MKCTX() Ctx c; { const Args CAS* ap_ = (const Args CAS*)__builtin_amdgcn_kernarg_segment_ptr(); asm volatile("" : "+s"(ap_)); int tid_ = wave_s * 64 + (int)__builtin_amdgcn_mbcnt_hi(~0u, __builtin_amdgcn_mbcnt_lo(~0u, 0u)); asm volatile("" : "+v"(tid_)); \
        c.a = ap_; c.lds = (LAS unsigned char*)lds_base; c.tid = tid_; c.lane = tid_ & 63; c.wave = RFL(tid_ >> 6); c.bid = blockIdx.x; c.G = gridDim.x; }
#else
#define MKCTX() Ctx c; c.a = &args; c.lds = lds_base; c.tid = threadIdx.x; c.lane = c.tid & 63; c.wave = c.tid >> 6; c.bid = blockIdx.x; c.G = gridDim.x;
#endif
    const int lo = args.ph_lo, hi = args.ph_hi;
#ifndef PHMASK
#define PHMASK 0xFFFFFu
#endif
#define PHON(j) (((PHMASK) >> (j)) & 1u)
#define IN(k) (lo <= (k) && (k) < hi)
#define SEAM(k) do { if (IN((k) + 1)) GRID_BAR(); } while (0)
    if (PHON(18) && IN(0)) { { MKCTX(); for (int it = c.G - 1 - c.bid; it < DEPTH * CG; it += c.G) s5_build(c, it / CG, it % CG); } { MKCTX(); for (int rep = 0; rep < REP_CONV; ++rep) phase_pro(c); } { MKCTX(); phase_conv_early(c, 0); } SEAM(0); }
#define MOD_L(l) const float* mod = c.ws<float>(WS_MOD) + (size_t)(l) * NCOND * NMOD * D; (void)mod
#ifndef LRSEL
#define LRSEL 7
#endif
#define LAYER_BODY(l) { const int pb = 1 + (l) * PH_PER_LAYER; \
        if ((l) == 0 && PHON(0) && IN(pb + 0)) { { MKCTX(); phase_norm(c, l, 0); } SEAM(pb + 0); } \
        if (PHON(2) && IN(pb + 2)) { MKCTX(); MOD_L(l); run_gemm(c, c.ws<bf16_t>(WS_H), c.ws<bf16_t>(WS_FIT), 2 * FF, D, EpiSwiglu{c.ws<bf16_t>(WS_ACT)}); SEAM(pb + 2); } \
        if (PHON(3) && IN(pb + 3)) { MKCTX(); MOD_L(l); run_gemm_norm(c, c.ws<bf16_t>(WS_ACT), c.ws<bf16_t>(WS_FOT), FF, EpiResidNorm<false, true, (l) == 0>{c.ws<bf16_t>(WS_X), mod + 2 * D, c.in(I_NORMG) + (size_t)((l) * 3 + 1) * D, mod + 3 * D, c.ws<bf16_t>(WS_H), nullptr, NORM_SLOTS(), NORM_CNT(l, 0), c.lds, c.in(I_XP), c.in(I_XS)}); SEAM(pb + 3); } \
        if (PHON(5) && IN(pb + 5)) { { MKCTX(); run_gemm(c, c.ws<bf16_t>(WS_H), c.ws<bf16_t>(WS_WIT), RCOLS + ZB_LD, D, EpiZ{c.ws<bf16_t>(WS_ZA), c.ws<bf16_t>(WS_ZB)}); } { MKCTX(); run_gemm(c, c.ws<bf16_t>(WS_H), c.ws<bf16_t>(WS_WIT) + (size_t)(RCOLS + ZB_LD) * D, CW, D, EpiZC{c.ws<bf16_t>(WS_UG)}); } SEAM(pb + 5); } \
        if (PHON(6) && IN(pb + 6)) { MKCTX(); MOD_L(l); for (int rep = 0; rep < REP_ELT; ++rep) phase_prep(c, l); SEAM(pb + 6); } \
        if (PHON(7) && IN(pb + 7)) { \
            if (LRSEL & 1) { MKCTX(); run_gemm(c, c.ws<bf16_t>(WS_LRI), c.ws<bf16_t>(WS_LRT), 2 * RW, 256, EpiLRw{c.ws<bf16_t>(WS_OMD), c.in(I_RW0) + (size_t)l * 2 * RW}); } \
            if (LRSEL & 2) { MKCTX(); run_gemm(c, c.ws<bf16_t>(WS_LRI), c.ws<bf16_t>(WS_LRT) + (size_t)2 * RW * 256, 2 * RW, 256, \
                     EpiLRa{c.ws<bf16_t>(WS_KD), c.ws<bf16_t>(WS_BB), c.ws<bf16_t>(WS_XS), c.ws<bf16_t>(WS_KK), c.in(I_RA0) + (size_t)l * 2 * RW, c.in(I_RKA) + (size_t)l * RW}); } \
            if (LRSEL & 4) { MKCTX(); run_gemm(c, c.ws<bf16_t>(WS_LRI), c.ws<bf16_t>(WS_LRT) + (size_t)4 * RW * 256, RW, 256, EpiLRg{c.ws<bf16_t>(WS_GG)}); } \
            { MKCTX(); run_gemm_batched<EpiS5a, S5NT1>(c, c.ws<bf16_t>(WS_UG), c.ws<bf16_t>(WS_S5W + (size_t)(l) * S5W_L), S5K, EpiS5a{c.ws<bf16_t>(WS_YL), c.ws<float>(WS_SE)}); } \
            SEAM(pb + 7); } \
        if (PHON(8) && IN(pb + 8)) { MKCTX(); MOD_L(l); phase_scan(c, l); SEAM(pb + 8); } \
        if (PHON(9) && IN(pb + 9)) { { MKCTX(); MOD_L(l); for (int rep = 0; rep < REP_ELT; ++rep) phase_post(c, l); } { MKCTX(); run_gemm_batched<EpiS5b, S5NT2>(c, c.ws<bf16_t>(WS_SIN), c.ws<bf16_t>(WS_S5F + (size_t)(l) * S5F_L), 256, EpiS5b{c.ws<bf16_t>(WS_YL), c.ws<bf16_t>(WS_UG), c.ws<bf16_t>(WS_YC), c.in(I_CD) + (size_t)(l) * CW}); } { MKCTX(); run_gemm(c, c.ws<bf16_t>(WS_H), c.ws<bf16_t>(WS_WIT) + (size_t)NZ_MIX * D, 3 * D, D, EpiGate{c.ws<gate8_t>(WS_ZG)}); } SEAM(pb + 9); } \
        if (PHON(11) && IN(pb + 11)) { { MKCTX(); run_gemm(c, c.ws<bf16_t>(WS_YA), c.ws<bf16_t>(WS_PAT), D, RW, EpiProjAB<true>{c.ws<bf16_t>(WS_MRG), c.ws<gate8_t>(WS_ZG), 0}); } \
            { MKCTX(); run_gemm(c, c.ws<bf16_t>(WS_YB), c.ws<bf16_t>(WS_PBT), D, SW, EpiProjAB<false>{c.ws<bf16_t>(WS_MRG), c.ws<gate8_t>(WS_ZG), D}); } \
            { MKCTX(); run_gemm_projc(c, c.ws<bf16_t>(WS_YC), c.ws<bf16_t>(WS_PCT), CW, EpiProjC{c.ws<bf16_t>(WS_MRG), c.ws<bf16_t>(WS_MRGB), c.ws<gate8_t>(WS_ZG)}); } SEAM(pb + 11); } \
        if (PHON(14) && IN(pb + 14)) { MKCTX(); MOD_L(l); run_gemm_norm(c, c.ws<bf16_t>(WS_MRGB), c.ws<bf16_t>(WS_WOT), D, EpiResidNorm<false, false>{c.ws<bf16_t>(WS_X), mod + 5 * D, c.in(I_NORMG) + (size_t)((l) * 3 + 2) * D, mod + 6 * D, c.ws<bf16_t>(WS_H3), nullptr, NORM_SLOTS(), NORM_CNT(l, 1), c.lds, nullptr, nullptr}); SEAM(pb + 14); } \
        if (PHON(16) && IN(pb + 16)) { MKCTX(); MOD_L(l); run_gemm(c, c.ws<bf16_t>(WS_H3), c.ws<bf16_t>(WS_FIT) + (size_t)2 * FF * D, 2 * FF, D, EpiSwiglu{c.ws<bf16_t>(WS_ACT)}); SEAM(pb + 16); } \
        if (PHON(17) && IN(pb + 17)) { MKCTX(); MOD_L(l); \
            if ((l) + 1 < DEPTH) { run_gemm_norm(c, c.ws<bf16_t>(WS_ACT), c.ws<bf16_t>(WS_FOT) + (size_t)D * FF, FF, EpiResidNorm<false, true>{c.ws<bf16_t>(WS_X), mod + 8 * D, c.in(I_NORMG) + (size_t)(((l) + 1) * 3) * D, mod + (size_t)NCOND * NMOD * D, c.ws<bf16_t>(WS_H), nullptr, NORM_SLOTS(), NORM_CNT(l, 2), c.lds, nullptr, nullptr}); SEAM(pb + 17); } \
            else run_gemm_norm(c, c.ws<bf16_t>(WS_ACT), c.ws<bf16_t>(WS_FOT) + (size_t)D * FF, FF, EpiResidNorm<true, true>{c.ws<bf16_t>(WS_X), mod + 8 * D, c.in(I_FNG), nullptr, nullptr, c.out() + OUT_Y, NORM_SLOTS(), NORM_CNT(l, 2), c.lds, nullptr, nullptr}); } }
    LAYER_BODY(0)
    LAYER_BODY(1)
    static_assert(DEPTH == 2, "two layer bodies written out");
#undef IN
#undef SEAM
}

#ifndef CPU_EMU
#ifndef MK_PER_PHASE
#define MK_PER_PHASE 0
#endif
extern "C" void kernel_launch(void* const* d_in, const int* in_sizes, int n_in, void* d_out, int out_size, void* d_ws, size_t ws_size, hipStream_t stream) {
    static int grid = 0;
    if (grid == 0) {
        if (n_in != N_IN || (size_t)out_size != OUT_END || ws_size < WS_END) { fprintf(stderr, "kernel_launch: shape mismatch: n_in %d out %d ws %zu (need %zu)\n", n_in, out_size, ws_size, (size_t)WS_END); grid = -1; return; }
        int dev = 0, cus = 0, per_cu = 0;
        if (hipGetDevice(&dev) != hipSuccess || hipDeviceGetAttribute(&cus, hipDeviceAttributeMultiprocessorCount, dev) != hipSuccess) { grid = -1; return; }
        if (hipFuncSetAttribute((const void*)mega_fwd, hipFuncAttributeMaxDynamicSharedMemorySize, LDS_BYTES) != hipSuccess) { fprintf(stderr, "kernel_launch: hipFuncSetAttribute failed\n"); grid = -1; return; }
        if (hipOccupancyMaxActiveBlocksPerMultiprocessor(&per_cu, (const void*)mega_fwd, NTHREADS, LDS_BYTES) != hipSuccess || per_cu < 1) fprintf(stderr, "kernel_launch: occupancy query reports %d\n", per_cu);
        (void)hipGetLastError();
        grid = cus;
    }
    if (grid < 0) return;
    (void)hipMemsetAsync((char*)d_ws + WS_CTL, 0, CTL_BYTES, stream);
    Args a{};
    for (int i = 0; i < N_IN; ++i) a.in[i] = (const float*)d_in[i];
    a.out = (float*)d_out; a.ws = (unsigned char*)d_ws;
#if MK_PER_PHASE
    for (int p = 0; p < NPH; ++p) { a.ph_lo = p; a.ph_hi = p + 1; hipLaunchKernelGGL(mega_fwd, dim3(grid), dim3(NTHREADS), LDS_BYTES, stream, a); }
#else
    a.ph_lo = 0; a.ph_hi = NPH;
    hipLaunchKernelGGL(mega_fwd, dim3(grid), dim3(NTHREADS), LDS_BYTES, stream, a);
#endif
    const hipError_t le = hipPeekAtLastError();
    if (le != hipSuccess) fprintf(stderr, "kernel_launch: launch failed: %s\n", hipGetErrorName(le));
}
#endif
```

```cpp
#ifndef CPU_EMU
#include <hip/hip_runtime.h>
#endif
#include <cstdio>
#include <cstdint>
#include <cmath>

#ifdef CFG_SMALL
constexpr int D = 512, BATCH = 2, SEQ = 128, DEC_BATCH = 2, DEC_SEQ = 256, RW = 256, SW = 256, CW = 256, FF = 384;
#else
constexpr int D = 2048, BATCH = 32, SEQ = 256, DEC_BATCH = 4, DEC_SEQ = 2048, RW = 1024, SW = 1024, CW = 1024, FF = 5504;
#endif
constexpr int DEPTH = 2, GRID_W = 64, NMOD = 9;
#ifndef REP_S5
#define REP_S5 1
#endif
#ifndef REP_RS
#define REP_RS 1
#endif
#ifndef REP_CONV
#define REP_CONV 1
#endif
#ifndef REP_ELT
#define REP_ELT 1
#endif
constexpr int RH = RW / 64, RCOLS = 3 * RW + 256;
constexpr int SH = SW / 64, SG = 2, SN = 128, SXBC = SW + 2 * SG * SN, SCOLS = SW + SXBC + SH, SHG = SH / SG;
constexpr int CG = CW / 16, CP = 64;
constexpr int DIN = RCOLS + SCOLS + CW + 3 * D;
constexpr int MC = BATCH * SEQ, ML = DEC_BATCH * DEC_SEQ, M = MC + ML, NCOND = 1 + DEC_BATCH;
constexpr int ZB_LD = ((SCOLS + 255) / 256) * 256;
constexpr int NZ_MIX = RCOLS + ZB_LD + CW, NZ = NZ_MIX + 3 * D;
constexpr int LRN = 5 * RW;
constexpr float EPS = 1e-6f, RWKV_LN_EPS = 64e-5f;
constexpr int S5L = 32, S5K = S5L * 16, S5N1 = S5K + 256, MCH = ((M / S5L + 255) / 256) * 256, S5MT = MCH / 256, S5NT1 = S5N1 / 256, S5NT2 = S5K / 256;
static_assert(S5K % 256 == 0 && SEQ % S5L == 0 && DEC_SEQ % S5L == 0 && M % S5L == 0, "s5 chunking");
static_assert(RCOLS % 256 == 0 && CW % 256 == 0 && D % 256 == 0 && FF % 128 == 0 && MC % 256 == 0 && ML % 256 == 0 && DEC_SEQ % 256 == 0 && LRN % 256 == 0, "tile shapes");
static_assert(RW % 256 == 0 && SW % 256 == 0 && DEC_SEQ % GRID_W == 0 && SHG >= 1, "shapes");

enum In { I_XP = 0, I_XS, I_SRWKV, I_SSSD, I_SRE, I_SIM, I_C, I_CCTX, I_WMOD, I_BMOD, I_NORMG, I_FWIN, I_FWOUT, I_WIN, I_RMU, I_RW0, I_RW2, I_RA0, I_RA2, I_RG2,
          I_RKK, I_RKA, I_RRK, I_RLNG, I_RLNB, I_PA, I_SCW, I_SCB, I_SDTB, I_SALOG, I_SD, I_SNG, I_PB, I_CLRE, I_CLIM, I_CLDT, I_CBRE, I_CBIM, I_CCRE, I_CCIM, I_CD, I_PC, I_WOUT, I_FNG, N_IN };
static_assert(N_IN == 44, "44 inputs");

constexpr size_t OUT_Y = 0;
constexpr size_t OUT_RWKV = (size_t)M * D;
constexpr size_t OUT_SSD = OUT_RWKV + (size_t)BATCH * DEPTH * 2 * RH * 64 * 64;
constexpr size_t OUT_RE = OUT_SSD + (size_t)BATCH * DEPTH * 2 * SH * 64 * SN;
constexpr size_t OUT_IM = OUT_RE + (size_t)BATCH * DEPTH * 2 * CG * CP;
constexpr size_t OUT_END = OUT_IM + (size_t)BATCH * DEPTH * 2 * CG * CP;

constexpr size_t al256(size_t x) { return (x + 255) & ~(size_t)255; }
constexpr size_t WS_CTL = 0, CTL_BYTES = 1u << 20;
constexpr size_t WS_MOD = WS_CTL + CTL_BYTES;
constexpr size_t WS_X = al256(WS_MOD + (size_t)DEPTH * NCOND * NMOD * D * 4);
constexpr size_t WS_H = al256(WS_X + (size_t)M * D * 2);
constexpr size_t WS_FIT = al256(WS_H + (size_t)M * D * 2);
constexpr size_t WS_FOT = al256(WS_FIT + (size_t)2 * 2 * FF * D * 2);
constexpr size_t WS_WIT = al256(WS_FOT + (size_t)2 * D * FF * 2);
constexpr size_t WS_PAT = al256(WS_WIT + (size_t)NZ * D * 2);
constexpr size_t WS_PBT = al256(WS_PAT + (size_t)D * RW * 2);
constexpr size_t WS_PCT = al256(WS_PBT + (size_t)D * SW * 2);
constexpr size_t WS_WOT = al256(WS_PCT + (size_t)2 * D * CW * 2);
constexpr size_t WS_LRT = al256(WS_WOT + (size_t)D * D * 2);
constexpr size_t WS_ZA = al256(WS_LRT + (size_t)LRN * 256 * 2);
constexpr size_t WS_ZB = al256(WS_ZA + (size_t)M * RCOLS * 2);
constexpr size_t WS_UG = al256(WS_ZB + (size_t)M * ZB_LD * 2);
constexpr size_t WS_XS = al256(WS_UG + (size_t)CG * MCH * S5K * 2);
constexpr size_t WS_KK = WS_XS + (size_t)M * 3 * RW * 2;
constexpr size_t WS_LRI = al256(WS_KK + (size_t)M * RW * 2);
constexpr size_t WS_XBC = al256(WS_LRI + (size_t)M * 256 * 2);
constexpr size_t WS_DT = al256(WS_XBC + (size_t)M * SXBC * 2);
constexpr size_t WS_OMD = al256(WS_DT + (size_t)2 * M * SH * 4);
constexpr size_t WS_KD = WS_OMD + (size_t)2 * M * RW * 2;
constexpr size_t WS_BB = WS_KD + (size_t)2 * M * RW * 2;
constexpr size_t WS_GG = al256(WS_BB + (size_t)2 * M * RW * 2);
constexpr size_t WS_O = al256(WS_GG + (size_t)M * RW * 2);
constexpr size_t WS_YSSD = al256(WS_O + (size_t)2 * M * RW * 2);
constexpr size_t S5W_L = (size_t)CG * S5N1 * S5K * 2, S5F_L = (size_t)CG * S5K * 256 * 2;
constexpr size_t WS_S5W = al256(WS_YSSD + (size_t)2 * M * SW * 2);
constexpr size_t WS_S5F = al256(WS_S5W + DEPTH * S5W_L);
constexpr size_t WS_YL = al256(WS_S5F + DEPTH * S5F_L);
constexpr size_t WS_SE = al256(WS_YL + (size_t)CG * MCH * S5K * 2);
constexpr size_t WS_SIN = al256(WS_SE + (size_t)CG * MCH * 256 * 4);
constexpr size_t WS_END = al256(WS_SIN + (size_t)CG * MCH * 256 * 2);
constexpr size_t WS_ACT = WS_ZA;
constexpr size_t WS_YA = WS_ZA, WS_YB = WS_YA + (size_t)M * RW * 2, WS_YC = WS_YB + (size_t)M * SW * 2;
constexpr size_t WS_MRG = WS_XS, WS_MRGB = WS_H, WS_ZG = WS_OMD;
constexpr size_t WS_H3 = WS_MRG;
static_assert((size_t)M * FF * 2 <= WS_UG - WS_ZA, "ACT overlay");
static_assert((size_t)M * (RW + SW + CW) * 2 <= WS_ZB - WS_ZA || RW + SW + CW <= RCOLS, "Y overlay");
static_assert((size_t)M * D * 4 <= WS_LRI - WS_XS, "MRG overlay");
static_assert((size_t)M * 3 * D * 2 <= WS_GG - WS_OMD, "ZG overlay");
static_assert(WS_KK % 16 == 0 && WS_KD % 16 == 0 && WS_BB % 16 == 0 && WS_YB % 16 == 0 && WS_YC % 16 == 0, "alignment");
#ifndef CFG_SMALL
static_assert(WS_END <= 1442840576ull, "workspace budget (4 x largest input)");
#endif

#ifdef CPU_EMU
#define GAS
#define LAS
#define CAS
#define DEV inline
#define VM_WAIT() do {} while (0)
#define LDS_WAIT() do {} while (0)
#define CFENCE() do {} while (0)
static inline float __uint_as_float(unsigned u) { float f; memcpy(&f, &u, 4); return f; }
static inline unsigned __float_as_uint(float f) { unsigned u; memcpy(&u, &f, 4); return u; }
#define RFL(x) (x)
#define WAVE_SYNC() emu::wave_barrier()
#else
#define GAS __attribute__((address_space(1)))
#define LAS __attribute__((address_space(3)))
#define CAS __attribute__((address_space(4)))
#define DEV __device__ __forceinline__
#define VM_WAIT() asm volatile("s_waitcnt vmcnt(0)" ::: "memory")
#define LDS_WAIT() asm volatile("s_waitcnt lgkmcnt(0)" ::: "memory")
#define CFENCE() asm volatile("" ::: "memory")
#define RFL(x) __builtin_amdgcn_readfirstlane(x)
#define WAVE_SYNC() __builtin_amdgcn_wave_barrier()
#endif
typedef unsigned short bf16_t;
typedef float f32x4 __attribute__((ext_vector_type(4)));
typedef float f32x2 __attribute__((ext_vector_type(2)));
typedef unsigned u32x4 __attribute__((ext_vector_type(4)));
typedef unsigned u32x2 __attribute__((ext_vector_type(2)));
typedef short bf16x8 __attribute__((ext_vector_type(8)));
constexpr int NWAVES = 8, NTHREADS = 512, LDS_MAIN_BYTES = 131072;

#ifdef CPU_EMU
DEV unsigned f2bf(float f) { unsigned u = __float_as_uint(f); return (u + 0x7fffu + ((u >> 16) & 1u)) >> 16; }
DEV unsigned pk2(float lo, float hi) { return f2bf(lo) | (f2bf(hi) << 16); }
#else
typedef __bf16 hwbf16x2 __attribute__((ext_vector_type(2)));
typedef float hwf32x2 __attribute__((ext_vector_type(2)));
DEV unsigned pk2(float lo, float hi) { const hwbf16x2 v = __builtin_convertvector((hwf32x2){lo, hi}, hwbf16x2); return __builtin_bit_cast(unsigned, v); }
DEV unsigned f2bf(float f) { return (unsigned)__builtin_bit_cast(unsigned short, (__bf16)f); }
#endif
DEV float bflo(unsigned w) { return __uint_as_float(w << 16); }
DEV float bfhi(unsigned w) { return __uint_as_float(w & 0xffff0000u); }
DEV float bf1(bf16_t h) { return __uint_as_float(((unsigned)h) << 16); }
DEV void unpack8(const u32x4 v, float (&f)[8]) { f[0] = bflo(v.x); f[1] = bfhi(v.x); f[2] = bflo(v.y); f[3] = bfhi(v.y); f[4] = bflo(v.z); f[5] = bfhi(v.z); f[6] = bflo(v.w); f[7] = bfhi(v.w); }
DEV u32x4 pack8(const float (&f)[8]) { u32x4 o; o.x = pk2(f[0], f[1]); o.y = pk2(f[2], f[3]); o.z = pk2(f[4], f[5]); o.w = pk2(f[6], f[7]); return o; }
DEV u32x4 ld8(const bf16_t* p) { return *(const u32x4*)p; }
DEV void st8(bf16_t* p, const u32x4 v) { *(u32x4*)p = v; }
#ifdef CPU_EMU
DEV float frcp_(float x) { return 1.0f / x; }
#else
DEV float frcp_(float x) { return __builtin_amdgcn_rcpf(x); }
#endif
DEV float sigmoidf_(float x) { return frcp_(1.0f + __expf(-x)); }
DEV float siluf_(float x) { return x * sigmoidf_(x); }
DEV float softplusf_(float x) { return x > 20.f ? x : log1pf(expf(x)); }
DEV float geluf_(float x) { const float u = 0.7978845608028654f * (x + 0.044715f * x * x * x); return x * sigmoidf_(2.0f * u); }
DEV float wave_sum(float v) {
#pragma unroll
    for (int o = 1; o < 64; o <<= 1) v += __shfl_xor(v, o);
    return v;
}
#ifdef CPU_EMU
template <int MASK> DEV float xor_dpp(float v) { return __shfl_xor(v, MASK); }
DEV float red8(float v) { v += __shfl_xor(v, 1); v += __shfl_xor(v, 2); v += __shfl_xor(v, 4); return v; }
#else
template <int CTRL, int BANK> DEV float dpp_mov(float old, float v) {
    if constexpr (BANK == 0xF) return __builtin_bit_cast(float, __builtin_amdgcn_update_dpp(0, __builtin_bit_cast(int, v), CTRL, 0xF, 0xF, true));
    else return __builtin_bit_cast(float, __builtin_amdgcn_update_dpp(__builtin_bit_cast(int, old), __builtin_bit_cast(int, v), CTRL, 0xF, BANK, false)); }
template <int MASK> DEV float xor_dpp(float v) {
    if constexpr (MASK == 1) return dpp_mov<0xB1, 0xF>(v, v);
    else if constexpr (MASK == 2) return dpp_mov<0x4E, 0xF>(v, v);
    else if constexpr (MASK == 4) { float t = dpp_mov<0x104, 0x5>(v, v); return dpp_mov<0x114, 0xA>(t, v); }
    else { static_assert(MASK == 8, "xor_dpp mask"); return dpp_mov<0x128, 0xF>(v, v); }
}
DEV float red8(float v) { v += xor_dpp<1>(v); v += xor_dpp<2>(v); v += dpp_mov<0x141, 0xF>(v, v); return v; }
#endif
DEV int cond_of_row(int row) { return row < MC ? 0 : 1 + (row - MC) / DEC_SEQ; }

namespace pg8 {
#define PG8_LAS LAS
constexpr int BM = 256, BK = 64, HALF = 128, HTB = HALF * BK * 2, STAGE_BYTES = 8 * HTB, NXCD = 8, WGM = 8;
DEV int lds_byte(int r, int c) { const int st = (r >> 4) * 2 + (c >> 5), rr = r & 15, cc = c & 31, ob = rr * 64 + cc * 2; return st * 1024 + (ob ^ (((ob >> 9) & 1) << 5)); }
DEV void stage_rc(int b, int& R, int& C) { const int st = b / 1024, sb = b % 1024, swz = sb ^ (((sb >> 9) & 1) << 5); R = (st >> 1) * 16 + swz / 64; C = (st & 1) * 32 + (swz % 64) / 2; }
DEV int perm32(int rho) { const int n = rho >> 4, i = rho & 15; return 8 * (i >> 2) + 4 * n + (i & 3); }
struct Unit { int pm, pn; };
struct Gemm { const bf16_t* A; const bf16_t* Bt; int M, N, K; };
struct StaticOrder {
    int nM, nN, nwg, G, c;
    DEV void init(int M_, int N_, int G_, int c_) { nM = M_ / BM; nN = N_ / BM; nwg = nM * nN; G = G_; c = c_; }
    DEV bool next(int i, Unit& u) const {
        const long L = (long)i * G + c; if (L >= nwg) return false;
        int wgid = (int)L; { const int q = nwg / NXCD, r = nwg % NXCD, xcd = wgid % NXCD, off = wgid / NXCD; wgid = (xcd < r ? xcd * (q + 1) : r * (q + 1) + (xcd - r) * q) + off; }
        const int nig = WGM * nN, gid = wgid / nig, fm = gid * WGM, gsz = (nM - fm) < WGM ? (nM - fm) : WGM;
        u.pm = fm + ((wgid % nig) % gsz); u.pn = (wgid % nig) / gsz; return true;
    }
    DEV void a_ready(const Unit&) const {}
    DEV void done(const Unit&) const {}
};
#ifdef CPU_EMU
template <class Epi, class Sched, bool ALIGN_EPI = false, bool SP2 = false>
inline void gemm_phase(unsigned char* lds, const int tid, const Gemm g, const Sched& S, const Epi& E) {
    const int wid = tid >> 6, lane = tid & 63, wr = wid >> 2, wc = wid & 3, fr = lane & 15, fq = lane >> 4;
    Unit u;
    for (int i = 0; S.next(i, u); ++i) {
        f32x4 acc[2][2][4][2];
        for (int ai = 0; ai < 2; ++ai) for (int bj = 0; bj < 2; ++bj) for (int m = 0; m < 4; ++m) for (int n = 0; n < 2; ++n) for (int j = 0; j < 4; ++j) {
            const int row = 256 * u.pm + 128 * ai + 64 * wr + 16 * m + fr;
            const int col = 256 * u.pn + 128 * bj + 32 * wc + (Epi::PERM ? (8 * fq + 4 * n + j) : (16 * n + 4 * fq + j));
            const bf16_t* a = g.A + (size_t)row * g.K; const bf16_t* b = g.Bt + (size_t)col * g.K; float s = 0.f;
            for (int k = 0; k < g.K; ++k) s += bf1(a[k]) * bf1(b[k]);
            acc[ai][bj][m][n][j] = s;
        }
        E(acc, u, wr, wc, fr, fq);
    }
}
#else
template <class Epi, class Sched, bool ALIGN_EPI = false, bool SP2 = false>
__device__ __forceinline__ void gemm_phase(PG8_LAS unsigned char* lds, const int tid, const Gemm g, const Sched& S, const Epi& E) {
    const int wid = __builtin_amdgcn_readfirstlane(tid >> 6), lane = tid & 63, wr = wid >> 2, wc = wid & 3, fr = lane & 15, fq = lane >> 4;
    const int K = g.K, nt = K / BK;
    unsigned voffA[2], voffB[2];
#pragma unroll
    for (int i = 0; i < 2; ++i) { int R, C; stage_rc(tid * 16 + i * 8192, R, C); const int Rb = Epi::PERM ? ((R & ~31) + perm32(R & 31)) : R;
        voffA[i] = (unsigned)(R * K + C) * 2u; voffB[i] = (unsigned)(Rb * K + C) * 2u; }
    const size_t kstep = (size_t)(BK * 2);
    const size_t hstep = (size_t)HALF * K * 2;
    const size_t tstep = 2 * hstep;
    const unsigned ldsw = (unsigned)wid * 1024u;
    const int aoff = lds_byte(wr * 64 + fr, fq * 8), boff = lds_byte(wc * 32 + fr, fq * 8);
#define PG8_SA(b, h) (((b) * 2 + (h)) * HTB)
#define PG8_SB(b, h) ((4 + (b) * 2 + (h)) * HTB)
#define PG8_STAGE(bufoff, gbase, voff) do { _Pragma("unroll") for (int _i = 0; _i < 2; ++_i) \
        __builtin_amdgcn_global_load_lds((const unsigned*)((const char*)(gbase) + (voff)[_i]), (PG8_LAS unsigned*)(lds + (bufoff) + ldsw + _i * 8192), 16, 0, 0); } while (0)
#define PG8_LDA(dst, b, h) do { _Pragma("unroll") for (int m = 0; m < 4; ++m) _Pragma("unroll") for (int k = 0; k < 2; ++k) dst[m][k] = *(const PG8_LAS bf16x8*)(lds + PG8_SA(b, h) + aoff + m * 2048 + k * 1024); } while (0)
#define PG8_LDB(dst, b, h) do { _Pragma("unroll") for (int n = 0; n < 2; ++n) _Pragma("unroll") for (int k = 0; k < 2; ++k) dst[n][k] = *(const PG8_LAS bf16x8*)(lds + PG8_SB(b, h) + boff + n * 2048 + k * 1024); } while (0)
#define PG8_MMA(ai, bj, At, Bt) do { __builtin_amdgcn_s_setprio(1); _Pragma("unroll") for (int m = 0; m < 4; ++m) _Pragma("unroll") for (int n = 0; n < 2; ++n) _Pragma("unroll") for (int k = 0; k < 2; ++k) \
        acc[ai][bj][m][n] = __builtin_amdgcn_mfma_f32_16x16x32_bf16(Bt[n][k], At[m][k], acc[ai][bj][m][n], 0, 0, 0); __builtin_amdgcn_s_setprio(0); } while (0)
#define PG8_WAIT_V(n) asm volatile("s_waitcnt vmcnt(" #n ")" ::: "memory")
#define PG8_WAIT_L(n) asm volatile("s_waitcnt lgkmcnt(" #n ")" ::: "memory")
#define PG8_BAR __builtin_amdgcn_s_barrier()
#define PG8_SCHED __builtin_amdgcn_sched_barrier(0)
    Unit cur, nxt; int ui = 0;
    if (!S.next(0, cur)) return;
    f32x4 acc[2][2][4][2];
#pragma unroll
    for (int a = 0; a < 2; ++a)
#pragma unroll
        for (int b = 0; b < 2; ++b)
#pragma unroll
            for (int m = 0; m < 4; ++m)
#pragma unroll
                for (int n = 0; n < 2; ++n) acc[a][b][m][n] = (f32x4){0.f, 0.f, 0.f, 0.f};
    bf16x8 At[4][2], B0[2][2], B1[2][2];
    const char* cA = (const char*)g.A + (size_t)cur.pm * tstep; const char* cB = (const char*)g.Bt + (size_t)cur.pn * tstep;
    S.a_ready(cur);
    if constexpr (SP2) {
        PG8_STAGE(PG8_SB(0, 0), cB, voffB); PG8_STAGE(PG8_SB(0, 1), cB + hstep, voffB); PG8_STAGE(PG8_SA(0, 0), cA, voffA); PG8_STAGE(PG8_SA(0, 1), cA + hstep, voffA);
        if (wr == 1) PG8_BAR;
        PG8_WAIT_V(2); PG8_BAR;
        PG8_STAGE(PG8_SB(1, 0), cB + kstep, voffB); PG8_STAGE(PG8_SA(1, 0), cA + kstep, voffA); PG8_STAGE(PG8_SB(1, 1), cB + hstep + kstep, voffB);
        PG8_WAIT_V(6); PG8_BAR;
    } else {
        PG8_STAGE(PG8_SB(0, 0), cB, voffB); PG8_STAGE(PG8_SA(0, 0), cA, voffA); PG8_STAGE(PG8_SB(0, 1), cB + hstep, voffB); PG8_STAGE(PG8_SA(0, 1), cA + hstep, voffA);
        if (wr == 1) PG8_BAR;
        PG8_WAIT_V(4); PG8_BAR;
        PG8_STAGE(PG8_SB(1, 0), cB + kstep, voffB); PG8_STAGE(PG8_SA(1, 0), cA + kstep, voffA); PG8_STAGE(PG8_SB(1, 1), cB + hstep + kstep, voffB);
        PG8_WAIT_V(6); PG8_BAR;
    }
    for (;;) {
        const bool has_next = S.next(ui + 1, nxt);
        const char* nA = has_next ? (const char*)g.A + (size_t)nxt.pm * tstep : cA; const char* nB = has_next ? (const char*)g.Bt + (size_t)nxt.pn * tstep : cB;
        for (int t = 0; t < nt; t += 2) {
            const bool last = (t == nt - 2);
            const char* a1 = cA + (size_t)(t + 1) * kstep;
            const char* a2 = last ? nA : cA + (size_t)(t + 2) * kstep; const char* b2 = last ? nB : cB + (size_t)(t + 2) * kstep;
            const char* a3 = a2 + kstep; const char* b3 = b2 + kstep;
            if (last && has_next) S.a_ready(nxt);
            if constexpr (SP2) {
            PG8_LDB(B0, 0, 0); PG8_LDB(B1, 0, 1); PG8_SCHED; PG8_LDA(At, 0, 0); PG8_STAGE(PG8_SA(1, 1), a1 + hstep, voffA);
            PG8_WAIT_V(8); PG8_WAIT_L(0); PG8_BAR; PG8_MMA(0, 0, At, B0); PG8_MMA(0, 1, At, B1); PG8_BAR; PG8_SCHED;
            PG8_LDA(At, 0, 1); PG8_STAGE(PG8_SB(0, 0), b2, voffB); PG8_STAGE(PG8_SB(0, 1), b2 + hstep, voffB); PG8_STAGE(PG8_SA(0, 0), a2, voffA);
            PG8_WAIT_V(8); PG8_WAIT_L(0); PG8_BAR; PG8_MMA(1, 0, At, B0); PG8_MMA(1, 1, At, B1); PG8_BAR; PG8_SCHED;
            PG8_LDB(B0, 1, 0); PG8_LDB(B1, 1, 1); PG8_SCHED; PG8_LDA(At, 1, 0); PG8_STAGE(PG8_SA(0, 1), a2 + hstep, voffA);
            PG8_WAIT_V(8); PG8_WAIT_L(0); PG8_BAR; PG8_MMA(0, 0, At, B0); PG8_MMA(0, 1, At, B1); PG8_BAR; PG8_SCHED;
            PG8_LDA(At, 1, 1); PG8_STAGE(PG8_SB(1, 0), b3, voffB); PG8_STAGE(PG8_SB(1, 1), b3 + hstep, voffB); PG8_STAGE(PG8_SA(1, 0), a3, voffA);
            PG8_WAIT_V(8); PG8_WAIT_L(0); PG8_BAR; PG8_MMA(1, 0, At, B0); PG8_MMA(1, 1, At, B1); PG8_BAR; PG8_SCHED;
            } else {
            PG8_LDB(B0, 0, 0); PG8_SCHED; PG8_LDA(At, 0, 0); PG8_STAGE(PG8_SA(1, 1), a1 + hstep, voffA);
            PG8_WAIT_L(8); PG8_BAR; PG8_WAIT_L(0); PG8_MMA(0, 0, At, B0); PG8_BAR; PG8_SCHED;
            PG8_LDB(B1, 0, 1); PG8_STAGE(PG8_SB(0, 0), b2, voffB);
            PG8_BAR; PG8_WAIT_L(0); PG8_MMA(0, 1, At, B1); PG8_BAR;
            PG8_LDA(At, 0, 1); PG8_STAGE(PG8_SA(0, 0), a2, voffA);
            PG8_BAR; PG8_WAIT_L(0); PG8_MMA(1, 0, At, B0); PG8_BAR; PG8_SCHED;
            PG8_STAGE(PG8_SB(0, 1), b2 + hstep, voffB);
            PG8_WAIT_V(6); PG8_BAR; PG8_MMA(1, 1, At, B1); PG8_BAR;
            PG8_LDB(B0, 1, 0); PG8_SCHED; PG8_LDA(At, 1, 0); PG8_STAGE(PG8_SA(0, 1), a2 + hstep, voffA);
            PG8_WAIT_L(8); PG8_BAR; PG8_WAIT_L(0); PG8_MMA(0, 0, At, B0); PG8_BAR; PG8_SCHED;
            PG8_LDB(B1, 1, 1); PG8_STAGE(PG8_SB(1, 0), b3, voffB);
            PG8_BAR; PG8_WAIT_L(0); PG8_MMA(0, 1, At, B1); PG8_BAR;
            PG8_LDA(At, 1, 1); PG8_STAGE(PG8_SA(1, 0), a3, voffA);
            PG8_BAR; PG8_WAIT_L(0); PG8_MMA(1, 0, At, B0); PG8_BAR; PG8_SCHED;
            PG8_STAGE(PG8_SB(1, 1), b3 + hstep, voffB);
            PG8_WAIT_V(6); PG8_BAR; PG8_MMA(1, 1, At, B1); PG8_BAR;
            }
        }
        if constexpr (ALIGN_EPI) { if (wr == 0) PG8_BAR; }
        E(acc, cur, wr, wc, fr, fq); S.done(cur);
        if (!has_next) break;
#pragma unroll
        for (int a = 0; a < 2; ++a)
#pragma unroll
            for (int b = 0; b < 2; ++b)
#pragma unroll
                for (int m = 0; m < 4; ++m)
#pragma unroll
                    for (int n = 0; n < 2; ++n) acc[a][b][m][n] = (f32x4){0.f, 0.f, 0.f, 0.f};
        cur = nxt; cA = nA; cB = nB; ++ui;
        if constexpr (ALIGN_EPI) { if (wr == 1) PG8_BAR; }
    }
    PG8_WAIT_V(0);
    if constexpr (!ALIGN_EPI) { if (wr == 0) PG8_BAR; }
    PG8_BAR;
#undef PG8_SA
#undef PG8_SB
#undef PG8_STAGE
#undef PG8_LDA
#undef PG8_LDB
#undef PG8_MMA
#undef PG8_WAIT_V
#undef PG8_WAIT_L
#undef PG8_BAR
#undef PG8_SCHED
}
#endif
}
#ifndef PG8_SP2
#define PG8_SP2 true
#endif
#ifndef PG8_ALIGN
#define PG8_ALIGN true
#endif
DEV void wg_sync() { __syncthreads(); }
#define PR(v4, h) ((f32x2){(v4)[2 * (h)], (v4)[2 * (h) + 1]})
typedef f32x4 Acc[2][2][4][2];
#define UNROLL _Pragma("unroll")

#define EPI_ROWS(...) _Pragma("unroll") for (int ai = 0; ai < 2; ++ai) _Pragma("unroll") for (int m = 0; m < 4; ++m) { const int row = u.pm * 256 + ai * 128 + wr * 64 + m * 16 + fr; __VA_ARGS__ }

#define EPI_ROW_OF(ai, m) (u.pm * 256 + (ai) * 128 + wr * 64 + (m) * 16 + fr)
#define EPI_M(...) _Pragma("unroll") for (int m = 0; m < 4; ++m) { const int row = EPI_ROW_OF(ai, m); __VA_ARGS__ }
#define EPI_AI _Pragma("unroll") for (int ai = 0; ai < 2; ++ai)
struct EpiSwiglu {
    static constexpr bool PERM = true, AFTER_DRAIN = false;
    bf16_t* act;
    DEV void operator()(const Acc& acc, const pg8::Unit& u, int wr, int wc, int fr, int fq) const {
        const int col = u.pn * 128 + wc * 32 + 8 * fq;
        EPI_ROWS({ float o[8]; UNROLL for (int j = 0; j < 8; ++j) { const float gv = acc[ai][0][m][j >> 2][j & 3], uv = acc[ai][1][m][j >> 2][j & 3]; o[j] = siluf_(gv) * uv; }
            st8(act + (size_t)row * FF + col, pack8(o)); })
    }
};
struct EpiResid {
    static constexpr bool PERM = true, AFTER_DRAIN = false;
    float* X; const float* gate; float scale;
    DEV void operator()(const Acc& acc, const pg8::Unit& u, int wr, int wc, int fr, int fq) const {
        const int cidx = cond_of_row(u.pm * 256); UNROLL for (int bj = 0; bj < 2; ++bj) { const int col = u.pn * 256 + bj * 128 + wc * 32 + 8 * fq;
            const f32x4 g0 = *(const f32x4*)(gate + (size_t)cidx * NMOD * D + col) * scale, g1 = *(const f32x4*)(gate + (size_t)cidx * NMOD * D + col + 4) * scale;
            f32x4 x0[4], x1[4];
            EPI_AI { EPI_M({ const float* p = X + (size_t)row * D + col; x0[m] = *(const f32x4*)p; x1[m] = *(const f32x4*)(p + 4); }) EPI_M({ float* p = X + (size_t)row * D + col; *(f32x4*)p = x0[m] + g0 * acc[ai][bj][m][0]; *(f32x4*)(p + 4) = x1[m] + g1 * acc[ai][bj][m][1]; }) } }
    }
};
#ifdef CPU_EMU
static int emu_pass = 0;
#endif
constexpr int LDS_NORM_P = 131072, LDS_NORM_S = LDS_NORM_P + 4096;
constexpr size_t CTL_NORM_CNT = 16384, CTL_NORM_SLOTS = 131072;
template <bool FINAL, bool HALFSC, bool FIRSTX = false> struct EpiResidNorm {
    static constexpr bool PERM = true, AFTER_DRAIN = false; static constexpr float scale = HALFSC ? 0.5f : 1.0f;
    bf16_t* X; const float* gate;
    const float* ng; const float* msh;
    bf16_t* H; float* out;
    float* slots; unsigned* cnt; LAS unsigned char* lds; const float* xp; const float* xs;
    DEV void operator()(Acc& acc, const pg8::Unit& u_, int wr, int wc, int fr, int fq) const {
        pg8::Unit u = u_;
#ifndef CPU_EMU
        asm volatile("" : "+s"(u.pm), "+s"(u.pn));
#endif
        const int cidx = cond_of_row(u.pm * 256);
        UNROLL for (int bj = 0; bj < 2; ++bj) { const int col = u.pn * 256 + bj * 128 + wc * 32 + 8 * fq;
            const f32x4 g0 = *(const f32x4*)(gate + (size_t)cidx * NMOD * D + col) * scale, g1 = *(const f32x4*)(gate + (size_t)cidx * NMOD * D + col + 4) * scale;
            f32x4 x0[4], x1[4]; u32x4 xq[4];
#ifdef CPU_EMU
            const bool f32src = FIRSTX && emu_pass == 0;
#else
            constexpr bool f32src = FIRSTX;
#endif
            const float* Xin = u.pm * 256 < MC ? xp : xs - (size_t)MC * D;
            EPI_AI { EPI_M({ const unsigned eo = (unsigned)row * D + (unsigned)col; if (f32src) { x0[m] = *(const f32x4*)((const char*)Xin + eo * 4u); x1[m] = *(const f32x4*)((const char*)Xin + eo * 4u + 16u); } else xq[m] = *(const u32x4*)((const char*)X + eo * 2u); }) EPI_M({ (void)row;
                        f32x4 b0, b1; if (f32src) { b0 = x0[m]; b1 = x1[m]; } else { b0 = (f32x4){bflo(xq[m].x), bfhi(xq[m].x), bflo(xq[m].y), bfhi(xq[m].y)}; b1 = (f32x4){bflo(xq[m].z), bfhi(xq[m].z), bflo(xq[m].w), bfhi(xq[m].w)}; }
#ifdef CPU_EMU
                        const f32x4 a0 = emu_pass ? b0 : b0 + g0 * acc[ai][bj][m][0], a1 = emu_pass ? b1 : b1 + g1 * acc[ai][bj][m][1];
#else
                        const f32x4 a0 = b0 + g0 * acc[ai][bj][m][0], a1 = b1 + g1 * acc[ai][bj][m][1];
#endif
                        acc[ai][bj][m][0] = a0; acc[ai][bj][m][1] = a1;
#ifndef CPU_EMU
                        asm volatile("" : "+v"(acc[ai][bj][m][0]), "+v"(acc[ai][bj][m][1]));
#endif
                        }) CFENCE(); } }
        LAS float* P = (LAS float*)(lds + LDS_NORM_P); LAS float* S = (LAS float*)(lds + LDS_NORM_S);
        UNROLL for (int ai = 0; ai < 2; ++ai) UNROLL for (int m = 0; m < 4; ++m) { float s = 0.f;
            UNROLL for (int bj = 0; bj < 2; ++bj) UNROLL for (int n = 0; n < 2; ++n) { const f32x4 a = acc[ai][bj][m][n]; s += (a.x * a.x + a.y * a.y) + (a.z * a.z + a.w * a.w); }
            s += __shfl_xor(s, 16); s += __shfl_xor(s, 32); if (fq == 0) P[wc * 256 + ai * 128 + wr * 64 + m * 16 + fr] = s; }
        wg_sync();
        const int wid = wr * 4 + wc, t = wid * 64 + fq * 16 + fr;
        if (wid < 4) {
            const float s = (P[t] + P[256 + t]) + (P[512 + t] + P[768 + t]); float* slot = slots + ((size_t)u.pm * 256 + t) * 8 + u.pn;
#ifdef CPU_EMU
            *slot = s;
#else
            __hip_atomic_store((unsigned*)slot, __float_as_uint(s), __ATOMIC_RELAXED, __HIP_MEMORY_SCOPE_AGENT);
            VM_WAIT();
            if (fq * 16 + fr == 0) (void)__hip_atomic_fetch_add(cnt + 64 * u.pm, 1u, __ATOMIC_RELAXED, __HIP_MEMORY_SCOPE_AGENT);
#endif
        }
#ifdef CPU_EMU
        if (emu_pass == 0) {
            UNROLL for (int bj = 0; bj < 2; ++bj) { const int col = u.pn * 256 + bj * 128 + wc * 32 + 8 * fq; EPI_ROWS({ const f32x4 a0 = acc[ai][bj][m][0], a1 = acc[ai][bj][m][1]; float o[8] = {a0.x, a0.y, a0.z, a0.w, a1.x, a1.y, a1.z, a1.w}; st8(X + (size_t)row * D + col, pack8(o)); }) }
            wg_sync(); wg_sync(); return; }
#else
        if (wid == 0) {
            unsigned sp = 0u; while ((unsigned)RFL((int)__hip_atomic_load(cnt + 64 * u.pm, __ATOMIC_RELAXED, __HIP_MEMORY_SCOPE_AGENT)) < 32u) { __builtin_amdgcn_s_sleep(1); if (++sp > (1u << 17)) break; }
            __builtin_amdgcn_fence(__ATOMIC_ACQUIRE, "agent"); VM_WAIT(); }
#endif
        wg_sync();
        if (wid < 4) { const float* sl = slots + ((size_t)u.pm * 256 + t) * 8; float v[8];
#ifdef CPU_EMU
            UNROLL for (int j = 0; j < 8; ++j) v[j] = sl[j];
#else
            UNROLL for (int j = 0; j < 8; ++j) v[j] = __uint_as_float(__hip_atomic_load((const unsigned*)sl + j, __ATOMIC_RELAXED, __HIP_MEMORY_SCOPE_AGENT));
#endif
            S[t] = rsqrtf((((v[0] + v[1]) + (v[2] + v[3])) + ((v[4] + v[5]) + (v[6] + v[7]))) * (1.0f / D) + EPS); }
        wg_sync();
        UNROLL for (int bj = 0; bj < 2; ++bj) { int col = u.pn * 256 + bj * 128 + wc * 32 + 8 * fq;
#ifndef CPU_EMU
            asm volatile("" : "+v"(col));
#endif
            f32x4 gm0 = *(const f32x4*)(ng + col), gm1 = *(const f32x4*)(ng + col + 4), sh0 = (f32x4){0.f, 0.f, 0.f, 0.f}, sh1 = sh0;
            if (!FINAL) { const float* ms = msh + (size_t)cidx * NMOD * D + col; gm0 = gm0 * (*(const f32x4*)(ms + D) + 1.0f); gm1 = gm1 * (*(const f32x4*)(ms + D + 4) + 1.0f); sh0 = *(const f32x4*)ms; sh1 = *(const f32x4*)(ms + 4); }
            EPI_ROWS({ const float rs = S[ai * 128 + wr * 64 + m * 16 + fr]; const f32x4 a0 = acc[ai][bj][m][0], a1 = acc[ai][bj][m][1];
                if (!FINAL) {
                    const unsigned eo = (unsigned)row * D + (unsigned)col;
#ifndef CPU_EMU
                    { float xo[8] = {a0.x, a0.y, a0.z, a0.w, a1.x, a1.y, a1.z, a1.w}; *(u32x4*)((char*)X + eo * 2u) = pack8(xo); }
#endif
                    const f32x4 y0 = a0 * rs * gm0 + sh0, y1 = a1 * rs * gm1 + sh1; float o[8] = {y0.x, y0.y, y0.z, y0.w, y1.x, y1.y, y1.z, y1.w};
                    *(u32x4*)((char*)H + eo * 2u) = pack8(o); }
                else { const unsigned bo = ((unsigned)row * D + (unsigned)col) * 4u; *(f32x4*)((char*)out + bo) = a0 * rs * gm0; *(f32x4*)((char*)out + bo + 16u) = a1 * rs * gm1; }
                CFENCE(); }) }
    }
};
struct EpiZ {
    static constexpr bool PERM = true, AFTER_DRAIN = false;
    bf16_t *za, *zb;
    DEV void operator()(const Acc& acc, const pg8::Unit& u, int wr, int wc, int fr, int fq) const {
        int c0 = u.pn * 256; bf16_t* base; int ld; if (c0 < RCOLS) { base = za; ld = RCOLS; } else { base = zb; ld = ZB_LD; c0 -= RCOLS; }
        UNROLL for (int bj = 0; bj < 2; ++bj) { const int col = c0 + bj * 128 + wc * 32 + 8 * fq;
            EPI_ROWS({ float o[8]; UNROLL for (int j = 0; j < 8; ++j) o[j] = acc[ai][bj][m][j >> 2][j & 3];
                st8(base + (size_t)row * ld + col, pack8(o)); }) }
    }
};
struct EpiZC {
    static constexpr bool PERM = true, AFTER_DRAIN = false;
    bf16_t* ug;
    DEV void operator()(const Acc& acc, const pg8::Unit& u, int wr, int wc, int fr, int fq) const {
        UNROLL for (int bj = 0; bj < 2; ++bj) { const int col = u.pn * 256 + bj * 128 + wc * 32 + 8 * fq, g = col >> 4, cl = col & 15;
            EPI_ROWS({ float o[8]; UNROLL for (int j = 0; j < 8; ++j) o[j] = acc[ai][bj][m][j >> 2][j & 3];
                st8(ug + ((size_t)g * MCH + row / S5L) * S5K + (row % S5L) * 16 + cl, pack8(o)); }) }
    }
};
DEV u32x2 pack_gate8(const float (&g)[8]) { unsigned q[8]; UNROLL for (int j = 0; j < 8; ++j) q[j] = (unsigned)(g[j] * 255.0f + 0.5f);
    u32x2 o; o.x = q[0] | (q[1] << 8) | (q[2] << 16) | (q[3] << 24); o.y = q[4] | (q[5] << 8) | (q[6] << 16) | (q[7] << 24); return o; }
DEV void unpack_gate8(const u32x2 w, float (&g)[8]) { UNROLL for (int j = 0; j < 4; ++j) { g[j] = (float)((w.x >> (8 * j)) & 255u) * (1.0f / 255.0f); g[4 + j] = (float)((w.y >> (8 * j)) & 255u) * (1.0f / 255.0f); } }
typedef unsigned char gate8_t;
struct EpiGate {
    static constexpr bool PERM = true, AFTER_DRAIN = false;
    gate8_t* zg;
    DEV void operator()(const Acc& acc, const pg8::Unit& u, int wr, int wc, int fr, int fq) const { UNROLL for (int bj = 0; bj < 2; ++bj) { const int col = u.pn * 256 + bj * 128 + wc * 32 + 8 * fq;
            EPI_ROWS({ float o[8]; UNROLL for (int j = 0; j < 8; ++j) o[j] = sigmoidf_(acc[ai][bj][m][j >> 2][j & 3]);
                *(u32x2*)(zg + (size_t)row * 3 * D + col) = pack_gate8(o); }) }
    }
};
struct EpiLRw {
    static constexpr bool PERM = true, AFTER_DRAIN = false;
    bf16_t* omd; const float* w0;
    DEV void operator()(const Acc& acc, const pg8::Unit& u, int wr, int wc, int fr, int fq) const {
        UNROLL for (int bj = 0; bj < 2; ++bj) { const int n = u.pn * 256 + bj * 128 + wc * 32 + 8 * fq, d = n / RW, c = n % RW;
            const f32x4 b0 = *(const f32x4*)(w0 + n), b1 = *(const f32x4*)(w0 + n + 4);
            EPI_ROWS({ float o[8];
                UNROLL for (int j = 0; j < 4; ++j) { const float r0 = 0.6065306597126334f * sigmoidf_(b0[j] + acc[ai][bj][m][0][j]), r1 = 0.6065306597126334f * sigmoidf_(b1[j] + acc[ai][bj][m][1][j]); o[j] = 1.0f - __expf(-r0); o[4 + j] = 1.0f - __expf(-r1); }
                st8(omd + ((size_t)d * M + row) * RW + c, pack8(o)); }) }
    }
};
struct EpiLRa {
    static constexpr bool PERM = true, AFTER_DRAIN = false;
    bf16_t *kd, *bb; const bf16_t *xs, *kk; const float *a0, *ka;
    DEV void operator()(const Acc& acc, const pg8::Unit& u, int wr, int wc, int fr, int fq) const {
        UNROLL for (int bj = 0; bj < 2; ++bj) { const int n = u.pn * 256 + bj * 128 + wc * 32 + 8 * fq, d = n / RW, c = n % RW;
            const f32x4 b0 = *(const f32x4*)(a0 + n), b1 = *(const f32x4*)(a0 + n + 4), k0 = *(const f32x4*)(ka + c), k1 = *(const f32x4*)(ka + c + 4);
            u32x4 kq[4], kkq[4];
            EPI_AI { EPI_M({ kq[m] = ld8(xs + (size_t)row * 3 * RW + RW + c); kkq[m] = ld8(kk + (size_t)row * RW + c); }) EPI_M({ float kv[8], kkv[8], o1[8], o2[8]; unpack8(kq[m], kv); unpack8(kkq[m], kkv);
                        UNROLL for (int j = 0; j < 4; ++j) { const float a_0 = sigmoidf_(b0[j] + acc[ai][bj][m][0][j]), a_1 = sigmoidf_(b1[j] + acc[ai][bj][m][1][j]);
                            o1[j] = kv[j] * (1.0f + (a_0 - 1.0f) * k0[j]); o2[j] = kkv[j] * a_0; o1[4 + j] = kv[4 + j] * (1.0f + (a_1 - 1.0f) * k1[j]); o2[4 + j] = kkv[4 + j] * a_1; }
                        st8(kd + ((size_t)d * M + row) * RW + c, pack8(o1)); st8(bb + ((size_t)d * M + row) * RW + c, pack8(o2)); }) } }
    }
};
struct EpiLRg {
    static constexpr bool PERM = true, AFTER_DRAIN = false;
    bf16_t* gg;
    DEV void operator()(const Acc& acc, const pg8::Unit& u, int wr, int wc, int fr, int fq) const {
        UNROLL for (int bj = 0; bj < 2; ++bj) { const int c = u.pn * 256 + bj * 128 + wc * 32 + 8 * fq;
            EPI_ROWS({ float o[8]; UNROLL for (int j = 0; j < 8; ++j) o[j] = acc[ai][bj][m][j >> 2][j & 3];
                st8(gg + (size_t)row * RW + c, pack8(o)); }) }
    }
};
template <bool FIRST> struct EpiProjAB {
    static constexpr bool PERM = true, AFTER_DRAIN = false;
    bf16_t* mrg; const gate8_t* zg; int goff;
    DEV void operator()(const Acc& acc, const pg8::Unit& u, int wr, int wc, int fr, int fq) const { UNROLL for (int bj = 0; bj < 2; ++bj) { const int col = u.pn * 256 + bj * 128 + wc * 32 + 8 * fq;
            u32x2 gq[4]; u32x4 mq[4];
            EPI_AI { EPI_M({ gq[m] = *(const u32x2*)(zg + (size_t)row * 3 * D + goff + col); if (!FIRST) mq[m] = ld8(mrg + (size_t)row * D + col); else mq[m] = (u32x4){0u, 0u, 0u, 0u}; }) EPI_M({ float g[8], r[8]; unpack_gate8(gq[m], g); unpack8(mq[m], r);
                        UNROLL for (int j = 0; j < 4; ++j) { r[j] += g[j] * acc[ai][bj][m][0][j]; r[4 + j] += g[4 + j] * acc[ai][bj][m][1][j]; }
                        st8(mrg + (size_t)row * D + col, pack8(r)); }) } }
    }
};
struct EpiProjC {
    static constexpr bool PERM = true, AFTER_DRAIN = false;
    const bf16_t* mrg; bf16_t* mrgb; const gate8_t* zg;
    DEV void operator()(const Acc& acc, const pg8::Unit& u, int wr, int wc, int fr, int fq) const {
        const int col = u.pn * 128 + wc * 32 + 8 * fq; u32x2 gq[4]; u32x4 mq[4];
        EPI_AI { EPI_M({ gq[m] = *(const u32x2*)(zg + (size_t)row * 3 * D + 2 * D + col); mq[m] = ld8(mrg + (size_t)row * D + col); }) EPI_M({ float g[8], r[8]; unpack_gate8(gq[m], g); unpack8(mq[m], r); float o[8];
                    UNROLL for (int j = 0; j < 4; ++j) { o[j] = r[j] + g[j] * acc[ai][0][m][0][j] * sigmoidf_(acc[ai][1][m][0][j]); o[4 + j] = r[4 + j] + g[4 + j] * acc[ai][0][m][1][j] * sigmoidf_(acc[ai][1][m][1][j]); }
                    st8(mrgb + (size_t)row * D + col, pack8(o)); }) }
    }
};
template <int NT> struct BatchOrder {
    int G, c;
    DEV bool next(int i, pg8::Unit& u) const { const long id = (long)i * G + c; if (id >= (long)CG * S5MT * NT) return false;
        const int g = (int)(id / (S5MT * NT)), r = (int)(id % (S5MT * NT)); u.pm = g * S5MT + r / NT; u.pn = g * NT + r % NT; return true; }
    DEV void a_ready(const pg8::Unit&) const {}
    DEV void done(const pg8::Unit&) const {}
};
struct PanelOrder {
    int G, c;
    DEV bool next(int i, pg8::Unit& u) const { const int L = i * G + c; if (L >= (M / 256) * (D / 256)) return false;
        const int x = L & 7, o = L >> 3; u.pm = ((o >> 5) * 8 + x) * 4 + (o & 3); u.pn = (o & 31) >> 2; return true; }
    DEV void a_ready(const pg8::Unit&) const {}
    DEV void done(const pg8::Unit&) const {}
};
struct ProjCOrder {
    pg8::StaticOrder base;
    DEV bool next(int i, pg8::Unit& u) const { if (!base.next(i >> 1, u)) return false; u.pn = 2 * u.pn + (i & 1); return true; }
    DEV void a_ready(const pg8::Unit&) const {}
    DEV void done(const pg8::Unit&) const {}
};
struct EpiS5a {
    static constexpr bool PERM = true, AFTER_DRAIN = false;
    bf16_t* yl; float* se;
    DEV void operator()(const Acc& acc, const pg8::Unit& u, int wr, int wc, int fr, int fq) const {
        const int g = u.pn / S5NT1, ni = u.pn % S5NT1, rbase = (u.pm % S5MT) * 256;
        UNROLL for (int bj = 0; bj < 2; ++bj) { const int col = ni * 256 + bj * 128 + wc * 32 + 8 * fq;
            EPI_ROWS({ const int r = rbase + (row - u.pm * 256);
                if (ni < S5NT2) { float o[8]; UNROLL for (int j = 0; j < 8; ++j) o[j] = acc[ai][bj][m][j >> 2][j & 3]; st8(yl + ((size_t)g * MCH + r) * S5K + col, pack8(o)); }
                else { float* p = se + ((size_t)g * MCH + r) * 256 + (col - S5K); *(f32x4*)p = acc[ai][bj][m][0]; *(f32x4*)(p + 4) = acc[ai][bj][m][1]; } }) }
    }
};
struct EpiS5b {
    static constexpr bool PERM = true, AFTER_DRAIN = false;
    const bf16_t *yl, *ug; bf16_t* yc; const float* dsk;
    DEV void operator()(const Acc& acc, const pg8::Unit& u, int wr, int wc, int fr, int fq) const {
        const int g = u.pn / S5NT2, ni = u.pn % S5NT2, rbase = (u.pm % S5MT) * 256;
        UNROLL for (int bj = 0; bj < 2; ++bj) { const int col = ni * 256 + bj * 128 + wc * 32 + 8 * fq, t = col >> 4, cl = col & 15;
            const f32x4 d0 = *(const f32x4*)(dsk + g * 16 + cl), d1 = *(const f32x4*)(dsk + g * 16 + cl + 4);
            u32x4 aq[4], uq[4];
            EPI_AI { EPI_M({ const int r = rbase + (row - u.pm * 256); const size_t off = ((size_t)g * MCH + (r < M / S5L ? r : 0)) * S5K + col; aq[m] = ld8(yl + off); uq[m] = ld8(ug + off); }) EPI_M({ const int r = rbase + (row - u.pm * 256);
                        if (r < M / S5L) { float a[8], uu[8], o[8]; unpack8(aq[m], a); unpack8(uq[m], uu);
                            UNROLL for (int j = 0; j < 4; ++j) { o[j] = geluf_(d0[j] * uu[j] + a[j] + acc[ai][bj][m][0][j]); o[4 + j] = geluf_(d1[j] * uu[4 + j] + a[4 + j] + acc[ai][bj][m][1][j]); }
                            st8(yc + ((size_t)r * S5L + t) * CW + g * 16 + cl, pack8(o)); } }) } }
    }
};

#ifndef CPU_EMU
#define XB_TMO      128
#define XB_XCNT(j)  (256  + 64 * (j))
#define XB_XSUB(j)  (1280 + 64 * (j))
#define XB_XGEN(j)  (2304 + 64 * (j))
#define XB_TOP      3328
#define XB_TOPGEN   3392
#define XCD_BAR_WORDS 3456
#define XB_SPIN_CAP (1u << 18)
__device__ __forceinline__ unsigned xb_ld(unsigned* p)              { return __hip_atomic_load(p, __ATOMIC_RELAXED, __HIP_MEMORY_SCOPE_AGENT); }
__device__ __forceinline__ unsigned xb_add(unsigned* p, unsigned v) { return __hip_atomic_fetch_add(p, v, __ATOMIC_RELAXED, __HIP_MEMORY_SCOPE_AGENT); }
__device__ __forceinline__ unsigned xb_xcc_id() { return (unsigned)__builtin_amdgcn_s_getreg((3 << 11) | 20) & 0xFu; }
#define XB_SPIN(cond, bar) do { unsigned _sp = 0; while (cond) { __builtin_amdgcn_s_sleep(1); \
    if ((++_sp & 255u) == 0u) { if (xb_ld(&(bar)[XB_TMO])) break; if (_sp > XB_SPIN_CAP) { atomicAdd(&(bar)[XB_TMO], 1u); break; } } } } while (0)
struct XcdBarrier { unsigned* bar; unsigned x; volatile LAS unsigned* st; };
__device__ __forceinline__ XcdBarrier xcd_barrier_post(unsigned* bar, volatile LAS unsigned* st) {
    XcdBarrier b; b.bar = bar; b.x = xb_xcc_id(); b.st = st;
    if (threadIdx.x == 0) (void)xb_add(&bar[XB_XCNT(b.x)], 1u);
    return b;
}
__device__ __forceinline__ void xcd_barrier_complete(unsigned* bar, unsigned x, unsigned& nloc, unsigned& nx) {
    const unsigned G = gridDim.x * gridDim.y * gridDim.z;
    unsigned sum, cnt, mine, sp = 0u;
    for (;;) {
        sum = 0u; cnt = 0u; mine = 0u;
#pragma unroll
        for (unsigned j = 0; j < 16; ++j) { const unsigned c = xb_ld(&bar[XB_XCNT(j)]); sum += c; cnt += (c > 0u) ? 1u : 0u; mine = (j == x) ? c : mine; }
        if (sum == G) break;
        __builtin_amdgcn_s_sleep(1);
        if ((++sp & 255u) == 0u) { if (xb_ld(&bar[XB_TMO])) break; if (sp > XB_SPIN_CAP) { atomicAdd(&bar[XB_TMO], 1u); break; } }
    }
    nloc = mine > 0u ? mine : 1u; nx = cnt > 0u ? cnt : 1u;
}
__device__ __forceinline__ void xcd_barrier(const XcdBarrier& b) {
    asm volatile("s_waitcnt vmcnt(0)" ::: "memory");
    __syncthreads();
    if (threadIdx.x == 0) {
        unsigned* bar = b.bar;
        __builtin_amdgcn_s_waitcnt(0);
        unsigned nloc = b.st[0], nx = b.st[1];
        if (nloc == 0u) { xcd_barrier_complete(bar, b.x, nloc, nx); b.st[0] = nloc; b.st[1] = nx; }
        const unsigned old = xb_add(&bar[XB_XSUB(b.x)], 1u);
        const unsigned gen = old / nloc;
        if (old + 1u == (gen + 1u) * nloc) {
            __builtin_amdgcn_fence(__ATOMIC_RELEASE, "agent");
            asm volatile("s_waitcnt vmcnt(0)" ::: "memory");
            const unsigned og = xb_add(&bar[XB_TOP], 1u);
            const unsigned tg = og / nx;
            if (og + 1u == (tg + 1u) * nx) xb_add(&bar[XB_TOPGEN], 1u);
            else XB_SPIN(xb_ld(&bar[XB_TOPGEN]) == tg, bar);
            __builtin_amdgcn_fence(__ATOMIC_ACQUIRE, "agent");
            xb_add(&bar[XB_XGEN(b.x)], 1u);
            asm volatile("s_waitcnt vmcnt(0)" ::: "memory");
        } else {
            XB_SPIN(xb_ld(&bar[XB_XGEN(b.x)]) == gen, bar);
            __builtin_amdgcn_fence(__ATOMIC_ACQUIRE, "agent");
            asm volatile("s_waitcnt vmcnt(0)" ::: "memory");
        }
    }
    __syncthreads();
}
#endif

constexpr int LDS_MAIN = 131072;
constexpr int LDS_MISC = 143360;
constexpr int LDS_BYTES = 147456;
struct Args { const float* in[N_IN]; float* out; unsigned char* ws; int ph_lo, ph_hi; };
struct Ctx {
    const Args CAS* a; LAS unsigned char* lds; int tid, lane, wave, bid, G;
    DEV const float* in(int i) const { return a->in[i]; }
    DEV float* out() const { return a->out; }
    template <class T> DEV T* ws(size_t off) const { return (T*)(a->ws + off); }
    DEV int gw() const { return wave * G + bid; }
    DEV int ngw() const { return G * NWAVES; }
};


struct Span2 { int a0, a1, b0, b1; };
DEV int cdiv_pos(long a, long b) { return a <= 0 ? 0 : (int)((a + b - 1) / b); }
DEV Span2 balanced_span(int w, int parts, int n0, long c0, int n1, long c1) {
    const long total = n0 * c0 + n1 * c1, tgt = (total + parts - 1) / parts, lo = (long)w * tgt, hi = lo + tgt, base = n0 * c0;
    Span2 s; s.a0 = cdiv_pos(lo, c0); s.a1 = cdiv_pos(hi, c0); if (s.a0 > n0) s.a0 = n0; if (s.a1 > n0) s.a1 = n0;
    s.b0 = cdiv_pos(lo - base, c1); s.b1 = cdiv_pos(hi - base, c1); if (s.b0 > n1) s.b0 = n1; if (s.b1 > n1) s.b1 = n1;
    return s;
}

DEV void phase_pro(const Ctx& c) {
    constexpr int NB = NMOD * D / 256, NITEM = DEPTH * NB, KW = D / NWAVES;
    LAS float* S = (LAS float*)c.lds;
    LAS float* P = (LAS float*)(c.lds + NCOND * D * 4);
    bool have = false;
    const int gstride = c.G >= 256 ? 128 : c.G;
    for (int it = c.bid; it < NITEM && c.bid < gstride; it += gstride) {
        if (!have) { for (int i = c.tid; i < NCOND * D; i += NTHREADS) { const int r = i / D, k = i % D; const float v = r == 0 ? c.in(I_CCTX)[k] : c.in(I_C)[(size_t)(r - 1) * D + k]; S[i] = siluf_(v); } have = true; wg_sync(); }
        const int l = it / NB, cb = it % NB;
        const float* W = c.in(I_WMOD) + (size_t)l * D * NMOD * D + (size_t)cb * 256 + c.lane * 4;
        f32x4 acc[NCOND];
#pragma unroll
        for (int r = 0; r < NCOND; ++r) acc[r] = (f32x4){0.f, 0.f, 0.f, 0.f};
        constexpr int GU = 16;
        static_assert(KW % GU == 0, "mod GEMV unroll");
        for (int k = c.wave * KW; k < (c.wave + 1) * KW; k += GU) { f32x4 w[GU];
#pragma unroll
            for (int q = 0; q < GU; ++q) w[q] = *(const f32x4*)(W + (size_t)(k + q) * NMOD * D);
#pragma unroll
            for (int q = 0; q < GU; ++q) {
#pragma unroll
                for (int r = 0; r < NCOND; ++r) acc[r] += w[q] * S[r * D + k + q]; } }
#pragma unroll
        for (int r = 0; r < NCOND; ++r) *(LAS f32x4*)(P + (c.wave * NCOND + r) * 256 + c.lane * 4) = acc[r];
        wg_sync();
        for (int i = c.tid; i < NCOND * 256; i += NTHREADS) { const int r = i / 256, n = i % 256; float s = c.in(I_BMOD)[(size_t)l * NMOD * D + cb * 256 + n];
#pragma unroll
            for (int w = 0; w < NWAVES; ++w) s += P[(w * NCOND + r) * 256 + n];
            c.ws<float>(WS_MOD)[((size_t)l * NCOND + r) * NMOD * D + cb * 256 + n] = s; }
        wg_sync();
    }
}

template <class MapF> DEV void cvt_item(const float* W, int ldw, int K, bf16_t* WT, LAS float* scr, int item, int nblk, int lane, MapF colmap) {
    const int kb = item / nblk, nb = item % nblk, k0 = 64 * kb, n0 = 64 * nb;
    const int r = lane >> 4, c4 = (lane & 15) * 4, col = colmap(n0 + c4);
    f32x4 v[16];
#pragma unroll
    for (int i = 0; i < 16; ++i) v[i] = col >= 0 ? *(const f32x4*)(W + (size_t)(k0 + 4 * i + r) * ldw + col) : (f32x4){0.f, 0.f, 0.f, 0.f};
#pragma unroll
    for (int i = 0; i < 16; ++i) { LAS float* d = scr + (4 * i + r) * 65 + c4; d[0] = v[i].x; d[1] = v[i].y; d[2] = v[i].z; d[3] = v[i].w; }
    LDS_WAIT(); CFENCE(); WAVE_SYNC();
    const int ch = lane & 7;
#pragma unroll
    for (int j = 0; j < 8; ++j) { const int n = (lane >> 3) + 8 * j; const LAS float* s = scr + (8 * ch) * 65 + n;
        u32x4 o; o.x = pk2(s[0 * 65], s[1 * 65]); o.y = pk2(s[2 * 65], s[3 * 65]); o.z = pk2(s[4 * 65], s[5 * 65]); o.w = pk2(s[6 * 65], s[7 * 65]);
        *(u32x4*)(WT + (size_t)(n0 + n) * K + k0 + 8 * ch) = o; }
    LDS_WAIT(); CFENCE(); WAVE_SYNC();
}
DEV void s5_build(const Ctx& c, int l, int g) {
    LAS float* POW = (LAS float*)c.lds;
    LAS float* BBv = POW + 2 * (S5L + 1) * 64 * 2;
    LAS float* KT = BBv + 2 * 64 * 16 * 2;
    static_assert((2 * (S5L + 1) * 64 * 2 + 2 * 64 * 16 * 2 + 2 * S5L * 256) * 4 <= LDS_MAIN_BYTES, "s5_build LDS");
    for (int e = c.tid; e < 2 * (S5L + 1) * 64; e += NTHREADS) { const int d = e / ((S5L + 1) * 64), m = (e / 64) % (S5L + 1), p = e % 64;
        const size_t gp = ((size_t)(l * 2 + d) * CG + g) * CP + p; const float delta = expf(c.in(I_CLDT)[(size_t)(l * 2 + d) * CG + g]);
        const float rho = c.in(I_CLRE)[gp] * delta, th = c.in(I_CLIM)[gp] * delta, mag = expf((float)m * rho);
        POW[e * 2] = mag * cosf((float)m * th); POW[e * 2 + 1] = mag * sinf((float)m * th); }
    for (int e = c.tid; e < 2 * 64 * 16; e += NTHREADS) { const int d = e / 1024, p = (e / 16) % 64, k = e % 16;
        const size_t gp = ((size_t)(l * 2 + d) * CG + g) * CP + p; const float lre = c.in(I_CLRE)[gp], lim = c.in(I_CLIM)[gp], delta = expf(c.in(I_CLDT)[(size_t)(l * 2 + d) * CG + g]);
        const float mag = expf(lre * delta), lbr = mag * cosf(lim * delta), lbi = mag * sinf(lim * delta), den = lre * lre + lim * lim;
        const float qr = ((lbr - 1.0f) * lre + lbi * lim) / den, qi = (lbi * lre - (lbr - 1.0f) * lim) / den;
        const float br = c.in(I_CBRE)[gp * 16 + k], bi = c.in(I_CBIM)[gp * 16 + k];
        BBv[e * 2] = qr * br - qi * bi; BBv[e * 2 + 1] = qr * bi + qi * br; }
    wg_sync();
    static_assert(NTHREADS == 2 * 16 * 16, "s5_build: one thread per (direction, output channel, input channel)");
    {
        const int d = c.tid >> 8, cc = (c.tid >> 4) & 15, k = c.tid & 15;
        const float* cre = c.in(I_CCRE) + (((size_t)(l * 2 + d) * CG + g) * 16 + cc) * CP; const float* cim = c.in(I_CCIM) + (((size_t)(l * 2 + d) * CG + g) * 16 + cc) * CP;
        float acc[S5L];
#pragma unroll
        for (int m = 0; m < S5L; ++m) acc[m] = 0.f;
#pragma unroll 2
        for (int p = 0; p < 64; ++p) { const float cr = cre[p], ci = cim[p], br = BBv[((d * 64 + p) * 16 + k) * 2], bi = BBv[((d * 64 + p) * 16 + k) * 2 + 1];
            const float wr = cr * br - ci * bi, wi = cr * bi + ci * br;
#pragma unroll
            for (int m = 0; m < S5L; ++m) { const f32x2 pw = *(const LAS f32x2*)(POW + ((d * (S5L + 1) + m) * 64 + p) * 2); acc[m] += wr * pw.x - wi * pw.y; } }
#pragma unroll
        for (int m = 0; m < S5L; ++m) KT[((d * S5L + m) * 16 + cc) * 16 + k] = acc[m];
    }
    wg_sync();
    bf16_t* W = c.ws<bf16_t>(WS_S5W + (size_t)l * S5W_L) + (size_t)g * S5N1 * S5K; bf16_t* F = c.ws<bf16_t>(WS_S5F + (size_t)l * S5F_L) + (size_t)g * S5K * 256;
    for (int e = c.tid; e < S5K * (S5K / 8); e += NTHREADS) { const int n = e / (S5K / 8), kc = e % (S5K / 8), t = n >> 4, cc = n & 15, j = kc >> 1, k0 = (kc & 1) * 8; float o[8];
#pragma unroll
        for (int q = 0; q < 8; ++q) o[q] = (j <= t ? KT[((0 * S5L + (t - j)) * 16 + cc) * 16 + k0 + q] : 0.f) + (j >= t ? KT[((1 * S5L + (j - t)) * 16 + cc) * 16 + k0 + q] : 0.f);
        st8(W + (size_t)n * S5K + kc * 8, pack8(o)); }
    for (int e = c.tid; e < 256 * (S5K / 8); e += NTHREADS) { const int q = e / (S5K / 8), kc = e % (S5K / 8), d = q >> 7, im = (q >> 6) & 1, p = q & 63, j = kc >> 1, k0 = (kc & 1) * 8, m = d ? j : S5L - 1 - j;
        const float pr = POW[((d * (S5L + 1) + m) * 64 + p) * 2], pi = POW[((d * (S5L + 1) + m) * 64 + p) * 2 + 1]; float o[8];
#pragma unroll
        for (int x = 0; x < 8; ++x) { const float br = BBv[((d * 64 + p) * 16 + k0 + x) * 2], bi = BBv[((d * 64 + p) * 16 + k0 + x) * 2 + 1]; o[x] = im ? (pr * bi + pi * br) : (pr * br - pi * bi); }
        st8(W + (size_t)(S5K + q) * S5K + kc * 8, pack8(o)); }
    for (int e = c.tid; e < S5K * 32; e += NTHREADS) { const int n = e / 32, qc = e % 32, t = n >> 4, cc = n & 15, q0 = qc * 8, d = q0 >> 7, im = (q0 >> 6) & 1, p0 = q0 & 63, m = d ? S5L - t : t + 1;
        const float* cre = c.in(I_CCRE) + (((size_t)(l * 2 + d) * CG + g) * 16 + cc) * CP + p0; const float* cim = c.in(I_CCIM) + (((size_t)(l * 2 + d) * CG + g) * 16 + cc) * CP + p0; float o[8];
#pragma unroll
        for (int x = 0; x < 8; ++x) { const float pr = POW[((d * (S5L + 1) + m) * 64 + p0 + x) * 2], pi = POW[((d * (S5L + 1) + m) * 64 + p0 + x) * 2 + 1]; o[x] = im ? -(cre[x] * pi + cim[x] * pr) : (cre[x] * pr - cim[x] * pi); }
        st8(F + (size_t)n * 256 + q0, pack8(o)); }
    wg_sync();
}
constexpr int CI_FI = (D / 64) * (2 * FF / 64), CI_FO = (FF / 64) * (D / 64), CI_WIM = (D / 64) * (NZ_MIX / 64), CI_WIG = (D / 64) * (3 * D / 64), CI_PA = (RW / 64) * (D / 64), CI_PB = (SW / 64) * (D / 64), CI_PC = (CW / 64) * (2 * D / 64), CI_WO = (D / 64) * (D / 64), CI_LR = 5 * 4 * (RW / 64);
constexpr int CONV_NE = CI_FI + CI_FO + CI_WIM + CI_LR, CONV_NL = CI_WIG + CI_PA + CI_PB + CI_PC + CI_WO + CI_FI + CI_FO;
static_assert((2 * FF) % 64 == 0 && NZ % 64 == 0 && NZ_MIX % 64 == 0 && FF % 64 == 0 && 8 * 16640 <= LDS_MISC && (LRN * 256) % 4096 == 0, "conversion tiles");
DEV void conv_one(const Ctx& c, int l, bool late, int r, LAS float* scr) {
    auto ident = [](int n) { return n; };
    auto ffmap = [](int n) { return ((n >> 7) & 1) * FF + (n >> 8) * 128 + (n & 127); };
    auto pcmap = [](int n) { return ((n >> 7) & 1) * D + (n >> 8) * 128 + (n & 127); };
    auto wimap = [](int n) { return n < RCOLS + SCOLS ? n : (n < RCOLS + ZB_LD ? -1 : n - (ZB_LD - SCOLS)); };
    if (!late) {
        if (r < CI_FI) { cvt_item(c.in(I_FWIN) + (size_t)(l * 2) * D * 2 * FF, 2 * FF, D, c.ws<bf16_t>(WS_FIT), scr, r, 2 * FF / 64, c.lane, ffmap); return; } r -= CI_FI;
        if (r < CI_FO) { cvt_item(c.in(I_FWOUT) + (size_t)(l * 2) * FF * D, D, FF, c.ws<bf16_t>(WS_FOT), scr, r, D / 64, c.lane, ident); return; } r -= CI_FO;
        if (r < CI_WIM) { cvt_item(c.in(I_WIN) + (size_t)l * D * DIN, DIN, D, c.ws<bf16_t>(WS_WIT), scr, (r / (NZ_MIX / 64)) * (NZ / 64) + r % (NZ_MIX / 64), NZ / 64, c.lane, wimap); return; } r -= CI_WIM;
        { const int blk = r / (4 * (RW / 64)), kb = (r / (RW / 64)) % 4, nb = r % (RW / 64);
          const bool data = blk < 2 ? kb == 0 : (blk < 4 ? kb == 1 : kb >= 2);
          const float* src = blk < 2 ? c.in(I_RW2) + (size_t)(l * 2 + blk) * 64 * RW : (blk < 4 ? c.in(I_RA2) + (size_t)(l * 2 + blk - 2) * 64 * RW - (size_t)64 * RW : c.in(I_RG2) + (size_t)l * 128 * RW - (size_t)128 * RW);
          auto zmap = [](int) { return -1; };
          if (data) cvt_item(src, RW, 256, c.ws<bf16_t>(WS_LRT) + (size_t)blk * RW * 256, scr, kb * (RW / 64) + nb, RW / 64, c.lane, ident);
          else cvt_item(src, RW, 256, c.ws<bf16_t>(WS_LRT) + (size_t)blk * RW * 256, scr, kb * (RW / 64) + nb, RW / 64, c.lane, zmap); }
        return;
    }
    if (r < CI_WIG) { cvt_item(c.in(I_WIN) + (size_t)l * D * DIN, DIN, D, c.ws<bf16_t>(WS_WIT), scr, (r / (3 * D / 64)) * (NZ / 64) + NZ_MIX / 64 + r % (3 * D / 64), NZ / 64, c.lane, wimap); return; } r -= CI_WIG;
    if (r < CI_PA) { cvt_item(c.in(I_PA) + (size_t)l * RW * D, D, RW, c.ws<bf16_t>(WS_PAT), scr, r, D / 64, c.lane, ident); return; } r -= CI_PA;
    if (r < CI_PB) { cvt_item(c.in(I_PB) + (size_t)l * SW * D, D, SW, c.ws<bf16_t>(WS_PBT), scr, r, D / 64, c.lane, ident); return; } r -= CI_PB;
    if (r < CI_PC) { cvt_item(c.in(I_PC) + (size_t)l * CW * 2 * D, 2 * D, CW, c.ws<bf16_t>(WS_PCT), scr, r, 2 * D / 64, c.lane, pcmap); return; } r -= CI_PC;
    if (r < CI_WO) { cvt_item(c.in(I_WOUT) + (size_t)l * D * D, D, D, c.ws<bf16_t>(WS_WOT), scr, r, D / 64, c.lane, ident); return; } r -= CI_WO;
    if (r < CI_FI) { cvt_item(c.in(I_FWIN) + (size_t)(l * 2 + 1) * D * 2 * FF, 2 * FF, D, c.ws<bf16_t>(WS_FIT) + (size_t)2 * FF * D, scr, r, 2 * FF / 64, c.lane, ffmap); return; } r -= CI_FI;
    cvt_item(c.in(I_FWOUT) + (size_t)(l * 2 + 1) * FF * D, D, FF, c.ws<bf16_t>(WS_FOT) + (size_t)D * FF, scr, r, D / 64, c.lane, ident);
}

DEV void phase_norm(const Ctx& c, int l, int j) {
    constexpr int NV = D / 256;
    const float* X = c.ws<float>(WS_X); bf16_t* H = c.ws<bf16_t>(WS_H);
    for (int row = c.gw(); row < M; row += c.ngw()) {
        const float* xrow = (l == 0 && j == 0) ? (row < MC ? c.in(I_XP) + (size_t)row * D : c.in(I_XS) + (size_t)(row - MC) * D) : X + (size_t)row * D;
        const f32x4* xr = (const f32x4*)xrow + c.lane; f32x4 v[NV]; float ss = 0.f;
#pragma unroll
        for (int i = 0; i < NV; ++i) { v[i] = xr[64 * i]; ss += (v[i].x * v[i].x + v[i].y * v[i].y) + (v[i].z * v[i].z + v[i].w * v[i].w); }
        const float rstd = rsqrtf(wave_sum(ss) * (1.0f / D) + EPS);
        const float* mod = c.ws<float>(WS_MOD) + ((size_t)l * NCOND + cond_of_row(row)) * NMOD * D;
        const f32x4* sh = (const f32x4*)(mod + (size_t)(3 * j) * D) + c.lane; const f32x4* sc = (const f32x4*)(mod + (size_t)(3 * j + 1) * D) + c.lane;
        const f32x4* g = (const f32x4*)(c.in(I_NORMG) + (size_t)(l * 3 + j) * D) + c.lane;
        u32x2* o = (u32x2*)(H + (size_t)row * D) + c.lane;
#pragma unroll
        for (int i = 0; i < NV; ++i) { const f32x4 y = v[i] * rstd * g[64 * i] * (sc[64 * i] + 1.0f) + sh[64 * i]; u32x2 w; w.x = pk2(y.x, y.y); w.y = pk2(y.z, y.w); o[64 * i] = w; }
    }
}
DEV void phase_final(const Ctx& c) {
    constexpr int NV = D / 256;
    const float* X = c.ws<float>(WS_X);
    for (int row = c.gw(); row < M; row += c.ngw()) {
        const f32x4* xr = (const f32x4*)(X + (size_t)row * D) + c.lane; f32x4 v[NV]; float ss = 0.f;
#pragma unroll
        for (int i = 0; i < NV; ++i) { v[i] = xr[64 * i]; ss += (v[i].x * v[i].x + v[i].y * v[i].y) + (v[i].z * v[i].z + v[i].w * v[i].w); }
        const float rstd = rsqrtf(wave_sum(ss) * (1.0f / D) + EPS);
        const f32x4* g = (const f32x4*)c.in(I_FNG) + c.lane; f32x4* o = (f32x4*)(c.out() + OUT_Y + (size_t)row * D) + c.lane;
#pragma unroll
        for (int i = 0; i < NV; ++i) o[64 * i] = v[i] * rstd * g[64 * i];
    }
}

DEV void acc8(float (&a)[8], const bf16_t* p, float w) { float f[8]; unpack8(ld8(p), f);
#pragma unroll
    for (int j = 0; j < 8; ++j) a[j] += w * f[j]; }
DEV void phase_prep(const Ctx& c, int l) {
    const bf16_t* ZA = c.ws<bf16_t>(WS_ZA); const bf16_t* ZB = c.ws<bf16_t>(WS_ZB);
    bf16_t* XS = c.ws<bf16_t>(WS_XS); bf16_t* KK = c.ws<bf16_t>(WS_KK); bf16_t* LRI = c.ws<bf16_t>(WS_LRI); bf16_t* XBC = c.ws<bf16_t>(WS_XBC); float* DT = c.ws<float>(WS_DT);
    for (int it = c.gw(); it < 2 * M; it += c.ngw()) {
        if (it < M) {
            const int row = it; int nbr[4]; float wn;
            if (row < MC) { const int t = row % SEQ; nbr[0] = t > 0 ? row - 1 : -1; nbr[1] = t < SEQ - 1 ? row + 1 : -1; nbr[2] = -1; nbr[3] = -1; wn = 0.5f; }
            else { const int t = (row - MC) % DEC_SEQ, gy = t / GRID_W, gx = t % GRID_W; nbr[0] = gy > 0 ? row - GRID_W : -1; nbr[1] = gy < DEC_SEQ / GRID_W - 1 ? row + GRID_W : -1; nbr[2] = gx > 0 ? row - 1 : -1; nbr[3] = gx < GRID_W - 1 ? row + 1 : -1; wn = 0.25f; }
            constexpr int NCH = RCOLS / 8, NIT = (NCH + 63) / 64;
            struct PrepLd { u32x4 z, n[4]; f32x4 mu0, mu1; };
            auto issue = [&](int i, PrepLd& L) { const int ch = c.lane + 64 * i; const int col = ch < NCH ? 8 * ch : 0;
                L.z = ld8(ZA + (size_t)row * RCOLS + col);
#pragma unroll
                for (int q = 0; q < 4; ++q) L.n[q] = nbr[q] >= 0 ? ld8(ZA + (size_t)nbr[q] * RCOLS + col) : (u32x4){0u, 0u, 0u, 0u};
                const float* mu = c.in(I_RMU) + (size_t)l * RCOLS + col; L.mu0 = *(const f32x4*)mu; L.mu1 = *(const f32x4*)(mu + 4); };
            auto finish = [&](int i, const PrepLd& L) {
                const int ch = c.lane + 64 * i; const bool act = ch < NCH; const int col = act ? 8 * ch : 0;
                float z[8], nb[8], xs[8], f[8];
                unpack8(L.z, z);
#pragma unroll
                for (int j = 0; j < 8; ++j) nb[j] = 0.f;
#pragma unroll
                for (int q = 0; q < 4; ++q) { unpack8(L.n[q], f);
#pragma unroll
                    for (int j = 0; j < 8; ++j) nb[j] += wn * f[j]; }
                const float mu[8] = {L.mu0.x, L.mu0.y, L.mu0.z, L.mu0.w, L.mu1.x, L.mu1.y, L.mu1.z, L.mu1.w};
#pragma unroll
                for (int j = 0; j < 8; ++j) xs[j] = z[j] + mu[j] * (nb[j] - z[j]);
                float kv[8], ssq = 0.f; const bool isk = act && col >= RW && col < 2 * RW;
                if (isk) { const float* kkw = c.in(I_RKK) + (size_t)l * RW + (col - RW);
#pragma unroll
                    for (int j = 0; j < 8; ++j) { kv[j] = xs[j] * kkw[j]; ssq += kv[j] * kv[j]; } }
                else {
#pragma unroll
                    for (int j = 0; j < 8; ++j) kv[j] = 0.f; }
                ssq = red8(ssq);
                if (act) {
                    if (col < 3 * RW) { st8(XS + (size_t)row * 3 * RW + col, pack8(xs));
                        if (isk) { const float rn = rsqrtf(ssq + 1e-12f);
#pragma unroll
                            for (int j = 0; j < 8; ++j) kv[j] *= rn;
                            st8(KK + (size_t)row * RW + (col - RW), pack8(kv)); } }
                    else { const int cc = col - 3 * RW; float o[8];
#pragma unroll
                        for (int j = 0; j < 8; ++j) o[j] = cc < 64 ? tanhf(xs[j]) : (cc < 128 ? xs[j] : sigmoidf_(xs[j]));
                        st8(LRI + (size_t)row * 256 + cc, pack8(o)); }
                } };
            PrepLd LA, LB; issue(0, LA);
#pragma unroll 1
            for (int i = 0; i < NIT; i += 2) {
                if (i + 1 < NIT) issue(i + 1, LB);
                finish(i, LA);
                if (i + 2 < NIT) issue(i + 2, LA);
                if (i + 1 < NIT) finish(i + 1, LB);
            }
        } else {
            const int row = it - M; int t, T; if (row < MC) { t = row % SEQ; T = SEQ; } else { t = (row - MC) % DEC_SEQ; T = DEC_SEQ; }
            constexpr int NCH = SXBC / 8, NIT = (NCH + 63) / 64;
            struct TapLd { u32x4 t[5]; };
            auto issue = [&](int i, TapLd& L) { const int ch = c.lane + 64 * i; const int col = ch < NCH ? 8 * ch : 0;
#pragma unroll
                for (int q = 0; q < 5; ++q) { const int tt = t + q - 2; L.t[q] = (tt >= 0 && tt < T) ? ld8(ZB + (size_t)(row + q - 2) * ZB_LD + SW + col) : (u32x4){0u, 0u, 0u, 0u}; } };
            auto finish = [&](int i, const TapLd& L) { const int ch = c.lane + 64 * i; if (ch >= NCH) return; const int col = 8 * ch; float a[8];
                const float* cb = c.in(I_SCB) + (size_t)l * SXBC + col;
#pragma unroll
                for (int j = 0; j < 8; ++j) a[j] = cb[j];
#pragma unroll
                for (int q = 0; q < 5; ++q) { float f[8]; unpack8(L.t[q], f);
                    const float* cw = c.in(I_SCW) + ((size_t)l * 5 + q) * SXBC + col;
#pragma unroll
                    for (int j = 0; j < 8; ++j) a[j] += cw[j] * f[j]; }
#pragma unroll
                for (int j = 0; j < 8; ++j) a[j] = siluf_(a[j]);
                st8(XBC + (size_t)row * SXBC + col, pack8(a)); };
            TapLd LA, LB; issue(0, LA);
#pragma unroll 1
            for (int i = 0; i < NIT; i += 2) {
                if (i + 1 < NIT) issue(i + 1, LB);
                finish(i, LA);
                if (i + 2 < NIT) issue(i + 2, LA);
                if (i + 1 < NIT) finish(i + 1, LB);
            }
            if (c.lane < SH) { const float raw = bf1(ZB[(size_t)row * ZB_LD + SW + SXBC + c.lane]);
#pragma unroll
                for (int d = 0; d < 2; ++d) DT[((size_t)d * M + row) * SH + c.lane] = softplusf_(raw + c.in(I_SDTB)[(size_t)(l * 2 + d) * SH + c.lane]); }
        }
    }
}

constexpr int TB = 32;
static_assert(SEQ % TB == 0 && DEC_SEQ % TB == 0, "scan block");
DEV void rwkv_chain(const Ctx& c, int l, bool lat, int b, int h, int d) {
    const int T = lat ? DEC_SEQ : SEQ, row0 = lat ? MC + b * DEC_SEQ : b * SEQ, nblk = T / TB;
    const bf16_t* XS = c.ws<bf16_t>(WS_XS); const bf16_t* KK = c.ws<bf16_t>(WS_KK);
    const bf16_t* OMD = c.ws<bf16_t>(WS_OMD) + (size_t)d * M * RW; const bf16_t* KD = c.ws<bf16_t>(WS_KD) + (size_t)d * M * RW; const bf16_t* BB = c.ws<bf16_t>(WS_BB) + (size_t)d * M * RW;
    bf16_t* O = c.ws<bf16_t>(WS_O) + (size_t)d * M * RW;
    LAS float* VEC = (LAS float*)c.lds;
    LAS float* OUTS = (LAS float*)(c.lds + 2 * TB * 6 * 64 * 4);
    const int vrow = c.tid >> 3, cg = c.tid & 7;
    f32x2 s2[4];
    if (lat) { const float* s0 = c.in(I_SRWKV) + ((((size_t)b * DEPTH + l) * 2 + d) * RH + h) * 4096 + vrow * 64 + cg * 8;
#pragma unroll
        for (int j = 0; j < 4; ++j) s2[j] = (f32x2){s0[2 * j], s0[2 * j + 1]}; }
    else {
#pragma unroll
        for (int j = 0; j < 4; ++j) s2[j] = (f32x2){0.f, 0.f}; }
    u32x4 stg[3];
    auto gload = [&](int blk) {
#pragma unroll
        for (int q = 0; q < 3; ++q) { const int task = c.tid + NTHREADS * q, i = task / 48, rem = task % 48, vec = rem >> 3, cc = rem & 7;
            const int st = blk * TB + i, row = row0 + (d ? T - 1 - st : st); const size_t hc = (size_t)h * 64 + cc * 8;
            const bf16_t* p = vec == 0 ? XS + (size_t)row * 3 * RW + hc : vec == 1 ? OMD + (size_t)row * RW + hc : vec == 2 ? KD + (size_t)row * RW + hc : vec == 3 ? BB + (size_t)row * RW + hc : vec == 4 ? KK + (size_t)row * RW + hc : XS + (size_t)row * 3 * RW + 2 * RW + hc;
            stg[q] = ld8(p); } };
    auto lstore = [&](int buf) {
#pragma unroll
        for (int q = 0; q < 3; ++q) { const int task = c.tid + NTHREADS * q, i = task / 48, rem = task % 48, vec = rem >> 3, cc = rem & 7; float f[8]; unpack8(stg[q], f);
            if (vec == 1) {
#pragma unroll
                for (int j = 0; j < 8; ++j) f[j] = 1.0f - f[j]; }
            LAS float* dst = VEC + ((buf * TB + i) * 6 + vec) * 64 + cc * 8; *(LAS f32x4*)dst = (f32x4){f[0], f[1], f[2], f[3]}; *(LAS f32x4*)(dst + 4) = (f32x4){f[4], f[5], f[6], f[7]}; } };
    gload(0); lstore(0); wg_sync();
    for (int blk = 0; blk < nblk; ++blk) {
        const int buf = blk & 1;
        if (blk + 1 < nblk) gload(blk + 1);
        struct RwOps { f32x4 r0, r1, w0, w1, k0, k1, b0, b1, q0, q1; float vv; };
#define RW_LOAD(X, i_) do { const LAS float* V_ = VEC + (buf * TB + (i_)) * 6 * 64 + cg * 8; \
            X.r0 = *(const LAS f32x4*)(V_); X.r1 = *(const LAS f32x4*)(V_ + 4); X.w0 = *(const LAS f32x4*)(V_ + 64); X.w1 = *(const LAS f32x4*)(V_ + 68); X.k0 = *(const LAS f32x4*)(V_ + 128); X.k1 = *(const LAS f32x4*)(V_ + 132); \
            X.b0 = *(const LAS f32x4*)(V_ + 192); X.b1 = *(const LAS f32x4*)(V_ + 196); X.q0 = *(const LAS f32x4*)(V_ + 256); X.q1 = *(const LAS f32x4*)(V_ + 260); X.vv = VEC[((buf * TB + (i_)) * 6 + 5) * 64 + vrow]; } while (0)
#define RW_STEP(X, i_) do { \
            f32x2 a2 = s2[0] * PR(X.q0, 0); a2 = s2[1] * PR(X.q0, 1) + a2; a2 = s2[2] * PR(X.q1, 0) + a2; a2 = s2[3] * PR(X.q1, 1) + a2; \
            const float skk = red8(a2.x + a2.y); const f32x2 v2 = (f32x2){X.vv, X.vv}, n2 = (f32x2){-skk, -skk}; \
            s2[0] = s2[0] * PR(X.w0, 0) + (n2 * PR(X.b0, 0) + v2 * PR(X.k0, 0)); s2[1] = s2[1] * PR(X.w0, 1) + (n2 * PR(X.b0, 1) + v2 * PR(X.k0, 1)); \
            s2[2] = s2[2] * PR(X.w1, 0) + (n2 * PR(X.b1, 0) + v2 * PR(X.k1, 0)); s2[3] = s2[3] * PR(X.w1, 1) + (n2 * PR(X.b1, 1) + v2 * PR(X.k1, 1)); \
            f32x2 o2 = s2[0] * PR(X.r0, 0); o2 = s2[1] * PR(X.r0, 1) + o2; o2 = s2[2] * PR(X.r1, 0) + o2; o2 = s2[3] * PR(X.r1, 1) + o2; \
            const float o = red8(o2.x + o2.y); if (cg == 0) OUTS[(i_) * 64 + vrow] = o; } while (0)
        static_assert(TB % 2 == 0, "paired steps");
        RwOps A, B; RW_LOAD(A, 0);
#pragma unroll 1
        for (int i = 0; i < TB; i += 2) {
            RW_LOAD(B, i + 1); RW_STEP(A, i);
            if (i + 2 < TB) RW_LOAD(A, i + 2);
            RW_STEP(B, i + 1);
        }
#undef RW_STEP
#undef RW_LOAD
        wg_sync();
        { const int i = c.tid >> 4, c4 = (c.tid & 15) * 4, st = blk * TB + i, row = row0 + (d ? T - 1 - st : st); const f32x4 v = *(const LAS f32x4*)(OUTS + i * 64 + c4);
          u32x2 w; w.x = pk2(v.x, v.y); w.y = pk2(v.z, v.w); *(u32x2*)(O + (size_t)row * RW + h * 64 + c4) = w; }
        if (blk + 1 < nblk) lstore(buf ^ 1);
        wg_sync();
    }
    if (!lat) { float* o = c.out() + OUT_RWKV + ((((size_t)b * DEPTH + l) * 2 + d) * RH + h) * 4096 + vrow * 64 + cg * 8;
        *(f32x4*)o = (f32x4){s2[0].x, s2[0].y, s2[1].x, s2[1].y}; *(f32x4*)(o + 4) = (f32x4){s2[2].x, s2[2].y, s2[3].x, s2[3].y}; }
}
typedef _Float16 h2_t __attribute__((ext_vector_type(2)));
#ifdef CPU_EMU
DEV h2_t hfma2(h2_t a, h2_t b, h2_t c) { h2_t r; r.x = (_Float16)((float)a.x * (float)b.x + (float)c.x); r.y = (_Float16)((float)a.y * (float)b.y + (float)c.y); return r; }
DEV float hdot2(h2_t a, h2_t b, float c) { return (float)a.x * (float)b.x + ((float)a.y * (float)b.y + c); }
#else
DEV h2_t hfma2(h2_t a, h2_t b, h2_t c) { return __builtin_elementwise_fma(a, b, c); }
DEV float hdot2(h2_t a, h2_t b, float c) { return __builtin_amdgcn_fdot2(a, b, c, false); }
#endif
DEV unsigned pkh2(float lo, float hi) { h2_t v; v.x = (_Float16)lo; v.y = (_Float16)hi; return __builtin_bit_cast(unsigned, v); }
DEV h2_t ash2(unsigned w) { return __builtin_bit_cast(h2_t, w); }
constexpr int TBH = 64;
static_assert(DEC_SEQ % TBH == 0 && 2 * TBH * 6 * 64 * 2 + (TBH + 1) * 64 * 4 <= LDS_MISC, "half rwkv chain blocks");
DEV void rwkv_chain_h(const Ctx& c, int l, int b, int h, int d) {
    constexpr int T = DEC_SEQ, nblk = T / TBH; const int row0 = MC + b * DEC_SEQ;
    const bf16_t* XS = c.ws<bf16_t>(WS_XS); const bf16_t* KK = c.ws<bf16_t>(WS_KK);
    const bf16_t* OMD = c.ws<bf16_t>(WS_OMD) + (size_t)d * M * RW; const bf16_t* KD = c.ws<bf16_t>(WS_KD) + (size_t)d * M * RW; const bf16_t* BB = c.ws<bf16_t>(WS_BB) + (size_t)d * M * RW;
    bf16_t* O = c.ws<bf16_t>(WS_O) + (size_t)d * M * RW;
    LAS unsigned* VEC = (LAS unsigned*)c.lds;
    LAS float* OUTS = (LAS float*)(c.lds + 2 * TBH * 6 * 64 * 2);
    const int vrow = c.tid >> 3, cg = c.tid & 7;
    h2_t s2[4];
    { const float* s0 = c.in(I_SRWKV) + ((((size_t)b * DEPTH + l) * 2 + d) * RH + h) * 4096 + vrow * 64 + cg * 8;
#pragma unroll
      for (int j = 0; j < 4; ++j) s2[j] = ash2(pkh2(s0[2 * j], s0[2 * j + 1])); }
    constexpr int NQ = TBH * 48 / NTHREADS; static_assert(TBH * 48 % NTHREADS == 0, "staging tasks");
    u32x4 stg[NQ];
    auto gload = [&](int blk) {
#pragma unroll
        for (int q = 0; q < NQ; ++q) { const int task = c.tid + NTHREADS * q, i = task / 48, rem = task % 48, vec = rem >> 3, cc = rem & 7;
            const int st = blk * TBH + i, row = row0 + (d ? T - 1 - st : st); const size_t hc = (size_t)h * 64 + cc * 8;
            const bf16_t* p = vec == 0 ? XS + (size_t)row * 3 * RW + hc : vec == 1 ? OMD + (size_t)row * RW + hc : vec == 2 ? KD + (size_t)row * RW + hc : vec == 3 ? BB + (size_t)row * RW + hc : vec == 4 ? KK + (size_t)row * RW + hc : XS + (size_t)row * 3 * RW + 2 * RW + hc;
            stg[q] = ld8(p); } };
    auto lstore = [&](int buf) {
#pragma unroll
        for (int q = 0; q < NQ; ++q) { const int task = c.tid + NTHREADS * q, i = task / 48, rem = task % 48, vec = rem >> 3, cc = rem & 7; float f[8]; unpack8(stg[q], f);
            if (vec == 1) {
#pragma unroll
                for (int j = 0; j < 8; ++j) f[j] = 1.0f - f[j]; }
            u32x4 o; o.x = pkh2(f[0], f[1]); o.y = pkh2(f[2], f[3]); o.z = pkh2(f[4], f[5]); o.w = pkh2(f[6], f[7]);
            *(LAS u32x4*)(VEC + ((buf * TBH + i) * 6 + vec) * 32 + cc * 4) = o; } };
    gload(0); lstore(0); wg_sync();
    for (int blk = 0; blk < nblk; ++blk) {
        const int buf = blk & 1;
        if (blk + 1 < nblk) gload(blk + 1);
        struct RwH { u32x4 r, w, k, b, q; unsigned vv; };
#define RH_LOAD(X, i_) do { const LAS unsigned* V_ = VEC + (buf * TBH + (i_)) * 6 * 32 + cg * 4; \
            X.r = *(const LAS u32x4*)(V_); X.w = *(const LAS u32x4*)(V_ + 32); X.k = *(const LAS u32x4*)(V_ + 64); X.b = *(const LAS u32x4*)(V_ + 96); X.q = *(const LAS u32x4*)(V_ + 128); \
            X.vv = ((const LAS unsigned short*)(VEC + ((buf * TBH + (i_)) * 6 + 5) * 32))[vrow]; } while (0)
#define RH_STEP(X, i_) do { \
            float sa = hdot2(s2[0], ash2(X.q.x), 0.f); sa = hdot2(s2[1], ash2(X.q.y), sa); sa = hdot2(s2[2], ash2(X.q.z), sa); sa = hdot2(s2[3], ash2(X.q.w), sa); \
            const float skk = red8(sa); const h2_t n2 = ash2(pkh2(-skk, -skk)), v2 = ash2(X.vv | (X.vv << 16)); \
            s2[0] = hfma2(s2[0], ash2(X.w.x), hfma2(v2, ash2(X.k.x), n2 * ash2(X.b.x))); s2[1] = hfma2(s2[1], ash2(X.w.y), hfma2(v2, ash2(X.k.y), n2 * ash2(X.b.y))); \
            s2[2] = hfma2(s2[2], ash2(X.w.z), hfma2(v2, ash2(X.k.z), n2 * ash2(X.b.z))); s2[3] = hfma2(s2[3], ash2(X.w.w), hfma2(v2, ash2(X.k.w), n2 * ash2(X.b.w))); \
            float o = hdot2(s2[0], ash2(X.r.x), 0.f); o = hdot2(s2[1], ash2(X.r.y), o); o = hdot2(s2[2], ash2(X.r.z), o); o = hdot2(s2[3], ash2(X.r.w), o); \
            o = red8(o); OUTS[cg == 0 ? (i_) * 64 + vrow : TBH * 64 + (c.tid & 63)] = o; } while (0)
        RwH A, B; RH_LOAD(A, 0);
#pragma unroll 1
        for (int i = 0; i < TBH; i += 2) {
            RH_LOAD(B, i + 1); RH_STEP(A, i);
            RH_LOAD(A, i + 2);
            RH_STEP(B, i + 1);
        }
#undef RH_STEP
#undef RH_LOAD
        wg_sync();
#pragma unroll
        for (int e = 0; e < TBH / 32; ++e) { const int i = (c.tid >> 4) + 32 * e, c4 = (c.tid & 15) * 4, st = blk * TBH + i, row = row0 + (d ? T - 1 - st : st); const f32x4 v = *(const LAS f32x4*)(OUTS + i * 64 + c4);
          u32x2 w; w.x = pk2(v.x, v.y); w.y = pk2(v.z, v.w); *(u32x2*)(O + (size_t)row * RW + h * 64 + c4) = w; }
        if (blk + 1 < nblk) lstore(buf ^ 1);
        wg_sync();
    }
}
DEV void ssd_chain(const Ctx& c, int l, bool lat, int b, int h, int d) {
    const int T = lat ? DEC_SEQ : SEQ, row0 = lat ? MC + b * DEC_SEQ : b * SEQ, nblk = T / TB, g = h / SHG;
    const bf16_t* XBC = c.ws<bf16_t>(WS_XBC); const float* DT = c.ws<float>(WS_DT) + (size_t)d * M * SH; bf16_t* Y = c.ws<bf16_t>(WS_YSSD) + (size_t)d * M * SW;
    const float aneg = -expf(c.in(I_SALOG)[(size_t)(l * 2 + d) * SH + h]);
    constexpr int BCS = 320;
    LAS float* BC = (LAS float*)c.lds;
    LAS float* XD = BC + 2 * TB * BCS;
    LAS float* DC = XD + 2 * TB * 64;
    LAS float* OUTS = DC + 2 * TB;
    const int p = c.tid >> 3, ng = c.tid & 7;
    f32x2 s2[8];
    if (lat) { const float* s0 = c.in(I_SSSD) + (((((size_t)b * DEPTH + l) * 2 + d) * SH + h) * 64 + p) * SN + ng * 16;
#pragma unroll
        for (int j = 0; j < 8; ++j) s2[j] = (f32x2){s0[2 * j], s0[2 * j + 1]}; }
    else {
#pragma unroll
        for (int j = 0; j < 8; ++j) s2[j] = (f32x2){0.f, 0.f}; }
    u32x4 stg[3]; float dtv = 0.f;
    auto rowof = [&](int blk, int i) { const int st = blk * TB + i; return row0 + (d ? T - 1 - st : st); };
    auto gload = [&](int blk) {
#pragma unroll
        for (int q = 0; q < 2; ++q) { const int task = c.tid + NTHREADS * q, i = task >> 5, cc = task & 31, row = rowof(blk, i);
            stg[q] = ld8(XBC + (size_t)row * SXBC + SW + (cc < 16 ? g * SN + cc * 8 : SG * SN + g * SN + (cc - 16) * 8)); }
        if (c.tid < TB * 8) { const int i = c.tid >> 3, cc = c.tid & 7, row = rowof(blk, i); stg[2] = ld8(XBC + (size_t)row * SXBC + h * 64 + cc * 8); dtv = DT[(size_t)row * SH + h]; } };
    auto lstore = [&](int buf) {
#pragma unroll
        for (int q = 0; q < 2; ++q) { const int task = c.tid + NTHREADS * q, i = task >> 5, cc = task & 31; float f[8]; unpack8(stg[q], f);
            LAS float* dst = BC + (buf * TB + i) * BCS + (cc >> 1) * 20 + (cc & 1) * 8; *(LAS f32x4*)dst = (f32x4){f[0], f[1], f[2], f[3]}; *(LAS f32x4*)(dst + 4) = (f32x4){f[4], f[5], f[6], f[7]}; }
        if (c.tid < TB * 8) { const int i = c.tid >> 3, cc = c.tid & 7; float f[8]; unpack8(stg[2], f);
            LAS float* dst = XD + (buf * TB + i) * 64 + cc * 8; *(LAS f32x4*)dst = (f32x4){f[0] * dtv, f[1] * dtv, f[2] * dtv, f[3] * dtv}; *(LAS f32x4*)(dst + 4) = (f32x4){f[4] * dtv, f[5] * dtv, f[6] * dtv, f[7] * dtv};
            if (cc == 0) DC[buf * TB + i] = expf(dtv * aneg); } };
    gload(0); lstore(0); wg_sync();
    for (int blk = 0; blk < nblk; ++blk) {
        const int buf = blk & 1;
        if (blk + 1 < nblk) gload(blk + 1);
        struct SsOps { f32x4 bv[4], cv[4]; float xd, dec; };
#define SS_LOAD(X, i_) do { const LAS float* Bp_ = BC + (buf * TB + (i_)) * BCS + ng * 20; \
            _Pragma("unroll") for (int q_ = 0; q_ < 4; ++q_) { X.bv[q_] = *(const LAS f32x4*)(Bp_ + 4 * q_); X.cv[q_] = *(const LAS f32x4*)(Bp_ + 160 + 4 * q_); } \
            X.xd = XD[(buf * TB + (i_)) * 64 + p]; X.dec = DC[buf * TB + (i_)]; } while (0)
#define SS_STEP(X, i_) do { const f32x2 xd2 = (f32x2){X.xd, X.xd}, dec2 = (f32x2){X.dec, X.dec}; f32x2 y2 = (f32x2){0.f, 0.f}; \
            _Pragma("unroll") for (int q_ = 0; q_ < 4; ++q_) { _Pragma("unroll") for (int hh = 0; hh < 2; ++hh) { s2[2 * q_ + hh] = s2[2 * q_ + hh] * dec2 + xd2 * PR(X.bv[q_], hh); y2 = s2[2 * q_ + hh] * PR(X.cv[q_], hh) + y2; } } \
            const float y = red8(y2.x + y2.y); if (ng == 0) OUTS[(i_) * 64 + p] = y; } while (0)
        SsOps A, B; SS_LOAD(A, 0);
#pragma unroll 1
        for (int i = 0; i < TB; i += 2) {
            SS_LOAD(B, i + 1); SS_STEP(A, i);
            if (i + 2 < TB) SS_LOAD(A, i + 2);
            SS_STEP(B, i + 1);
        }
#undef SS_STEP
#undef SS_LOAD
        wg_sync();
        { const int i = c.tid >> 4, c4 = (c.tid & 15) * 4, row = rowof(blk, i); const f32x4 v = *(const LAS f32x4*)(OUTS + i * 64 + c4);
          u32x2 w; w.x = pk2(v.x, v.y); w.y = pk2(v.z, v.w); *(u32x2*)(Y + (size_t)row * SW + h * 64 + c4) = w; }
        if (blk + 1 < nblk) lstore(buf ^ 1);
        wg_sync();
    }
    if (!lat) { float* o = c.out() + OUT_SSD + (((((size_t)b * DEPTH + l) * 2 + d) * SH + h) * 64 + p) * SN + ng * 16;
#pragma unroll
        for (int q = 0; q < 4; ++q) *(f32x4*)(o + 4 * q) = (f32x4){s2[2 * q].x, s2[2 * q].y, s2[2 * q + 1].x, s2[2 * q + 1].y}; }
}
DEV void s5_carry(const Ctx& c, int l, bool lat, int b, int g, int d) {
    const int T = lat ? DEC_SEQ : SEQ, nch = T / S5L, r0 = (lat ? MC + b * DEC_SEQ : b * SEQ) / S5L, p = c.lane;
    const float* SE = c.ws<float>(WS_SE) + (size_t)g * MCH * 256 + d * 128; bf16_t* SIN = c.ws<bf16_t>(WS_SIN) + (size_t)g * MCH * 256 + d * 128;
    const size_t gp = ((size_t)(l * 2 + d) * CG + g) * CP + p; const float delta = expf(c.in(I_CLDT)[(size_t)(l * 2 + d) * CG + g]);
    const float rho = c.in(I_CLRE)[gp] * delta * (float)S5L, th = c.in(I_CLIM)[gp] * delta * (float)S5L, mag = expf(rho), lr = mag * cosf(th), li = mag * sinf(th);
    float sr = 0.f, si = 0.f;
    if (lat) { const size_t so = (((size_t)b * DEPTH + l) * 2 + d) * CG * CP + (size_t)g * CP + p; sr = c.in(I_SRE)[so]; si = c.in(I_SIM)[so]; }
    constexpr int UB = 4; static_assert((SEQ / S5L) % UB == 0 && (DEC_SEQ / S5L) % UB == 0, "carry unroll");
    for (int cb = 0; cb < nch; cb += UB) {
        float er[UB], ei[UB];
#pragma unroll
        for (int q = 0; q < UB; ++q) { const int ch = d ? nch - 1 - (cb + q) : cb + q; er[q] = SE[(size_t)(r0 + ch) * 256 + p]; ei[q] = SE[(size_t)(r0 + ch) * 256 + 64 + p]; }
#pragma unroll
        for (int q = 0; q < UB; ++q) { const int ch = d ? nch - 1 - (cb + q) : cb + q; bf16_t* o = SIN + (size_t)(r0 + ch) * 256;
            o[p] = (bf16_t)f2bf(sr); o[64 + p] = (bf16_t)f2bf(si);
            const float nr = lr * sr - li * si + er[q], ni = lr * si + li * sr + ei[q]; sr = nr; si = ni; }
    }
    if (!lat) { const size_t so = (((size_t)b * DEPTH + l) * 2 + d) * CG * CP + (size_t)g * CP + p; c.out()[OUT_RE + so] = sr; c.out()[OUT_IM + so] = si; }
}
#ifdef CPU_EMU
#define MFMA16(a, b, c) emu_mfma16(a, b, c)
#else
#define MFMA16(a, b, c) __builtin_amdgcn_mfma_f32_16x16x32_bf16(a, b, c, 0, 0, 0)
#endif
constexpr int SCH = 64;
static_assert(SEQ % SCH == 0 && DEC_SEQ % SCH == 0 && SN == 128, "ssd chunking");
DEV void ssd_mfma_chain(const Ctx& c, int l, bool lat, int b, int h, int d) {
    const int T = lat ? DEC_SEQ : SEQ, row0 = lat ? MC + b * DEC_SEQ : b * SEQ, nch = T / SCH, g = h / SHG;
    const bf16_t* XBC = c.ws<bf16_t>(WS_XBC); const float* DT = c.ws<float>(WS_DT) + (size_t)d * M * SH; bf16_t* Y = c.ws<bf16_t>(WS_YSSD) + (size_t)d * M * SW;
    const float aneg = -expf(c.in(I_SALOG)[(size_t)(l * 2 + d) * SH + h]);
    constexpr int LDC = 136, LDX = 72;
    LAS bf16_t* Cs = (LAS bf16_t*)c.lds;
    LAS bf16_t* Bs = Cs + 64 * LDC;
    LAS bf16_t* Sb = Bs + 64 * LDC;
    LAS bf16_t* Bt = Sb + 64 * LDC;
    LAS bf16_t* Xt = Bt + 128 * LDX;
    LAS bf16_t* Xdt = Xt + 64 * LDX;
    LAS bf16_t* Ms = Xdt + 64 * LDX;
    LAS bf16_t* Ys = Ms + 64 * LDX;
    LAS bf16_t* Xs = Ys + 64 * LDX;
    LAS float* CUM = (LAS float*)(Xs + 64 * LDX);
    LAS float* DTV = CUM + 64;
    LAS float* WEND = DTV + 64;
    const int w = c.wave, lane = c.lane, r = lane & 15, q = lane >> 4;
    auto rowof = [&](int st) { return row0 + (d ? T - 1 - st : st); };
    f32x4 accS[4];
#pragma unroll
    for (int j = 0; j < 4; ++j) { const int ti = 4 * w + j, pt = ti >> 3, nt = ti & 7, p = 16 * pt + r, n0 = 16 * nt + 4 * q;
        accS[j] = lat ? *(const f32x4*)(c.in(I_SSSD) + (((((size_t)b * DEPTH + l) * 2 + d) * SH + h) * 64 + p) * SN + n0) : (f32x4){0.f, 0.f, 0.f, 0.f};
        u32x2 o; o.x = pk2(accS[j][0], accS[j][1]); o.y = pk2(accS[j][2], accS[j][3]); *(LAS u32x2*)(Sb + p * LDC + n0) = o; }
    u32x4 cR[2], bR[2], xR; float dtj = 0.f;
    auto prefetch = [&](int ck) {
#pragma unroll
        for (int e = 0; e < 2; ++e) { const int id = c.tid + NTHREADS * e, j = id >> 4, nc = (id & 15) * 8; const size_t ro = (size_t)rowof(ck * SCH + j) * SXBC + SW;
            cR[e] = ld8(XBC + ro + SG * SN + g * SN + nc); bR[e] = ld8(XBC + ro + g * SN + nc); }
        { const int j = c.tid >> 3, pc = (c.tid & 7) * 8; xR = ld8(XBC + (size_t)rowof(ck * SCH + j) * SXBC + h * 64 + pc); }
        dtj = DT[(size_t)rowof(ck * SCH + lane) * SH + h]; };
    prefetch(0);
    for (int ck = 0; ck < nch; ++ck) {
        float cum = dtj * aneg;
#pragma unroll
        for (int off = 1; off < 64; off <<= 1) { const float t = __shfl(cum, lane >= off ? lane - off : lane); if (lane >= off) cum += t; }
        const float cumL = __shfl(cum, 63), wend = dtj * __expf(cumL - cum), decL = __expf(cumL);
        if (w == 0) { CUM[lane] = cum; DTV[lane] = dtj; WEND[lane] = wend; }
#pragma unroll
        for (int e = 0; e < 2; ++e) { const int id = c.tid + NTHREADS * e, j = id >> 4, nc = (id & 15) * 8; *(LAS u32x4*)(Cs + j * LDC + nc) = cR[e]; *(LAS u32x4*)(Bs + j * LDC + nc) = bR[e]; }
        { const int j = c.tid >> 3, pc = (c.tid & 7) * 8; *(LAS u32x4*)(Xs + j * LDX + pc) = xR; }
        wg_sync();
#pragma unroll
        for (int e = 0; e < 2; ++e) { const int id = c.tid + NTHREADS * e, n = id & 127, s0 = (id >> 7) * 8; unsigned short v[8];
#pragma unroll
            for (int k = 0; k < 8; ++k) v[k] = Bs[(s0 + k) * LDC + n];
            u32x4 o; o.x = v[0] | ((unsigned)v[1] << 16); o.y = v[2] | ((unsigned)v[3] << 16); o.z = v[4] | ((unsigned)v[5] << 16); o.w = v[6] | ((unsigned)v[7] << 16); *(LAS u32x4*)(Bt + n * LDX + s0) = o; }
        { const int p = c.tid & 63, s0 = (c.tid >> 6) * 8; unsigned short v[8]; float f[8];
#pragma unroll
            for (int k = 0; k < 8; ++k) { v[k] = Xs[(s0 + k) * LDX + p]; f[k] = bf1(v[k]) * WEND[s0 + k]; }
            u32x4 o; o.x = v[0] | ((unsigned)v[1] << 16); o.y = v[2] | ((unsigned)v[3] << 16); o.z = v[4] | ((unsigned)v[5] << 16); o.w = v[6] | ((unsigned)v[7] << 16); *(LAS u32x4*)(Xt + p * LDX + s0) = o;
            *(LAS u32x4*)(Xdt + p * LDX + s0) = pack8(f); }
        wg_sync();
        if (ck + 1 < nch) prefetch(ck + 1);
#pragma unroll
        for (int e = 0; e < 2; ++e) { const int ti = 2 * w + e, tt = ti >> 2, st = ti & 3; f32x4 acc = (f32x4){0.f, 0.f, 0.f, 0.f};
            if (st <= tt) {
#pragma unroll
                for (int ks = 0; ks < 4; ++ks) acc = MFMA16(*(const LAS bf16x8*)(Bs + (16 * st + r) * LDC + 32 * ks + 8 * q), *(const LAS bf16x8*)(Cs + (16 * tt + r) * LDC + 32 * ks + 8 * q), acc); }
            const int t = 16 * tt + r, s0 = 16 * st + 4 * q; const float ct = CUM[t]; float v[4];
#pragma unroll
            for (int i = 0; i < 4; ++i) v[i] = s0 + i <= t ? acc[i] * __expf(ct - CUM[s0 + i]) * DTV[s0 + i] : 0.f;
            u32x2 o; o.x = pk2(v[0], v[1]); o.y = pk2(v[2], v[3]); *(LAS u32x2*)(Ms + t * LDX + s0) = o; }
        wg_sync();
#pragma unroll
        for (int e = 0; e < 2; ++e) { const int ti = 2 * w + e, tt = ti >> 2, pt = ti & 3; f32x4 a1 = (f32x4){0.f, 0.f, 0.f, 0.f}, a2 = a1;
#pragma unroll
            for (int ks = 0; ks < 2; ++ks) a1 = MFMA16(*(const LAS bf16x8*)(Xt + (16 * pt + r) * LDX + 32 * ks + 8 * q), *(const LAS bf16x8*)(Ms + (16 * tt + r) * LDX + 32 * ks + 8 * q), a1);
#pragma unroll
            for (int ks = 0; ks < 4; ++ks) a2 = MFMA16(*(const LAS bf16x8*)(Sb + (16 * pt + r) * LDC + 32 * ks + 8 * q), *(const LAS bf16x8*)(Cs + (16 * tt + r) * LDC + 32 * ks + 8 * q), a2);
            const int t = 16 * tt + r; const float ec = __expf(CUM[t]); u32x2 o; o.x = pk2(a1[0] + ec * a2[0], a1[1] + ec * a2[1]); o.y = pk2(a1[2] + ec * a2[2], a1[3] + ec * a2[3]); *(LAS u32x2*)(Ys + t * LDX + 16 * pt + 4 * q) = o; }
#pragma unroll
        for (int j = 0; j < 4; ++j) { const int ti = 4 * w + j, pt = ti >> 3, nt = ti & 7; accS[j] = accS[j] * decL;
#pragma unroll
            for (int ks = 0; ks < 2; ++ks) accS[j] = MFMA16(*(const LAS bf16x8*)(Bt + (16 * nt + r) * LDX + 32 * ks + 8 * q), *(const LAS bf16x8*)(Xdt + (16 * pt + r) * LDX + 32 * ks + 8 * q), accS[j]); }
        wg_sync();
#pragma unroll
        for (int j = 0; j < 4; ++j) { const int ti = 4 * w + j, pt = ti >> 3, nt = ti & 7; u32x2 o; o.x = pk2(accS[j][0], accS[j][1]); o.y = pk2(accS[j][2], accS[j][3]); *(LAS u32x2*)(Sb + (16 * pt + r) * LDC + 16 * nt + 4 * q) = o; }
        { const int t = c.tid >> 3, pc = (c.tid & 7) * 8; *(u32x4*)(Y + (size_t)rowof(ck * SCH + t) * SW + h * 64 + pc) = *(const LAS u32x4*)(Ys + t * LDX + pc); }
    }
    if (!lat) {
#pragma unroll
        for (int j = 0; j < 4; ++j) { const int ti = 4 * w + j, pt = ti >> 3, nt = ti & 7; *(f32x4*)(c.out() + OUT_SSD + (((((size_t)b * DEPTH + l) * 2 + d) * SH + h) * 64 + 16 * pt + r) * SN + 16 * nt + 4 * q) = accS[j]; } }
    wg_sync();
}
constexpr int TQ = 8;
static_assert(SEQ % TQ == 0 && (BATCH * RH * 2) % 4 == 0 && (BATCH * SH * 2) % 4 == 0, "quad scan shapes");
DEV void rwkv_quad(const Ctx& c, int l, int q) {
    constexpr int T = SEQ, nblk = T / TQ;
    const bf16_t* XS = c.ws<bf16_t>(WS_XS); const bf16_t* KK = c.ws<bf16_t>(WS_KK); const bf16_t* OMD = c.ws<bf16_t>(WS_OMD); const bf16_t* KD = c.ws<bf16_t>(WS_KD); const bf16_t* BB = c.ws<bf16_t>(WS_BB); bf16_t* O = c.ws<bf16_t>(WS_O);
    LAS float* VEC = (LAS float*)c.lds;
    LAS float* OUTS = VEC + 2 * 4 * TQ * 6 * 64;
    const int sg = c.tid >> 7, tg = c.tid & 127, rg = tg >> 3, cg = tg & 7;
    f32x2 s2[4][4];
#pragma unroll
    for (int rr = 0; rr < 4; ++rr)
#pragma unroll
        for (int j = 0; j < 4; ++j) s2[rr][j] = (f32x2){0.f, 0.f};
    u32x4 stg[3];
    auto gload = [&](int blk) {
#pragma unroll
        for (int qq = 0; qq < 3; ++qq) { const int task = c.tid + NTHREADS * qq, cq = task / (TQ * 48), rem = task % (TQ * 48), i = rem / 48, vec = (rem % 48) >> 3, cc = rem & 7;
            const int ch = 4 * q + cq, b = ch / (RH * 2), h = (ch >> 1) % RH, d = ch & 1, st = blk * TQ + i, row = b * SEQ + (d ? T - 1 - st : st); const size_t hc = (size_t)h * 64 + cc * 8, dm = (size_t)d * M * RW;
            const bf16_t* p = vec == 0 ? XS + (size_t)row * 3 * RW + hc : vec == 1 ? OMD + dm + (size_t)row * RW + hc : vec == 2 ? KD + dm + (size_t)row * RW + hc : vec == 3 ? BB + dm + (size_t)row * RW + hc : vec == 4 ? KK + (size_t)row * RW + hc : XS + (size_t)row * 3 * RW + 2 * RW + hc;
            stg[qq] = ld8(p); } };
    auto lstore = [&](int buf) {
#pragma unroll
        for (int qq = 0; qq < 3; ++qq) { const int task = c.tid + NTHREADS * qq, cq = task / (TQ * 48), rem = task % (TQ * 48), i = rem / 48, vec = (rem % 48) >> 3, cc = rem & 7; float f[8]; unpack8(stg[qq], f);
            if (vec == 1) {
#pragma unroll
                for (int j = 0; j < 8; ++j) f[j] = 1.0f - f[j]; }
            LAS float* dst = VEC + ((((buf * 4 + cq) * TQ + i) * 6 + vec) * 64) + cc * 8; *(LAS f32x4*)dst = (f32x4){f[0], f[1], f[2], f[3]}; *(LAS f32x4*)(dst + 4) = (f32x4){f[4], f[5], f[6], f[7]}; } };
    gload(0); lstore(0); wg_sync();
    for (int blk = 0; blk < nblk; ++blk) {
        const int buf = blk & 1;
        if (blk + 1 < nblk) gload(blk + 1);
#pragma unroll 1
        for (int i = 0; i < TQ; ++i) {
            const LAS float* V = VEC + ((buf * 4 + sg) * TQ + i) * 6 * 64;
            const f32x4 r0 = *(const LAS f32x4*)(V + cg * 8), r1 = *(const LAS f32x4*)(V + cg * 8 + 4), w0 = *(const LAS f32x4*)(V + 64 + cg * 8), w1 = *(const LAS f32x4*)(V + 68 + cg * 8), k0 = *(const LAS f32x4*)(V + 128 + cg * 8), k1 = *(const LAS f32x4*)(V + 132 + cg * 8),
                        b0 = *(const LAS f32x4*)(V + 192 + cg * 8), b1 = *(const LAS f32x4*)(V + 196 + cg * 8), q0 = *(const LAS f32x4*)(V + 256 + cg * 8), q1 = *(const LAS f32x4*)(V + 260 + cg * 8), v4 = *(const LAS f32x4*)(V + 320 + rg * 4);
            float skk[4];
#pragma unroll
            for (int rr = 0; rr < 4; ++rr) { f32x2 a2 = s2[rr][0] * PR(q0, 0); a2 = s2[rr][1] * PR(q0, 1) + a2; a2 = s2[rr][2] * PR(q1, 0) + a2; a2 = s2[rr][3] * PR(q1, 1) + a2; skk[rr] = a2.x + a2.y; }
#pragma unroll
            for (int rr = 0; rr < 4; ++rr) skk[rr] = red8(skk[rr]);
            float o[4];
#pragma unroll
            for (int rr = 0; rr < 4; ++rr) { const f32x2 v2 = (f32x2){v4[rr], v4[rr]}, n2 = (f32x2){-skk[rr], -skk[rr]};
                s2[rr][0] = s2[rr][0] * PR(w0, 0) + (n2 * PR(b0, 0) + v2 * PR(k0, 0)); s2[rr][1] = s2[rr][1] * PR(w0, 1) + (n2 * PR(b0, 1) + v2 * PR(k0, 1));
                s2[rr][2] = s2[rr][2] * PR(w1, 0) + (n2 * PR(b1, 0) + v2 * PR(k1, 0)); s2[rr][3] = s2[rr][3] * PR(w1, 1) + (n2 * PR(b1, 1) + v2 * PR(k1, 1));
                f32x2 o2 = s2[rr][0] * PR(r0, 0); o2 = s2[rr][1] * PR(r0, 1) + o2; o2 = s2[rr][2] * PR(r1, 0) + o2; o2 = s2[rr][3] * PR(r1, 1) + o2; o[rr] = o2.x + o2.y; }
#pragma unroll
            for (int rr = 0; rr < 4; ++rr) o[rr] = red8(o[rr]);
            if (cg == 0) *(LAS f32x4*)(OUTS + (sg * TQ + i) * 64 + rg * 4) = (f32x4){o[0], o[1], o[2], o[3]};
        }
        wg_sync();
        { const int cq = c.tid >> 7, i = (c.tid >> 4) & 7, c4 = (c.tid & 15) * 4, ch = 4 * q + cq, b = ch / (RH * 2), h = (ch >> 1) % RH, d = ch & 1, st = blk * TQ + i, row = b * SEQ + (d ? T - 1 - st : st);
          const f32x4 v = *(const LAS f32x4*)(OUTS + (cq * TQ + i) * 64 + c4); u32x2 w; w.x = pk2(v.x, v.y); w.y = pk2(v.z, v.w); *(u32x2*)(O + ((size_t)d * M + row) * RW + h * 64 + c4) = w; }
        if (blk + 1 < nblk) lstore(buf ^ 1);
        wg_sync();
    }
    { const int ch = 4 * q + sg, b = ch / (RH * 2), h = (ch >> 1) % RH, d = ch & 1;
#pragma unroll
      for (int rr = 0; rr < 4; ++rr) { float* o = c.out() + OUT_RWKV + ((((size_t)b * DEPTH + l) * 2 + d) * RH + h) * 4096 + (rg * 4 + rr) * 64 + cg * 8;
          *(f32x4*)o = (f32x4){s2[rr][0].x, s2[rr][0].y, s2[rr][1].x, s2[rr][1].y}; *(f32x4*)(o + 4) = (f32x4){s2[rr][2].x, s2[rr][2].y, s2[rr][3].x, s2[rr][3].y}; } }
}
DEV void ssd_quad(const Ctx& c, int l, int q) {
    constexpr int T = SEQ, nblk = T / TQ, BCS = 320;
    const bf16_t* XBC = c.ws<bf16_t>(WS_XBC); const float* DT = c.ws<float>(WS_DT); bf16_t* Y = c.ws<bf16_t>(WS_YSSD);
    LAS float* BC = (LAS float*)c.lds;
    LAS float* XD = BC + 2 * 4 * TQ * BCS;
    LAS float* DC = XD + 2 * 4 * TQ * 64;
    LAS float* OUTS = DC + 2 * 4 * TQ;
    const int sg = c.tid >> 7, tg = c.tid & 127, pg = tg >> 3, ng = tg & 7;
    f32x2 s2[4][8];
#pragma unroll
    for (int rr = 0; rr < 4; ++rr)
#pragma unroll
        for (int j = 0; j < 8; ++j) s2[rr][j] = (f32x2){0.f, 0.f};
    u32x4 stg[3]; float dtv = 0.f, anegv = 0.f;
    auto chain_of = [&](int cq, int& b, int& h, int& d) { const int ch = 4 * q + cq; b = ch / (SH * 2); h = (ch >> 1) % SH; d = ch & 1; };
    auto gload = [&](int blk) {
#pragma unroll
        for (int qq = 0; qq < 2; ++qq) { const int task = c.tid + NTHREADS * qq, cq = task >> 8, i = (task >> 5) & 7, cc = task & 31; int b, h, d; chain_of(cq, b, h, d); const int g = h / SHG, st = blk * TQ + i, row = b * SEQ + (d ? T - 1 - st : st);
            stg[qq] = ld8(XBC + (size_t)row * SXBC + SW + (cc < 16 ? g * SN + cc * 8 : SG * SN + g * SN + (cc - 16) * 8)); }
        if (c.tid < 4 * TQ * 8) { const int cq = c.tid >> 6, i = (c.tid >> 3) & 7, cc = c.tid & 7; int b, h, d; chain_of(cq, b, h, d); const int st = blk * TQ + i, row = b * SEQ + (d ? T - 1 - st : st);
            stg[2] = ld8(XBC + (size_t)row * SXBC + h * 64 + cc * 8); dtv = DT[((size_t)d * M + row) * SH + h]; anegv = -expf(c.in(I_SALOG)[(size_t)(l * 2 + d) * SH + h]); } };
    auto lstore = [&](int buf) {
#pragma unroll
        for (int qq = 0; qq < 2; ++qq) { const int task = c.tid + NTHREADS * qq, cq = task >> 8, i = (task >> 5) & 7, cc = task & 31; float f[8]; unpack8(stg[qq], f);
            LAS float* dst = BC + ((buf * 4 + cq) * TQ + i) * BCS + (cc >> 1) * 20 + (cc & 1) * 8; *(LAS f32x4*)dst = (f32x4){f[0], f[1], f[2], f[3]}; *(LAS f32x4*)(dst + 4) = (f32x4){f[4], f[5], f[6], f[7]}; }
        if (c.tid < 4 * TQ * 8) { const int cq = c.tid >> 6, i = (c.tid >> 3) & 7, cc = c.tid & 7; float f[8]; unpack8(stg[2], f);
            LAS float* dst = XD + ((buf * 4 + cq) * TQ + i) * 64 + cc * 8; *(LAS f32x4*)dst = (f32x4){f[0] * dtv, f[1] * dtv, f[2] * dtv, f[3] * dtv}; *(LAS f32x4*)(dst + 4) = (f32x4){f[4] * dtv, f[5] * dtv, f[6] * dtv, f[7] * dtv};
            if (cc == 0) DC[(buf * 4 + cq) * TQ + i] = expf(dtv * anegv); } };
    gload(0); lstore(0); wg_sync();
    for (int blk = 0; blk < nblk; ++blk) {
        const int buf = blk & 1;
        if (blk + 1 < nblk) gload(blk + 1);
#pragma unroll 1
        for (int i = 0; i < TQ; ++i) {
            const LAS float* Bp = BC + ((buf * 4 + sg) * TQ + i) * BCS + ng * 20; f32x4 bv[4], cv[4];
#pragma unroll
            for (int k = 0; k < 4; ++k) { bv[k] = *(const LAS f32x4*)(Bp + 4 * k); cv[k] = *(const LAS f32x4*)(Bp + 160 + 4 * k); }
            const f32x4 xd4 = *(const LAS f32x4*)(XD + ((buf * 4 + sg) * TQ + i) * 64 + pg * 4); const float dec = DC[(buf * 4 + sg) * TQ + i]; const f32x2 dec2 = (f32x2){dec, dec};
            float y[4];
#pragma unroll
            for (int rr = 0; rr < 4; ++rr) { const f32x2 xd2 = (f32x2){xd4[rr], xd4[rr]}; f32x2 y2 = (f32x2){0.f, 0.f};
#pragma unroll
                for (int k = 0; k < 4; ++k) {
#pragma unroll
                    for (int hh = 0; hh < 2; ++hh) { s2[rr][2 * k + hh] = s2[rr][2 * k + hh] * dec2 + xd2 * PR(bv[k], hh); y2 = s2[rr][2 * k + hh] * PR(cv[k], hh) + y2; } }
                y[rr] = y2.x + y2.y; }
#pragma unroll
            for (int rr = 0; rr < 4; ++rr) y[rr] = red8(y[rr]);
            if (ng == 0) *(LAS f32x4*)(OUTS + (sg * TQ + i) * 64 + pg * 4) = (f32x4){y[0], y[1], y[2], y[3]};
        }
        wg_sync();
        { const int cq = c.tid >> 7, i = (c.tid >> 4) & 7, c4 = (c.tid & 15) * 4; int b, h, d; chain_of(cq, b, h, d); const int st = blk * TQ + i, row = b * SEQ + (d ? T - 1 - st : st);
          const f32x4 v = *(const LAS f32x4*)(OUTS + (cq * TQ + i) * 64 + c4); u32x2 w; w.x = pk2(v.x, v.y); w.y = pk2(v.z, v.w); *(u32x2*)(Y + ((size_t)d * M + row) * SW + h * 64 + c4) = w; }
        if (blk + 1 < nblk) lstore(buf ^ 1);
        wg_sync();
    }
    { int b, h, d; chain_of(sg, b, h, d);
#pragma unroll
      for (int rr = 0; rr < 4; ++rr) { float* o = c.out() + OUT_SSD + (((((size_t)b * DEPTH + l) * 2 + d) * SH + h) * 64 + pg * 4 + rr) * SN + ng * 16;
#pragma unroll
          for (int k = 0; k < 4; ++k) *(f32x4*)(o + 4 * k) = (f32x4){s2[rr][2 * k].x, s2[rr][2 * k].y, s2[rr][2 * k + 1].x, s2[rr][2 * k + 1].y}; } }
}
struct PoolSpan { int i0, i1; };
DEV PoolSpan pool_span(long lo, long hi, long base, int n, long cost) { PoolSpan s; s.i0 = cdiv_pos(lo - base, cost); s.i1 = cdiv_pos(hi - base, cost); if (s.i0 > n) s.i0 = n; if (s.i1 > n) s.i1 = n; return s; }
#ifndef CONV_CF0
#define CONV_CF0 80
#endif
#ifndef CONV_CF1
#define CONV_CF1 44
#endif
DEV int wq_pull(const Ctx& c, unsigned* head) {
    volatile LAS unsigned* slot = (volatile LAS unsigned*)(c.lds + LDS_MISC) + 4;
    if (c.tid == 0) {
#ifdef CPU_EMU
        *slot = (*head)++;
#else
        *slot = __hip_atomic_fetch_add(head, 1u, __ATOMIC_RELAXED, __HIP_MEMORY_SCOPE_AGENT);
#endif
    }
    wg_sync(); const int it = (int)*slot; wg_sync(); return it;
}
DEV void phase_conv_early(const Ctx& c, int l) {
    LAS float* scr = (LAS float*)(c.lds + c.wave * 16640); unsigned* head = (unsigned*)(c.a->ws + WS_CTL) + 8192 + 256 * 2 * DEPTH;
    constexpr int nchunk = (CONV_NE + 63) / 64;
    for (int ch = wq_pull(c, head); ch < nchunk; ch = wq_pull(c, head)) { for (int k = 0; k < 8; ++k) { const int r = ch * 64 + k * 8 + c.wave; if (r < CONV_NE) conv_one(c, l, false, r, scr); } wg_sync(); }
}
DEV void phase_scan(const Ctx& c, int l) {
    for (int rep = 0; rep < REP_RS; ++rep) {
        constexpr int NLR = DEC_BATCH * RH * 2, NQR = BATCH * RH * 2 / 4, NLS = DEC_BATCH * SH * 2, NCS4 = BATCH * SH * 2 / 4, NTOT = NLR + NQR + NLS + NCS4;
        (void)NTOT;
        unsigned* head = (unsigned*)(c.a->ws + WS_CTL) + 8192 + 256 * (l * 2 + rep);
        constexpr int CONV_CH = 64; const int nconv = CONV_NL + (l + 1 < DEPTH ? CONV_NE : 0), nchunk = (nconv + CONV_CH - 1) / CONV_CH;
        int ncf = l + 1 < DEPTH ? CONV_CF0 : CONV_CF1; if (ncf > c.G / 2) ncf = c.G / 2;
        LAS float* scr = (LAS float*)(c.lds + c.wave * 16640);
#define CONV_POOL() for (int ch = wq_pull(c, head + 192); ch < nchunk; ch = wq_pull(c, head + 192)) { \
            for (int k = 0; k < CONV_CH / NWAVES; ++k) { const int r = ch * CONV_CH + k * NWAVES + c.wave; if (r < nconv) { if (r < CONV_NL) conv_one(c, l, true, r, scr); else conv_one(c, l + 1, false, r - CONV_NL, scr); } } wg_sync(); }
        if (rep == 0 && c.bid >= c.G - ncf) { CONV_POOL() }
        for (int it = c.bid; it < NLR; it += c.G) rwkv_chain_h(c, l, it / (RH * 2), (it >> 1) % RH, it & 1);
        for (int it = wq_pull(c, head); it < NQR; it = wq_pull(c, head)) rwkv_quad(c, l, it);
        for (int it = wq_pull(c, head + 64); it < NLS; it = wq_pull(c, head + 64)) ssd_mfma_chain(c, l, true, it / (SH * 2), (it >> 1) % SH, it & 1);
        if (rep == 0) { CONV_POOL() }
#undef CONV_POOL
        for (int it = wq_pull(c, head + 128); it < 2 * NCS4; it = wq_pull(c, head + 128)) {
#pragma unroll 1
            for (int k = 0; k < 2; ++k) { const int i = 2 * it + k; ssd_mfma_chain(c, l, false, i / (SH * 2), (i >> 1) % SH, i & 1); } }
    }
    for (int rep = 0; rep < REP_S5; ++rep)
    {
        const Span2 sp = balanced_span(c.gw(), c.ngw(), DEC_BATCH * CG * 2, DEC_SEQ, BATCH * CG * 2, SEQ);
        for (int i = sp.a0; i < sp.a1; ++i) s5_carry(c, l, true, i / (CG * 2), (i >> 1) % CG, i & 1);
        for (int i = sp.b0; i < sp.b1; ++i) s5_carry(c, l, false, i / (CG * 2), (i >> 1) % CG, i & 1);
    }
}

DEV void phase_post(const Ctx& c, int l) {
    const bf16_t* XS = c.ws<bf16_t>(WS_XS); const bf16_t* O = c.ws<bf16_t>(WS_O); const bf16_t* GG = c.ws<bf16_t>(WS_GG);
    const bf16_t* XBC = c.ws<bf16_t>(WS_XBC); const bf16_t* ZB = c.ws<bf16_t>(WS_ZB); const bf16_t* YS = c.ws<bf16_t>(WS_YSSD);
    bf16_t* YA = c.ws<bf16_t>(WS_YA); bf16_t* YB = c.ws<bf16_t>(WS_YB);
    for (int it = c.gw(); it < 2 * M; it += c.ngw()) {
        if (it < M) {
            const int row = it; constexpr int NCH = RW / 8, NIT = (NCH + 63) / 64;
            struct PostLd { u32x4 o0, o1, r, k, v, g; };
            auto issue = [&](int i, PostLd& L) { const int ch = c.lane + 64 * i; const int col = ch < NCH ? 8 * ch : 0;
                L.o0 = ld8(O + (size_t)row * RW + col); L.o1 = ld8(O + ((size_t)M + row) * RW + col);
                L.r = ld8(XS + (size_t)row * 3 * RW + col); L.k = ld8(XS + (size_t)row * 3 * RW + RW + col); L.v = ld8(XS + (size_t)row * 3 * RW + 2 * RW + col); L.g = ld8(GG + (size_t)row * RW + col); };
            auto finish = [&](int i, const PostLd& L) {
                const int ch = c.lane + 64 * i; const bool act = ch < NCH; const int col = act ? 8 * ch : 0, h = col / 64;
                float o[8], t[8], r[8], k[8], v[8], g[8];
                unpack8(L.o0, o); unpack8(L.o1, t); unpack8(L.r, r); unpack8(L.k, k); unpack8(L.v, v); unpack8(L.g, g);
                const float* rk = c.in(I_RRK) + ((size_t)l * RH + h) * 64 + (col & 63); const float* lg = c.in(I_RLNG) + (size_t)l * RW + col; const float* lb = c.in(I_RLNB) + (size_t)l * RW + col;
                float sm = 0.f, bn = 0.f;
#pragma unroll
                for (int j = 0; j < 8; ++j) { o[j] += t[j]; sm += o[j]; bn += r[j] * k[j] * rk[j]; }
                const float mu = red8(sm) * (1.0f / 64.0f); bn = red8(bn); float vq = 0.f;
#pragma unroll
                for (int j = 0; j < 8; ++j) { o[j] -= mu; vq += o[j] * o[j]; }
                const float rstd = rsqrtf(red8(vq) * (1.0f / 64.0f) + RWKV_LN_EPS);
#pragma unroll
                for (int j = 0; j < 8; ++j) o[j] = (o[j] * rstd * lg[j] + lb[j] + bn * v[j]) * g[j];
                if (act) st8(YA + (size_t)row * RW + col, pack8(o)); };
            PostLd LA, LB; issue(0, LA);
#pragma unroll 1
            for (int i = 0; i < NIT; i += 2) {
                if (i + 1 < NIT) issue(i + 1, LB);
                finish(i, LA);
                if (i + 2 < NIT) issue(i + 2, LA);
                if (i + 1 < NIT) finish(i + 1, LB);
            }
        } else {
            const int row = it - M; constexpr int NCH = SW / 8, NIT = (NCH + 63) / 64; float y[NIT][8]; float ss = 0.f;
#pragma unroll
            for (int i = 0; i < NIT; ++i) {
                const int ch = c.lane + 64 * i; const bool act = ch < NCH; const int col = act ? 8 * ch : 0; float x[8], a[8], b[8], z[8];
                unpack8(ld8(XBC + (size_t)row * SXBC + col), x); unpack8(ld8(YS + (size_t)row * SW + col), a); unpack8(ld8(YS + ((size_t)M + row) * SW + col), b); unpack8(ld8(ZB + (size_t)row * ZB_LD + col), z);
                const float dsk = c.in(I_SD)[(size_t)l * SH + col / 64];
#pragma unroll
                for (int j = 0; j < 8; ++j) { const float v = act ? (dsk * x[j] + a[j] + b[j]) * siluf_(z[j]) : 0.f; y[i][j] = v; ss += v * v; }
            }
            const float rstd = rsqrtf(wave_sum(ss) * (1.0f / SW) + EPS);
#pragma unroll
            for (int i = 0; i < NIT; ++i) { const int ch = c.lane + 64 * i; if (ch < NCH) { const int col = 8 * ch; const float* g = c.in(I_SNG) + (size_t)l * SW + col; float o[8];
#pragma unroll
                for (int j = 0; j < 8; ++j) o[j] = y[i][j] * rstd * g[j];
                st8(YB + (size_t)row * SW + col, pack8(o)); } }
        }
    }
}

constexpr int PH_PER_LAYER = 18, NPH = 2 + DEPTH * PH_PER_LAYER;
template <class Epi> DEV void run_gemm(const Ctx& c, const bf16_t* A, const bf16_t* Bt, int N, int K, const Epi& E) {
#ifndef CPU_EMU
    asm volatile("" : "+s"(K));
#endif
    pg8::Gemm g{A, Bt, M, N, K}; pg8::StaticOrder S; S.init(M, N, c.G, c.bid);
    pg8::gemm_phase<Epi, pg8::StaticOrder, PG8_ALIGN, PG8_SP2>(c.lds, c.tid, g, S, E);
}
template <class Epi, int NT> DEV void run_gemm_batched(const Ctx& c, const bf16_t* A, const bf16_t* Bt, int K, const Epi& E) {
#ifndef CPU_EMU
    asm volatile("" : "+s"(K));
#endif
    pg8::Gemm g{A, Bt, 0, 0, K}; BatchOrder<NT> S{c.G, c.bid};
    pg8::gemm_phase<Epi, BatchOrder<NT>, PG8_ALIGN, PG8_SP2>(c.lds, c.tid, g, S, E);
}
template <class Epi> DEV void run_gemm_projc(const Ctx& c, const bf16_t* A, const bf16_t* Bt, int K, const Epi& E) {
#ifndef CPU_EMU
    asm volatile("" : "+s"(K));
#endif
    pg8::Gemm g{A, Bt, M, 2 * D, K}; ProjCOrder S; S.base.init(M, D, c.G, c.bid);
    pg8::gemm_phase<Epi, ProjCOrder, PG8_ALIGN, PG8_SP2>(c.lds, c.tid, g, S, E);
}
template <class Epi> DEV void run_gemm_norm(const Ctx& c, const bf16_t* A, const bf16_t* Bt, int K, const Epi& E) {
#ifndef CPU_EMU
    asm volatile("" : "+s"(K));
    static_assert(PG8_ALIGN && M / 256 == 64 && D / 256 == 8, "fused norm: aligned epilogue, 64 x 8 units");
    pg8::Gemm g{A, Bt, M, D, K}; PanelOrder S{c.G, c.bid};
    pg8::gemm_phase<Epi, PanelOrder, PG8_ALIGN, PG8_SP2>(c.lds, c.tid, g, S, E);
#else
    pg8::Gemm g{A, Bt, M, D, K}; pg8::StaticOrder S; S.init(M, D, c.G, c.bid);
    pg8::gemm_phase<Epi, pg8::StaticOrder, PG8_ALIGN, PG8_SP2>(c.lds, c.tid, g, S, E);
#endif
}
#define NORM_CNT(l, j) ((unsigned*)(c.a->ws + WS_CTL) + CTL_NORM_CNT + (size_t)((l) * 3 + (j)) * 4096)
#define NORM_SLOTS() ((float*)(c.a->ws + WS_CTL) + CTL_NORM_SLOTS)
#ifdef CPU_EMU
#define GRID_BAR() do {} while (0)
#else
#define GRID_BAR() xcd_barrier(bar)
#endif
#ifdef CPU_EMU
inline void mega_body(const Args& args, unsigned char* lds_base)
#else
__global__ void __launch_bounds__(NTHREADS, 2) mega_fwd(Args args)
#endif
{
#ifndef CPU_EMU
    extern __shared__ __attribute__((aligned(16))) unsigned char lds_base[];
#endif
#ifndef CPU_EMU
    volatile LAS unsigned* MISC = (volatile LAS unsigned*)((LAS unsigned char*)lds_base + LDS_MISC);
    if (threadIdx.x < 16) MISC[threadIdx.x] = 0u;
    __syncthreads();
    XcdBarrier bar = xcd_barrier_post((unsigned*)(args.ws + WS_CTL) + 4096, MISC + 8);
    const int wave_s = __builtin_amdgcn_readfirstlane(threadIdx.x >> 6);
#define MKCTX() Ctx c; { const Args CAS* ap_ = (const Args CAS*)__builtin_amdgcn_kernarg_segment_ptr(); asm volatile("" : "+s"(ap_)); int tid_ = wave_s * 64 + (int)__builtin_amdgcn_mbcnt_hi(~0u, __builtin_amdgcn_mbcnt_lo(~0u, 0u)); asm volatile("" : "+v"(tid_)); \
        c.a = ap_; c.lds = (LAS unsigned char*)lds_base; c.tid = tid_; c.lane = tid_ & 63; c.wave = RFL(tid_ >> 6); c.bid = blockIdx.x; c.G = gridDim.x; }
#else
#define MKCTX() Ctx c; c.a = &args; c.lds = lds_base; c.tid = threadIdx.x; c.lane = c.tid & 63; c.wave = c.tid >> 6; c.bid = blockIdx.x; c.G = gridDim.x;
#endif
    const int lo = args.ph_lo, hi = args.ph_hi;
#ifndef PHMASK
#define PHMASK 0xFFFFFu
#endif
#define PHON(j) (((PHMASK) >> (j)) & 1u)
#define IN(k) (lo <= (k) && (k) < hi)
#define SEAM(k) do { if (IN((k) + 1)) GRID_BAR(); } while (0)
    if (PHON(18) && IN(0)) { { MKCTX(); for (int it = c.G - 1 - c.bid; it < DEPTH * CG; it += c.G) s5_build(c, it / CG, it % CG); } { MKCTX(); for (int rep = 0; rep < REP_CONV; ++rep) phase_pro(c); } { MKCTX(); phase_conv_early(c, 0); } SEAM(0); }
#define MOD_L(l) const float* mod = c.ws<float>(WS_MOD) + (size_t)(l) * NCOND * NMOD * D; (void)mod
#ifndef LRSEL
#define LRSEL 7
#endif
#define LAYER_BODY(l) { const int pb = 1 + (l) * PH_PER_LAYER; \
        if ((l) == 0 && PHON(0) && IN(pb + 0)) { { MKCTX(); phase_norm(c, l, 0); } SEAM(pb + 0); } \
        if (PHON(2) && IN(pb + 2)) { MKCTX(); MOD_L(l); run_gemm(c, c.ws<bf16_t>(WS_H), c.ws<bf16_t>(WS_FIT), 2 * FF, D, EpiSwiglu{c.ws<bf16_t>(WS_ACT)}); SEAM(pb + 2); } \
        if (PHON(3) && IN(pb + 3)) { MKCTX(); MOD_L(l); run_gemm_norm(c, c.ws<bf16_t>(WS_ACT), c.ws<bf16_t>(WS_FOT), FF, EpiResidNorm<false, true, (l) == 0>{c.ws<bf16_t>(WS_X), mod + 2 * D, c.in(I_NORMG) + (size_t)((l) * 3 + 1) * D, mod + 3 * D, c.ws<bf16_t>(WS_H), nullptr, NORM_SLOTS(), NORM_CNT(l, 0), c.lds, c.in(I_XP), c.in(I_XS)}); SEAM(pb + 3); } \
        if (PHON(5) && IN(pb + 5)) { { MKCTX(); run_gemm(c, c.ws<bf16_t>(WS_H), c.ws<bf16_t>(WS_WIT), RCOLS + ZB_LD, D, EpiZ{c.ws<bf16_t>(WS_ZA), c.ws<bf16_t>(WS_ZB)}); } { MKCTX(); run_gemm(c, c.ws<bf16_t>(WS_H), c.ws<bf16_t>(WS_WIT) + (size_t)(RCOLS + ZB_LD) * D, CW, D, EpiZC{c.ws<bf16_t>(WS_UG)}); } SEAM(pb + 5); } \
        if (PHON(6) && IN(pb + 6)) { MKCTX(); MOD_L(l); for (int rep = 0; rep < REP_ELT; ++rep) phase_prep(c, l); SEAM(pb + 6); } \
        if (PHON(7) && IN(pb + 7)) { \
            if (LRSEL & 1) { MKCTX(); run_gemm(c, c.ws<bf16_t>(WS_LRI), c.ws<bf16_t>(WS_LRT), 2 * RW, 256, EpiLRw{c.ws<bf16_t>(WS_OMD), c.in(I_RW0) + (size_t)l * 2 * RW}); } \
            if (LRSEL & 2) { MKCTX(); run_gemm(c, c.ws<bf16_t>(WS_LRI), c.ws<bf16_t>(WS_LRT) + (size_t)2 * RW * 256, 2 * RW, 256, \
                     EpiLRa{c.ws<bf16_t>(WS_KD), c.ws<bf16_t>(WS_BB), c.ws<bf16_t>(WS_XS), c.ws<bf16_t>(WS_KK), c.in(I_RA0) + (size_t)l * 2 * RW, c.in(I_RKA) + (size_t)l * RW}); } \
            if (LRSEL & 4) { MKCTX(); run_gemm(c, c.ws<bf16_t>(WS_LRI), c.ws<bf16_t>(WS_LRT) + (size_t)4 * RW * 256, RW, 256, EpiLRg{c.ws<bf16_t>(WS_GG)}); } \
            { MKCTX(); run_gemm_batched<EpiS5a, S5NT1>(c, c.ws<bf16_t>(WS_UG), c.ws<bf16_t>(WS_S5W + (size_t)(l) * S5W_L), S5K, EpiS5a{c.ws<bf16_t>(WS_YL), c.ws<float>(WS_SE)}); } \
            SEAM(pb + 7); } \
        if (PHON(8) && IN(pb + 8)) { MKCTX(); MOD_L(l); phase_scan(c, l); SEAM(pb + 8); } \
        if (PHON(9) && IN(pb + 9)) { { MKCTX(); MOD_L(l); for (int rep = 0; rep < REP_ELT; ++rep) phase_post(c, l); } { MKCTX(); run_gemm_batched<EpiS5b, S5NT2>(c, c.ws<bf16_t>(WS_SIN), c.ws<bf16_t>(WS_S5F + (size_t)(l) * S5F_L), 256, EpiS5b{c.ws<bf16_t>(WS_YL), c.ws<bf16_t>(WS_UG), c.ws<bf16_t>(WS_YC), c.in(I_CD) + (size_t)(l) * CW}); } { MKCTX(); run_gemm(c, c.ws<bf16_t>(WS_H), c.ws<bf16_t>(WS_WIT) + (size_t)NZ_MIX * D, 3 * D, D, EpiGate{c.ws<gate8_t>(WS_ZG)}); } SEAM(pb + 9); } \
        if (PHON(11) && IN(pb + 11)) { { MKCTX(); run_gemm(c, c.ws<bf16_t>(WS_YA), c.ws<bf16_t>(WS_PAT), D, RW, EpiProjAB<true>{c.ws<bf16_t>(WS_MRG), c.ws<gate8_t>(WS_ZG), 0}); } \
            { MKCTX(); run_gemm(c, c.ws<bf16_t>(WS_YB), c.ws<bf16_t>(WS_PBT), D, SW, EpiProjAB<false>{c.ws<bf16_t>(WS_MRG), c.ws<gate8_t>(WS_ZG), D}); } \
            { MKCTX(); run_gemm_projc(c, c.ws<bf16_t>(WS_YC), c.ws<bf16_t>(WS_PCT), CW, EpiProjC{c.ws<bf16_t>(WS_MRG), c.ws<bf16_t>(WS_MRGB), c.ws<gate8_t>(WS_ZG)}); } SEAM(pb + 11); } \
        if (PHON(14) && IN(pb + 14)) { MKCTX(); MOD_L(l); run_gemm_norm(c, c.ws<bf16_t>(WS_MRGB), c.ws<bf16_t>(WS_WOT), D, EpiResidNorm<false, false>{c.ws<bf16_t>(WS_X), mod + 5 * D, c.in(I_NORMG) + (size_t)((l) * 3 + 2) * D, mod + 6 * D, c.ws<bf16_t>(WS_H3), nullptr, NORM_SLOTS(), NORM_CNT(l, 1), c.lds, nullptr, nullptr}); SEAM(pb + 14); } \
        if (PHON(16) && IN(pb + 16)) { MKCTX(); MOD_L(l); run_gemm(c, c.ws<bf16_t>(WS_H3), c.ws<bf16_t>(WS_FIT) + (size_t)2 * FF * D, 2 * FF, D, EpiSwiglu{c.ws<bf16_t>(WS_ACT)}); SEAM(pb + 16); } \
        if (PHON(17) && IN(pb + 17)) { MKCTX(); MOD_L(l); \
            if ((l) + 1 < DEPTH) { run_gemm_norm(c, c.ws<bf16_t>(WS_ACT), c.ws<bf16_t>(WS_FOT) + (size_t)D * FF, FF, EpiResidNorm<false, true>{c.ws<bf16_t>(WS_X), mod + 8 * D, c.in(I_NORMG) + (size_t)(((l) + 1) * 3) * D, mod + (size_t)NCOND * NMOD * D, c.ws<bf16_t>(WS_H), nullptr, NORM_SLOTS(), NORM_CNT(l, 2), c.lds, nullptr, nullptr}); SEAM(pb + 17); } \
            else run_gemm_norm(c, c.ws<bf16_t>(WS_ACT), c.ws<bf16_t>(WS_FOT) + (size_t)D * FF, FF, EpiResidNorm<true, true>{c.ws<bf16_t>(WS_X), mod + 8 * D, c.in(I_FNG), nullptr, nullptr, c.out() + OUT_Y, NORM_SLOTS(), NORM_CNT(l, 2), c.lds, nullptr, nullptr}); } }
    LAYER_BODY(0)
    LAYER_BODY(1)
    static_assert(DEPTH == 2, "two layer bodies written out");
#undef IN
#undef SEAM
}

#ifndef CPU_EMU
#ifndef MK_PER_PHASE
#define MK_PER_PHASE 0
#endif
extern "C" void kernel_launch(void* const* d_in, const int* in_sizes, int n_in, void* d_out, int out_size, void* d_ws, size_t ws_size, hipStream_t stream) {
    static int grid = 0;
    if (grid == 0) {
        if (n_in != N_IN || (size_t)out_size != OUT_END || ws_size < WS_END) { fprintf(stderr, "kernel_launch: shape mismatch: n_in %d out %d ws %zu (need %zu)\n", n_in, out_size, ws_size, (size_t)WS_END); grid = -1; return; }
        int dev = 0, cus = 0, per_cu = 0;
        if (hipGetDevice(&dev) != hipSuccess || hipDeviceGetAttribute(&cus, hipDeviceAttributeMultiprocessorCount, dev) != hipSuccess) { grid = -1; return; }
        if (hipFuncSetAttribute((const void*)mega_fwd, hipFuncAttributeMaxDynamicSharedMemorySize, LDS_BYTES) != hipSuccess) { fprintf(stderr, "kernel_launch: hipFuncSetAttribute failed\n"); grid = -1; return; }
        if (hipOccupancyMaxActiveBlocksPerMultiprocessor(&per_cu, (const void*)mega_fwd, NTHREADS, LDS_BYTES) != hipSuccess || per_cu < 1) fprintf(stderr, "kernel_launch: occupancy query reports %d\n", per_cu);
        (void)hipGetLastError();
        grid = cus;
    }
    if (grid < 0) return;
    (void)hipMemsetAsync((char*)d_ws + WS_CTL, 0, CTL_BYTES, stream);
    Args a{};
    for (int i = 0; i < N_IN; ++i) a.in[i] = (const float*)d_in[i];
    a.out = (float*)d_out; a.ws = (unsigned char*)d_ws;
#if MK_PER_PHASE
    for (int p = 0; p < NPH; ++p) { a.ph_lo = p; a.ph_hi = p + 1; hipLaunchKernelGGL(mega_fwd, dim3(grid), dim3(NTHREADS), LDS_BYTES, stream, a); }
#else
    a.ph_lo = 0; a.ph_hi = NPH;
    hipLaunchKernelGGL(mega_fwd, dim3(grid), dim3(NTHREADS), LDS_BYTES, stream, a);
#endif
    const hipError_t le = hipPeekAtLastError();
    if (le != hipSuccess) fprintf(stderr, "kernel_launch: launch failed: %s\n", hipGetErrorName(le));
}
#endif
```

```cpp
#ifndef CPU_EMU
#include <hip/hip_runtime.h>
#endif
#include <cstdio>
#include <cstdint>
#include <cmath>

#ifdef CFG_SMALL
constexpr int D = 512, BATCH = 2, SEQ = 128, DEC_BATCH = 2, DEC_SEQ = 256, RW = 256, SW = 256, CW = 256, FF = 384;
#else
constexpr int D = 2048, BATCH = 32, SEQ = 256, DEC_BATCH = 4, DEC_SEQ = 2048, RW = 1024, SW = 1024, CW = 1024, FF = 5504;
#endif
constexpr int DEPTH = 2, GRID_W = 64, NMOD = 9;
#ifndef REP_S5
#define REP_S5 1
#endif
#ifndef REP_RS
#define REP_RS 1
#endif
#ifndef REP_CONV
#define REP_CONV 1
#endif
#ifndef REP_ELT
#define REP_ELT 1
#endif
constexpr int RH = RW / 64, RCOLS = 3 * RW + 256;
constexpr int SH = SW / 64, SG = 2, SN = 128, SXBC = SW + 2 * SG * SN, SCOLS = SW + SXBC + SH, SHG = SH / SG;
constexpr int CG = CW / 16, CP = 64;
constexpr int DIN = RCOLS + SCOLS + CW + 3 * D;
constexpr int MC = BATCH * SEQ, ML = DEC_BATCH * DEC_SEQ, M = MC + ML, NCOND = 1 + DEC_BATCH;
constexpr int ZB_LD = ((SCOLS + 255) / 256) * 256;
constexpr int NZ_MIX = RCOLS + ZB_LD + CW, NZ = NZ_MIX + 3 * D;
constexpr int LRN = 5 * RW;
constexpr float EPS = 1e-6f, RWKV_LN_EPS = 64e-5f;
constexpr int S5L = 32, S5K = S5L * 16, S5N1 = S5K + 256, MCH = ((M / S5L + 255) / 256) * 256, S5MT = MCH / 256, S5NT1 = S5N1 / 256, S5NT2 = S5K / 256;
static_assert(S5K % 256 == 0 && SEQ % S5L == 0 && DEC_SEQ % S5L == 0 && M % S5L == 0, "s5 chunking");
static_assert(RCOLS % 256 == 0 && CW % 256 == 0 && D % 256 == 0 && FF % 128 == 0 && MC % 256 == 0 && ML % 256 == 0 && DEC_SEQ % 256 == 0 && LRN % 256 == 0, "tile shapes");
static_assert(RW % 256 == 0 && SW % 256 == 0 && DEC_SEQ % GRID_W == 0 && SHG >= 1, "shapes");

enum In { I_XP = 0, I_XS, I_SRWKV, I_SSSD, I_SRE, I_SIM, I_C, I_CCTX, I_WMOD, I_BMOD, I_NORMG, I_FWIN, I_FWOUT, I_WIN, I_RMU, I_RW0, I_RW2, I_RA0, I_RA2, I_RG2,
          I_RKK, I_RKA, I_RRK, I_RLNG, I_RLNB, I_PA, I_SCW, I_SCB, I_SDTB, I_SALOG, I_SD, I_SNG, I_PB, I_CLRE, I_CLIM, I_CLDT, I_CBRE, I_CBIM, I_CCRE, I_CCIM, I_CD, I_PC, I_WOUT, I_FNG, N_IN };
static_assert(N_IN == 44, "44 inputs");

constexpr size_t OUT_Y = 0;
constexpr size_t OUT_RWKV = (size_t)M * D;
constexpr size_t OUT_SSD = OUT_RWKV + (size_t)BATCH * DEPTH * 2 * RH * 64 * 64;
constexpr size_t OUT_RE = OUT_SSD + (size_t)BATCH * DEPTH * 2 * SH * 64 * SN;
constexpr size_t OUT_IM = OUT_RE + (size_t)BATCH * DEPTH * 2 * CG * CP;
constexpr size_t OUT_END = OUT_IM + (size_t)BATCH * DEPTH * 2 * CG * CP;

constexpr size_t al256(size_t x) { return (x + 255) & ~(size_t)255; }
constexpr size_t WS_CTL = 0, CTL_BYTES = 1u << 20;
constexpr size_t WS_MOD = WS_CTL + CTL_BYTES;
constexpr size_t WS_X = al256(WS_MOD + (size_t)DEPTH * NCOND * NMOD * D * 4);
constexpr size_t WS_H = al256(WS_X + (size_t)M * D * 2);
constexpr size_t WS_FIT = al256(WS_H + (size_t)M * D * 2);
constexpr size_t WS_FOT = al256(WS_FIT + (size_t)2 * 2 * FF * D * 2);
constexpr size_t WS_WIT = al256(WS_FOT + (size_t)2 * D * FF * 2);
constexpr size_t WS_PAT = al256(WS_WIT + (size_t)NZ * D * 2);
constexpr size_t WS_PBT = al256(WS_PAT + (size_t)D * RW * 2);
constexpr size_t WS_PCT = al256(WS_PBT + (size_t)D * SW * 2);
constexpr size_t WS_WOT = al256(WS_PCT + (size_t)2 * D * CW * 2);
constexpr size_t WS_LRT = al256(WS_WOT + (size_t)D * D * 2);
constexpr size_t WS_ZA = al256(WS_LRT + (size_t)LRN * 256 * 2);
constexpr size_t WS_ZB = al256(WS_ZA + (size_t)M * RCOLS * 2);
constexpr size_t WS_UG = al256(WS_ZB + (size_t)M * ZB_LD * 2);
constexpr size_t WS_XS = al256(WS_UG + (size_t)CG * MCH * S5K * 2);
constexpr size_t WS_KK = WS_XS + (size_t)M * 3 * RW * 2;
constexpr size_t WS_LRI = al256(WS_KK + (size_t)M * RW * 2);
constexpr size_t WS_XBC = al256(WS_LRI + (size_t)M * 256 * 2);
constexpr size_t WS_DT = al256(WS_XBC + (size_t)M * SXBC * 2);
constexpr size_t WS_OMD = al256(WS_DT + (size_t)2 * M * SH * 4);
constexpr size_t WS_KD = WS_OMD + (size_t)2 * M * RW * 2;
constexpr size_t WS_BB = WS_KD + (size_t)2 * M * RW * 2;
constexpr size_t WS_GG = al256(WS_BB + (size_t)2 * M * RW * 2);
constexpr size_t WS_O = al256(WS_GG + (size_t)M * RW * 2);
constexpr size_t WS_YSSD = al256(WS_O + (size_t)2 * M * RW * 2);
constexpr size_t S5W_L = (size_t)CG * S5N1 * S5K * 2, S5F_L = (size_t)CG * S5K * 256 * 2;
constexpr size_t WS_S5W = al256(WS_YSSD + (size_t)2 * M * SW * 2);
constexpr size_t WS_S5F = al256(WS_S5W + DEPTH * S5W_L);
constexpr size_t WS_YL = al256(WS_S5F + DEPTH * S5F_L);
constexpr size_t WS_SE = al256(WS_YL + (size_t)CG * MCH * S5K * 2);
constexpr size_t WS_SIN = al256(WS_SE + (size_t)CG * MCH * 256 * 4);
constexpr size_t WS_END = al256(WS_SIN + (size_t)CG * MCH * 256 * 2);
constexpr size_t WS_ACT = WS_ZA;
constexpr size_t WS_YA = WS_ZA, WS_YB = WS_YA + (size_t)M * RW * 2, WS_YC = WS_YB + (size_t)M * SW * 2;
constexpr size_t WS_MRG = WS_XS, WS_MRGB = WS_H, WS_ZG = WS_OMD;
constexpr size_t WS_H3 = WS_MRG;
static_assert((size_t)M * FF * 2 <= WS_UG - WS_ZA, "ACT overlay");
static_assert((size_t)M * (RW + SW + CW) * 2 <= WS_ZB - WS_ZA || RW + SW + CW <= RCOLS, "Y overlay");
static_assert((size_t)M * D * 4 <= WS_LRI - WS_XS, "MRG overlay");
static_assert((size_t)M * 3 * D * 2 <= WS_GG - WS_OMD, "ZG overlay");
static_assert(WS_KK % 16 == 0 && WS_KD % 16 == 0 && WS_BB % 16 == 0 && WS_YB % 16 == 0 && WS_YC % 16 == 0, "alignment");
#ifndef CFG_SMALL
static_assert(WS_END <= 1442840576ull, "workspace budget (4 x largest input)");
#endif

#ifdef CPU_EMU
#define GAS
#define LAS
#define CAS
#define DEV inline
#define VM_WAIT() do {} while (0)
#define LDS_WAIT() do {} while (0)
#define CFENCE() do {} while (0)
static inline float __uint_as_float(unsigned u) { float f; memcpy(&f, &u, 4); return f; }
static inline unsigned __float_as_uint(float f) { unsigned u; memcpy(&u, &f, 4); return u; }
#define RFL(x) (x)
#define WAVE_SYNC() emu::wave_barrier()
#else
#define GAS __attribute__((address_space(1)))
#define LAS __attribute__((address_space(3)))
#define CAS __attribute__((address_space(4)))
#define DEV __device__ __forceinline__
#define VM_WAIT() asm volatile("s_waitcnt vmcnt(0)" ::: "memory")
#define LDS_WAIT() asm volatile("s_waitcnt lgkmcnt(0)" ::: "memory")
#define CFENCE() asm volatile("" ::: "memory")
#define RFL(x) __builtin_amdgcn_readfirstlane(x)
#define WAVE_SYNC() __builtin_amdgcn_wave_barrier()
#endif
typedef unsigned short bf16_t;
typedef float f32x4 __attribute__((ext_vector_type(4)));
typedef float f32x2 __attribute__((ext_vector_type(2)));
typedef unsigned u32x4 __attribute__((ext_vector_type(4)));
typedef unsigned u32x2 __attribute__((ext_vector_type(2)));
typedef short bf16x8 __attribute__((ext_vector_type(8)));
constexpr int NWAVES = 8, NTHREADS = 512, LDS_MAIN_BYTES = 131072;

#ifdef CPU_EMU
DEV unsigned f2bf(float f) { unsigned u = __float_as_uint(f); return (u + 0x7fffu + ((u >> 16) & 1u)) >> 16; }
DEV unsigned pk2(float lo, float hi) { return f2bf(lo) | (f2bf(hi) << 16); }
#else
typedef __bf16 hwbf16x2 __attribute__((ext_vector_type(2)));
typedef float hwf32x2 __attribute__((ext_vector_type(2)));
DEV unsigned pk2(float lo, float hi) { const hwbf16x2 v = __builtin_convertvector((hwf32x2){lo, hi}, hwbf16x2); return __builtin_bit_cast(unsigned, v); }
DEV unsigned f2bf(float f) { return (unsigned)__builtin_bit_cast(unsigned short, (__bf16)f); }
#endif
DEV float bflo(unsigned w) { return __uint_as_float(w << 16); }
DEV float bfhi(unsigned w) { return __uint_as_float(w & 0xffff0000u); }
DEV float bf1(bf16_t h) { return __uint_as_float(((unsigned)h) << 16); }
DEV void unpack8(const u32x4 v, float (&f)[8]) { f[0] = bflo(v.x); f[1] = bfhi(v.x); f[2] = bflo(v.y); f[3] = bfhi(v.y); f[4] = bflo(v.z); f[5] = bfhi(v.z); f[6] = bflo(v.w); f[7] = bfhi(v.w); }
DEV u32x4 pack8(const float (&f)[8]) { u32x4 o; o.x = pk2(f[0], f[1]); o.y = pk2(f[2], f[3]); o.z = pk2(f[4], f[5]); o.w = pk2(f[6], f[7]); return o; }
DEV u32x4 ld8(const bf16_t* p) { return *(const u32x4*)p; }
DEV void st8(bf16_t* p, const u32x4 v) { *(u32x4*)p = v; }
#ifdef CPU_EMU
DEV float frcp_(float x) { return 1.0f / x; }
#else
DEV float frcp_(float x) { return __builtin_amdgcn_rcpf(x); }
#endif
DEV float sigmoidf_(float x) { return frcp_(1.0f + __expf(-x)); }
DEV float siluf_(float x) { return x * sigmoidf_(x); }
DEV float softplusf_(float x) { return x > 20.f ? x : log1pf(expf(x)); }
DEV float geluf_(float x) { const float u = 0.7978845608028654f * (x + 0.044715f * x * x * x); return x * sigmoidf_(2.0f * u); }
DEV float wave_sum(float v) {
#pragma unroll
    for (int o = 1; o < 64; o <<= 1) v += __shfl_xor(v, o);
    return v;
}
#ifdef CPU_EMU
template <int MASK> DEV float xor_dpp(float v) { return __shfl_xor(v, MASK); }
DEV float red8(float v) { v += __shfl_xor(v, 1); v += __shfl_xor(v, 2); v += __shfl_xor(v, 4); return v; }
#else
template <int CTRL, int BANK> DEV float dpp_mov(float old, float v) {
    if constexpr (BANK == 0xF) return __builtin_bit_cast(float, __builtin_amdgcn_update_dpp(0, __builtin_bit_cast(int, v), CTRL, 0xF, 0xF, true));
    else return __builtin_bit_cast(float, __builtin_amdgcn_update_dpp(__builtin_bit_cast(int, old), __builtin_bit_cast(int, v), CTRL, 0xF, BANK, false)); }
template <int MASK> DEV float xor_dpp(float v) {
    if constexpr (MASK == 1) return dpp_mov<0xB1, 0xF>(v, v);
    else if constexpr (MASK == 2) return dpp_mov<0x4E, 0xF>(v, v);
    else if constexpr (MASK == 4) { float t = dpp_mov<0x104, 0x5>(v, v); return dpp_mov<0x114, 0xA>(t, v); }
    else { static_assert(MASK == 8, "xor_dpp mask"); return dpp_mov<0x128, 0xF>(v, v); }
}
DEV float red8(float v) { v += xor_dpp<1>(v); v += xor_dpp<2>(v); v += dpp_mov<0x141, 0xF>(v, v); return v; }
#endif
DEV int cond_of_row(int row) { return row < MC ? 0 : 1 + (row - MC) / DEC_SEQ; }

namespace pg8 {
#define PG8_LAS LAS
constexpr int BM = 256, BK = 64, HALF = 128, HTB = HALF * BK * 2, STAGE_BYTES = 8 * HTB, NXCD = 8, WGM = 8;
DEV int lds_byte(int r, int c) { const int st = (r >> 4) * 2 + (c >> 5), rr = r & 15, cc = c & 31, ob = rr * 64 + cc * 2; return st * 1024 + (ob ^ (((ob >> 9) & 1) << 5)); }
DEV void stage_rc(int b, int& R, int& C) { const int st = b / 1024, sb = b % 1024, swz = sb ^ (((sb >> 9) & 1) << 5); R = (st >> 1) * 16 + swz / 64; C = (st & 1) * 32 + (swz % 64) / 2; }
DEV int perm32(int rho) { const int n = rho >> 4, i = rho & 15; return 8 * (i >> 2) + 4 * n + (i & 3); }
struct Unit { int pm, pn; };
struct Gemm { const bf16_t* A; const bf16_t* Bt; int M, N, K; };
struct StaticOrder {
    int nM, nN, nwg, G, c;
    DEV void init(int M_, int N_, int G_, int c_) { nM = M_ / BM; nN = N_ / BM; nwg = nM * nN; G = G_; c = c_; }
    DEV bool next(int i, Unit& u) const {
        const long L = (long)i * G + c; if (L >= nwg) return false;
        int wgid = (int)L; { const int q = nwg / NXCD, r = nwg % NXCD, xcd = wgid % NXCD, off = wgid / NXCD; wgid = (xcd < r ? xcd * (q + 1) : r * (q + 1) + (xcd - r) * q) + off; }
        const int nig = WGM * nN, gid = wgid / nig, fm = gid * WGM, gsz = (nM - fm) < WGM ? (nM - fm) : WGM;
        u.pm = fm + ((wgid % nig) % gsz); u.pn = (wgid % nig) / gsz; return true;
    }
    DEV void a_ready(const Unit&) const {}
    DEV void done(const Unit&) const {}
};
#ifdef CPU_EMU
template <class Epi, class Sched, bool ALIGN_EPI = false, bool SP2 = false>
inline void gemm_phase(unsigned char* lds, const int tid, const Gemm g, const Sched& S, const Epi& E) {
    const int wid = tid >> 6, lane = tid & 63, wr = wid >> 2, wc = wid & 3, fr = lane & 15, fq = lane >> 4;
    Unit u;
    for (int i = 0; S.next(i, u); ++i) {
        f32x4 acc[2][2][4][2];
        for (int ai = 0; ai < 2; ++ai) for (int bj = 0; bj < 2; ++bj) for (int m = 0; m < 4; ++m) for (int n = 0; n < 2; ++n) for (int j = 0; j < 4; ++j) {
            const int row = 256 * u.pm + 128 * ai + 64 * wr + 16 * m + fr;
            const int col = 256 * u.pn + 128 * bj + 32 * wc + (Epi::PERM ? (8 * fq + 4 * n + j) : (16 * n + 4 * fq + j));
            const bf16_t* a = g.A + (size_t)row * g.K; const bf16_t* b = g.Bt + (size_t)col * g.K; float s = 0.f;
            for (int k = 0; k < g.K; ++k) s += bf1(a[k]) * bf1(b[k]);
            acc[ai][bj][m][n][j] = s;
        }
        E(acc, u, wr, wc, fr, fq);
    }
}
#else
template <class Epi, class Sched, bool ALIGN_EPI = false, bool SP2 = false>
__device__ __forceinline__ void gemm_phase(PG8_LAS unsigned char* lds, const int tid, const Gemm g, const Sched& S, const Epi& E) {
    const int wid = __builtin_amdgcn_readfirstlane(tid >> 6), lane = tid & 63, wr = wid >> 2, wc = wid & 3, fr = lane & 15, fq = lane >> 4;
    const int K = g.K, nt = K / BK;
    unsigned voffA[2], voffB[2];
#pragma unroll
    for (int i = 0; i < 2; ++i) { int R, C; stage_rc(tid * 16 + i * 8192, R, C); const int Rb = Epi::PERM ? ((R & ~31) + perm32(R & 31)) : R;
        voffA[i] = (unsigned)(R * K + C) * 2u; voffB[i] = (unsigned)(Rb * K + C) * 2u; }
    const size_t kstep = (size_t)(BK * 2);
    const size_t hstep = (size_t)HALF * K * 2;
    const size_t tstep = 2 * hstep;
    const unsigned ldsw = (unsigned)wid * 1024u;
    const int aoff = lds_byte(wr * 64 + fr, fq * 8), boff = lds_byte(wc * 32 + fr, fq * 8);
#define PG8_SA(b, h) (((b) * 2 + (h)) * HTB)
#define PG8_SB(b, h) ((4 + (b) * 2 + (h)) * HTB)
#define PG8_STAGE(bufoff, gbase, voff) do { _Pragma("unroll") for (int _i = 0; _i < 2; ++_i) \
        __builtin_amdgcn_global_load_lds((const unsigned*)((const char*)(gbase) + (voff)[_i]), (PG8_LAS unsigned*)(lds + (bufoff) + ldsw + _i * 8192), 16, 0, 0); } while (0)
#define PG8_LDA(dst, b, h) do { _Pragma("unroll") for (int m = 0; m < 4; ++m) _Pragma("unroll") for (int k = 0; k < 2; ++k) dst[m][k] = *(const PG8_LAS bf16x8*)(lds + PG8_SA(b, h) + aoff + m * 2048 + k * 1024); } while (0)
#define PG8_LDB(dst, b, h) do { _Pragma("unroll") for (int n = 0; n < 2; ++n) _Pragma("unroll") for (int k = 0; k < 2; ++k) dst[n][k] = *(const PG8_LAS bf16x8*)(lds + PG8_SB(b, h) + boff + n * 2048 + k * 1024); } while (0)
#define PG8_MMA(ai, bj, At, Bt) do { __builtin_amdgcn_s_setprio(1); _Pragma("unroll") for (int m = 0; m < 4; ++m) _Pragma("unroll") for (int n = 0; n < 2; ++n) _Pragma("unroll") for (int k = 0; k < 2; ++k) \
        acc[ai][bj][m][n] = __builtin_amdgcn_mfma_f32_16x16x32_bf16(Bt[n][k], At[m][k], acc[ai][bj][m][n], 0, 0, 0); __builtin_amdgcn_s_setprio(0); } while (0)
#define PG8_WAIT_V(n) asm volatile("s_waitcnt vmcnt(" #n ")" ::: "memory")
#define PG8_WAIT_L(n) asm volatile("s_waitcnt lgkmcnt(" #n ")" ::: "memory")
#define PG8_BAR __builtin_amdgcn_s_barrier()
#define PG8_SCHED __builtin_amdgcn_sched_barrier(0)
    Unit cur, nxt; int ui = 0;
    if (!S.next(0, cur)) return;
    f32x4 acc[2][2][4][2];
#pragma unroll
    for (int a = 0; a < 2; ++a)
#pragma unroll
        for (int b = 0; b < 2; ++b)
#pragma unroll
            for (int m = 0; m < 4; ++m)
#pragma unroll
                for (int n = 0; n < 2; ++n) acc[a][b][m][n] = (f32x4){0.f, 0.f, 0.f, 0.f};
    bf16x8 At[4][2], B0[2][2], B1[2][2];
    const char* cA = (const char*)g.A + (size_t)cur.pm * tstep; const char* cB = (const char*)g.Bt + (size_t)cur.pn * tstep;
    S.a_ready(cur);
    if constexpr (SP2) {
        PG8_STAGE(PG8_SB(0, 0), cB, voffB); PG8_STAGE(PG8_SB(0, 1), cB + hstep, voffB); PG8_STAGE(PG8_SA(0, 0), cA, voffA); PG8_STAGE(PG8_SA(0, 1), cA + hstep, voffA);
        if (wr == 1) PG8_BAR;
        PG8_WAIT_V(2); PG8_BAR;
        PG8_STAGE(PG8_SB(1, 0), cB + kstep, voffB); PG8_STAGE(PG8_SA(1, 0), cA + kstep, voffA); PG8_STAGE(PG8_SB(1, 1), cB + hstep + kstep, voffB);
        PG8_WAIT_V(6); PG8_BAR;
    } else {
        PG8_STAGE(PG8_SB(0, 0), cB, voffB); PG8_STAGE(PG8_SA(0, 0), cA, voffA); PG8_STAGE(PG8_SB(0, 1), cB + hstep, voffB); PG8_STAGE(PG8_SA(0, 1), cA + hstep, voffA);
        if (wr == 1) PG8_BAR;
        PG8_WAIT_V(4); PG8_BAR;
        PG8_STAGE(PG8_SB(1, 0), cB + kstep, voffB); PG8_STAGE(PG8_SA(1, 0), cA + kstep, voffA); PG8_STAGE(PG8_SB(1, 1), cB + hstep + kstep, voffB);
        PG8_WAIT_V(6); PG8_BAR;
    }
    for (;;) {
        const bool has_next = S.next(ui + 1, nxt);
        const char* nA = has_next ? (const char*)g.A + (size_t)nxt.pm * tstep : cA; const char* nB = has_next ? (const char*)g.Bt + (size_t)nxt.pn * tstep : cB;
        for (int t = 0; t < nt; t += 2) {
            const bool last = (t == nt - 2);
            const char* a1 = cA + (size_t)(t + 1) * kstep;
            const char* a2 = last ? nA : cA + (size_t)(t + 2) * kstep; const char* b2 = last ? nB : cB + (size_t)(t + 2) * kstep;
            const char* a3 = a2 + kstep; const char* b3 = b2 + kstep;
            if (last && has_next) S.a_ready(nxt);
            if constexpr (SP2) {
            PG8_LDB(B0, 0, 0); PG8_LDB(B1, 0, 1); PG8_SCHED; PG8_LDA(At, 0, 0); PG8_STAGE(PG8_SA(1, 1), a1 + hstep, voffA);
            PG8_WAIT_V(8); PG8_WAIT_L(0); PG8_BAR; PG8_MMA(0, 0, At, B0); PG8_MMA(0, 1, At, B1); PG8_BAR; PG8_SCHED;
            PG8_LDA(At, 0, 1); PG8_STAGE(PG8_SB(0, 0), b2, voffB); PG8_STAGE(PG8_SB(0, 1), b2 + hstep, voffB); PG8_STAGE(PG8_SA(0, 0), a2, voffA);
            PG8_WAIT_V(8); PG8_WAIT_L(0); PG8_BAR; PG8_MMA(1, 0, At, B0); PG8_MMA(1, 1, At, B1); PG8_BAR; PG8_SCHED;
            PG8_LDB(B0, 1, 0); PG8_LDB(B1, 1, 1); PG8_SCHED; PG8_LDA(At, 1, 0); PG8_STAGE(PG8_SA(0, 1), a2 + hstep, voffA);
            PG8_WAIT_V(8); PG8_WAIT_L(0); PG8_BAR; PG8_MMA(0, 0, At, B0); PG8_MMA(0, 1, At, B1); PG8_BAR; PG8_SCHED;
            PG8_LDA(At, 1, 1); PG8_STAGE(PG8_SB(1, 0), b3, voffB); PG8_STAGE(PG8_SB(1, 1), b3 + hstep, voffB); PG8_STAGE(PG8_SA(1, 0), a3, voffA);
            PG8_WAIT_V(8); PG8_WAIT_L(0); PG8_BAR; PG8_MMA(1, 0, At, B0); PG8_MMA(1, 1, At, B1); PG8_BAR; PG8_SCHED;
            } else {
            PG8_LDB(B0, 0, 0); PG8_SCHED; PG8_LDA(At, 0, 0); PG8_STAGE(PG8_SA(1, 1), a1 + hstep, voffA);
            PG8_WAIT_L(8); PG8_BAR; PG8_WAIT_L(0); PG8_MMA(0, 0, At, B0); PG8_BAR; PG8_SCHED;
            PG8_LDB(B1, 0, 1); PG8_STAGE(PG8_SB(0, 0), b2, voffB);
            PG8_BAR; PG8_WAIT_L(0); PG8_MMA(0, 1, At, B1); PG8_BAR;
            PG8_LDA(At, 0, 1); PG8_STAGE(PG8_SA(0, 0), a2, voffA);
            PG8_BAR; PG8_WAIT_L(0); PG8_MMA(1, 0, At, B0); PG8_BAR; PG8_SCHED;
            PG8_STAGE(PG8_SB(0, 1), b2 + hstep, voffB);
            PG8_WAIT_V(6); PG8_BAR; PG8_MMA(1, 1, At, B1); PG8_BAR;
            PG8_LDB(B0, 1, 0); PG8_SCHED; PG8_LDA(At, 1, 0); PG8_STAGE(PG8_SA(0, 1), a2 + hstep, voffA);
            PG8_WAIT_L(8); PG8_BAR; PG8_WAIT_L(0); PG8_MMA(0, 0, At, B0); PG8_BAR; PG8_SCHED;
            PG8_LDB(B1, 1, 1); PG8_STAGE(PG8_SB(1, 0), b3, voffB);
            PG8_BAR; PG8_WAIT_L(0); PG8_MMA(0, 1, At, B1); PG8_BAR;
            PG8_LDA(At, 1, 1); PG8_STAGE(PG8_SA(1, 0), a3, voffA);
            PG8_BAR; PG8_WAIT_L(0); PG8_MMA(1, 0, At, B0); PG8_BAR; PG8_SCHED;
            PG8_STAGE(PG8_SB(1, 1), b3 + hstep, voffB);
            PG8_WAIT_V(6); PG8_BAR; PG8_MMA(1, 1, At, B1); PG8_BAR;
            }
        }
        if constexpr (ALIGN_EPI) { if (wr == 0) PG8_BAR; }
        E(acc, cur, wr, wc, fr, fq); S.done(cur);
        if (!has_next) break;
#pragma unroll
        for (int a = 0; a < 2; ++a)
#pragma unroll
            for (int b = 0; b < 2; ++b)
#pragma unroll
                for (int m = 0; m < 4; ++m)
#pragma unroll
                    for (int n = 0; n < 2; ++n) acc[a][b][m][n] = (f32x4){0.f, 0.f, 0.f, 0.f};
        cur = nxt; cA = nA; cB = nB; ++ui;
        if constexpr (ALIGN_EPI) { if (wr == 1) PG8_BAR; }
    }
    PG8_WAIT_V(0);
    if constexpr (!ALIGN_EPI) { if (wr == 0) PG8_BAR; }
    PG8_BAR;
#undef PG8_SA
#undef PG8_SB
#undef PG8_STAGE
#undef PG8_LDA
#undef PG8_LDB
#undef PG8_MMA
#undef PG8_WAIT_V
#undef PG8_WAIT_L
#undef PG8_BAR
#undef PG8_SCHED
}
#endif
}
#ifndef PG8_SP2
#define PG8_SP2 true
#endif
#ifndef PG8_ALIGN
#define PG8_ALIGN true
#endif
DEV void wg_sync() { __syncthreads(); }
#define PR(v4, h) ((f32x2){(v4)[2 * (h)], (v4)[2 * (h) + 1]})
typedef f32x4 Acc[2][2][4][2];
#define UNROLL _Pragma("unroll")

#define EPI_ROWS(...) _Pragma("unroll") for (int ai = 0; ai < 2; ++ai) _Pragma("unroll") for (int m = 0; m < 4; ++m) { const int row = u.pm * 256 + ai * 128 + wr * 64 + m * 16 + fr; __VA_ARGS__ }

#define EPI_ROW_OF(ai, m) (u.pm * 256 + (ai) * 128 + wr * 64 + (m) * 16 + fr)
#define EPI_M(...) _Pragma("unroll") for (int m = 0; m < 4; ++m) { const int row = EPI_ROW_OF(ai, m); __VA_ARGS__ }
#define EPI_AI _Pragma("unroll") for (int ai = 0; ai < 2; ++ai)
struct EpiSwiglu {
    static constexpr bool PERM = true, AFTER_DRAIN = false;
    bf16_t* act;
    DEV void operator()(const Acc& acc, const pg8::Unit& u, int wr, int wc, int fr, int fq) const {
        const int col = u.pn * 128 + wc * 32 + 8 * fq;
        EPI_ROWS({ float o[8]; UNROLL for (int j = 0; j < 8; ++j) { const float gv = acc[ai][0][m][j >> 2][j & 3], uv = acc[ai][1][m][j >> 2][j & 3]; o[j] = siluf_(gv) * uv; }
            st8(act + (size_t)row * FF + col, pack8(o)); })
    }
};
struct EpiResid {
    static constexpr bool PERM = true, AFTER_DRAIN = false;
    float* X; const float* gate; float scale;
    DEV void operator()(const Acc& acc, const pg8::Unit& u, int wr, int wc, int fr, int fq) const {
        const int cidx = cond_of_row(u.pm * 256); UNROLL for (int bj = 0; bj < 2; ++bj) { const int col = u.pn * 256 + bj * 128 + wc * 32 + 8 * fq;
            const f32x4 g0 = *(const f32x4*)(gate + (size_t)cidx * NMOD * D + col) * scale, g1 = *(const f32x4*)(gate + (size_t)cidx * NMOD * D + col + 4) * scale;
            f32x4 x0[4], x1[4];
            EPI_AI { EPI_M({ const float* p = X + (size_t)row * D + col; x0[m] = *(const f32x4*)p; x1[m] = *(const f32x4*)(p + 4); }) EPI_M({ float* p = X + (size_t)row * D + col; *(f32x4*)p = x0[m] + g0 * acc[ai][bj][m][0]; *(f32x4*)(p + 4) = x1[m] + g1 * acc[ai][bj][m][1]; }) } }
    }
};
#ifdef CPU_EMU
static int emu_pass = 0;
#endif
constexpr int LDS_NORM_P = 131072, LDS_NORM_S = LDS_NORM_P + 4096;
constexpr size_t CTL_NORM_CNT = 16384, CTL_NORM_SLOTS = 131072;
template <bool FINAL, bool HALFSC, bool FIRSTX = false> struct EpiResidNorm {
    static constexpr bool PERM = true, AFTER_DRAIN = false; static constexpr float scale = HALFSC ? 0.5f : 1.0f;
    bf16_t* X; const float* gate;
    const float* ng; const float* msh;
    bf16_t* H; float* out;
    float* slots; unsigned* cnt; LAS unsigned char* lds; const float* xp; const float* xs;
    DEV void operator()(Acc& acc, const pg8::Unit& u_, int wr, int wc, int fr, int fq) const {
        pg8::Unit u = u_;
#ifndef CPU_EMU
        asm volatile("" : "+s"(u.pm), "+s"(u.pn));
#endif
        const int cidx = cond_of_row(u.pm * 256);
        UNROLL for (int bj = 0; bj < 2; ++bj) { const int col = u.pn * 256 + bj * 128 + wc * 32 + 8 * fq;
            const f32x4 g0 = *(const f32x4*)(gate + (size_t)cidx * NMOD * D + col) * scale, g1 = *(const f32x4*)(gate + (size_t)cidx * NMOD * D + col + 4) * scale;
            f32x4 x0[4], x1[4]; u32x4 xq[4];
#ifdef CPU_EMU
            const bool f32src = FIRSTX && emu_pass == 0;
#else
            constexpr bool f32src = FIRSTX;
#endif
            const float* Xin = u.pm * 256 < MC ? xp : xs - (size_t)MC * D;
            EPI_AI { EPI_M({ const unsigned eo = (unsigned)row * D + (unsigned)col; if (f32src) { x0[m] = *(const f32x4*)((const char*)Xin + eo * 4u); x1[m] = *(const f32x4*)((const char*)Xin + eo * 4u + 16u); } else xq[m] = *(const u32x4*)((const char*)X + eo * 2u); }) EPI_M({ (void)row;
                        f32x4 b0, b1; if (f32src) { b0 = x0[m]; b1 = x1[m]; } else { b0 = (f32x4){bflo(xq[m].x), bfhi(xq[m].x), bflo(xq[m].y), bfhi(xq[m].y)}; b1 = (f32x4){bflo(xq[m].z), bfhi(xq[m].z), bflo(xq[m].w), bfhi(xq[m].w)}; }
#ifdef CPU_EMU
                        const f32x4 a0 = emu_pass ? b0 : b0 + g0 * acc[ai][bj][m][0], a1 = emu_pass ? b1 : b1 + g1 * acc[ai][bj][m][1];
#else
                        const f32x4 a0 = b0 + g0 * acc[ai][bj][m][0], a1 = b1 + g1 * acc[ai][bj][m][1];
#endif
                        acc[ai][bj][m][0] = a0; acc[ai][bj][m][1] = a1;
#ifndef CPU_EMU
                        asm volatile("" : "+v"(acc[ai][bj][m][0]), "+v"(acc[ai][bj][m][1]));
#endif
                        }) CFENCE(); } }
        LAS float* P = (LAS float*)(lds + LDS_NORM_P); LAS float* S = (LAS float*)(lds + LDS_NORM_S);
        UNROLL for (int ai = 0; ai < 2; ++ai) UNROLL for (int m = 0; m < 4; ++m) { float s = 0.f;
            UNROLL for (int bj = 0; bj < 2; ++bj) UNROLL for (int n = 0; n < 2; ++n) { const f32x4 a = acc[ai][bj][m][n]; s += (a.x * a.x + a.y * a.y) + (a.z * a.z + a.w * a.w); }
            s += __shfl_xor(s, 16); s += __shfl_xor(s, 32); if (fq == 0) P[wc * 256 + ai * 128 + wr * 64 + m * 16 + fr] = s; }
        wg_sync();
        const int wid = wr * 4 + wc, t = wid * 64 + fq * 16 + fr;
        if (wid < 4) {
            const float s = (P[t] + P[256 + t]) + (P[512 + t] + P[768 + t]); float* slot = slots + ((size_t)u.pm * 256 + t) * 8 + u.pn;
#ifdef CPU_EMU
            *slot = s;
#else
            __hip_atomic_store((unsigned*)slot, __float_as_uint(s), __ATOMIC_RELAXED, __HIP_MEMORY_SCOPE_AGENT);
            VM_WAIT();
            if (fq * 16 + fr == 0) (void)__hip_atomic_fetch_add(cnt + 64 * u.pm, 1u, __ATOMIC_RELAXED, __HIP_MEMORY_SCOPE_AGENT);
#endif
        }
#ifdef CPU_EMU
        if (emu_pass == 0) {
            UNROLL for (int bj = 0; bj < 2; ++bj) { const int col = u.pn * 256 + bj * 128 + wc * 32 + 8 * fq; EPI_ROWS({ const f32x4 a0 = acc[ai][bj][m][0], a1 = acc[ai][bj][m][1]; float o[8] = {a0.x, a0.y, a0.z, a0.w, a1.x, a1.y, a1.z, a1.w}; st8(X + (size_t)row * D + col, pack8(o)); }) }
            wg_sync(); wg_sync(); return; }
#else
        if (wid == 0) {
            unsigned sp = 0u; while ((unsigned)RFL((int)__hip_atomic_load(cnt + 64 * u.pm, __ATOMIC_RELAXED, __HIP_MEMORY_SCOPE_AGENT)) < 32u) { __builtin_amdgcn_s_sleep(1); if (++sp > (1u << 17)) break; }
            __builtin_amdgcn_fence(__ATOMIC_ACQUIRE, "agent"); VM_WAIT(); }
#endif
        wg_sync();
        if (wid < 4) { const float* sl = slots + ((size_t)u.pm * 256 + t) * 8; float v[8];
#ifdef CPU_EMU
            UNROLL for (int j = 0; j < 8; ++j) v[j] = sl[j];
#else
            UNROLL for (int j = 0; j < 8; ++j) v[j] = __uint_as_float(__hip_atomic_load((const unsigned*)sl + j, __ATOMIC_RELAXED, __HIP_MEMORY_SCOPE_AGENT));
#endif
            S[t] = rsqrtf((((v[0] + v[1]) + (v[2] + v[3])) + ((v[4] + v[5]) + (v[6] + v[7]))) * (1.0f / D) + EPS); }
        wg_sync();
        UNROLL for (int bj = 0; bj < 2; ++bj) { int col = u.pn * 256 + bj * 128 + wc * 32 + 8 * fq;
#ifndef CPU_EMU
            asm volatile("" : "+v"(col));
#endif
            f32x4 gm0 = *(const f32x4*)(ng + col), gm1 = *(const f32x4*)(ng + col + 4), sh0 = (f32x4){0.f, 0.f, 0.f, 0.f}, sh1 = sh0;
            if (!FINAL) { const float* ms = msh + (size_t)cidx * NMOD * D + col; gm0 = gm0 * (*(const f32x4*)(ms + D) + 1.0f); gm1 = gm1 * (*(const f32x4*)(ms + D + 4) + 1.0f); sh0 = *(const f32x4*)ms; sh1 = *(const f32x4*)(ms + 4); }
            EPI_ROWS({ const float rs = S[ai * 128 + wr * 64 + m * 16 + fr]; const f32x4 a0 = acc[ai][bj][m][0], a1 = acc[ai][bj][m][1];
                if (!FINAL) {
                    const unsigned eo = (unsigned)row * D + (unsigned)col;
#ifndef CPU_EMU
                    { float xo[8] = {a0.x, a0.y, a0.z, a0.w, a1.x, a1.y, a1.z, a1.w}; *(u32x4*)((char*)X + eo * 2u) = pack8(xo); }
#endif
                    const f32x4 y0 = a0 * rs * gm0 + sh0, y1 = a1 * rs * gm1 + sh1; float o[8] = {y0.x, y0.y, y0.z, y0.w, y1.x, y1.y, y1.z, y1.w};
                    *(u32x4*)((char*)H + eo * 2u) = pack8(o); }
                else { const unsigned bo = ((unsigned)row * D + (unsigned)col) * 4u; *(f32x4*)((char*)out + bo) = a0 * rs * gm0; *(f32x4*)((char*)out + bo + 16u) = a1 * rs * gm1; }
                CFENCE(); }) }
    }
};
struct EpiZ {
    static constexpr bool PERM = true, AFTER_DRAIN = false;
    bf16_t *za, *zb;
    DEV void operator()(const Acc& acc, const pg8::Unit& u, int wr, int wc, int fr, int fq) const {
        int c0 = u.pn * 256; bf16_t* base; int ld; if (c0 < RCOLS) { base = za; ld = RCOLS; } else { base = zb; ld = ZB_LD; c0 -= RCOLS; }
        UNROLL for (int bj = 0; bj < 2; ++bj) { const int col = c0 + bj * 128 + wc * 32 + 8 * fq;
            EPI_ROWS({ float o[8]; UNROLL for (int j = 0; j < 8; ++j) o[j] = acc[ai][bj][m][j >> 2][j & 3];
                st8(base + (size_t)row * ld + col, pack8(o)); }) }
    }
};
struct EpiZC {
    static constexpr bool PERM = true, AFTER_DRAIN = false;
    bf16_t* ug;
    DEV void operator()(const Acc& acc, const pg8::Unit& u, int wr, int wc, int fr, int fq) const {
        UNROLL for (int bj = 0; bj < 2; ++bj) { const int col = u.pn * 256 + bj * 128 + wc * 32 + 8 * fq, g = col >> 4, cl = col & 15;
            EPI_ROWS({ float o[8]; UNROLL for (int j = 0; j < 8; ++j) o[j] = acc[ai][bj][m][j >> 2][j & 3];
                st8(ug + ((size_t)g * MCH + row / S5L) * S5K + (row % S5L) * 16 + cl, pack8(o)); }) }
    }
};
DEV u32x2 pack_gate8(const float (&g)[8]) { unsigned q[8]; UNROLL for (int j = 0; j < 8; ++j) q[j] = (unsigned)(g[j] * 255.0f + 0.5f);
    u32x2 o; o.x = q[0] | (q[1] << 8) | (q[2] << 16) | (q[3] << 24); o.y = q[4] | (q[5] << 8) | (q[6] << 16) | (q[7] << 24); return o; }
DEV void unpack_gate8(const u32x2 w, float (&g)[8]) { UNROLL for (int j = 0; j < 4; ++j) { g[j] = (float)((w.x >> (8 * j)) & 255u) * (1.0f / 255.0f); g[4 + j] = (float)((w.y >> (8 * j)) & 255u) * (1.0f / 255.0f); } }
typedef unsigned char gate8_t;
struct EpiGate {
    static constexpr bool PERM = true, AFTER_DRAIN = false;
    gate8_t* zg;
    DEV void operator()(const Acc& acc, const pg8::Unit& u, int wr, int wc, int fr, int fq) const { UNROLL for (int bj = 0; bj < 2; ++bj) { const int col = u.pn * 256 + bj * 128 + wc * 32 + 8 * fq;
            EPI_ROWS({ float o[8]; UNROLL for (int j = 0; j < 8; ++j) o[j] = sigmoidf_(acc[ai][bj][m][j >> 2][j & 3]);
                *(u32x2*)(zg + (size_t)row * 3 * D + col) = pack_gate8(o); }) }
    }
};
struct EpiLRw {
    static constexpr bool PERM = true, AFTER_DRAIN = false;
    bf16_t* omd; const float* w0;
    DEV void operator()(const Acc& acc, const pg8::Unit& u, int wr, int wc, int fr, int fq) const {
        UNROLL for (int bj = 0; bj < 2; ++bj) { const int n = u.pn * 256 + bj * 128 + wc * 32 + 8 * fq, d = n / RW, c = n % RW;
            const f32x4 b0 = *(const f32x4*)(w0 + n), b1 = *(const f32x4*)(w0 + n + 4);
            EPI_ROWS({ float o[8];
                UNROLL for (int j = 0; j < 4; ++j) { const float r0 = 0.6065306597126334f * sigmoidf_(b0[j] + acc[ai][bj][m][0][j]), r1 = 0.6065306597126334f * sigmoidf_(b1[j] + acc[ai][bj][m][1][j]); o[j] = 1.0f - __expf(-r0); o[4 + j] = 1.0f - __expf(-r1); }
                st8(omd + ((size_t)d * M + row) * RW + c, pack8(o)); }) }
    }
};
struct EpiLRa {
    static constexpr bool PERM = true, AFTER_DRAIN = false;
    bf16_t *kd, *bb; const bf16_t *xs, *kk; const float *a0, *ka;
    DEV void operator()(const Acc& acc, const pg8::Unit& u, int wr, int wc, int fr, int fq) const {
        UNROLL for (int bj = 0; bj < 2; ++bj) { const int n = u.pn * 256 + bj * 128 + wc * 32 + 8 * fq, d = n / RW, c = n % RW;
            const f32x4 b0 = *(const f32x4*)(a0 + n), b1 = *(const f32x4*)(a0 + n + 4), k0 = *(const f32x4*)(ka + c), k1 = *(const f32x4*)(ka + c + 4);
            u32x4 kq[4], kkq[4];
            EPI_AI { EPI_M({ kq[m] = ld8(xs + (size_t)row * 3 * RW + RW + c); kkq[m] = ld8(kk + (size_t)row * RW + c); }) EPI_M({ float kv[8], kkv[8], o1[8], o2[8]; unpack8(kq[m], kv); unpack8(kkq[m], kkv);
                        UNROLL for (int j = 0; j < 4; ++j) { const float a_0 = sigmoidf_(b0[j] + acc[ai][bj][m][0][j]), a_1 = sigmoidf_(b1[j] + acc[ai][bj][m][1][j]);
                            o1[j] = kv[j] * (1.0f + (a_0 - 1.0f) * k0[j]); o2[j] = kkv[j] * a_0; o1[4 + j] = kv[4 + j] * (1.0f + (a_1 - 1.0f) * k1[j]); o2[4 + j] = kkv[4 + j] * a_1; }
                        st8(kd + ((size_t)d * M + row) * RW + c, pack8(o1)); st8(bb + ((size_t)d * M + row) * RW + c, pack8(o2)); }) } }
    }
};
struct EpiLRg {
    static constexpr bool PERM = true, AFTER_DRAIN = false;
    bf16_t* gg;
    DEV void operator()(const Acc& acc, const pg8::Unit& u, int wr, int wc, int fr, int fq) const {
        UNROLL for (int bj = 0; bj < 2; ++bj) { const int c = u.pn * 256 + bj * 128 + wc * 32 + 8 * fq;
            EPI_ROWS({ float o[8]; UNROLL for (int j = 0; j < 8; ++j) o[j] = acc[ai][bj][m][j >> 2][j & 3];
                st8(gg + (size_t)row * RW + c, pack8(o)); }) }
    }
};
template <bool FIRST> struct EpiProjAB {
    static constexpr bool PERM = true, AFTER_DRAIN = false;
    bf16_t* mrg; const gate8_t* zg; int goff;
    DEV void operator()(const Acc& acc, const pg8::Unit& u, int wr, int wc, int fr, int fq) const { UNROLL for (int bj = 0; bj < 2; ++bj) { const int col = u.pn * 256 + bj * 128 + wc * 32 + 8 * fq;
            u32x2 gq[4]; u32x4 mq[4];
            EPI_AI { EPI_M({ gq[m] = *(const u32x2*)(zg + (size_t)row * 3 * D + goff + col); if (!FIRST) mq[m] = ld8(mrg + (size_t)row * D + col); else mq[m] = (u32x4){0u, 0u, 0u, 0u}; }) EPI_M({ float g[8], r[8]; unpack_gate8(gq[m], g); unpack8(mq[m], r);
                        UNROLL for (int j = 0; j < 4; ++j) { r[j] += g[j] * acc[ai][bj][m][0][j]; r[4 + j] += g[4 + j] * acc[ai][bj][m][1][j]; }
                        st8(mrg + (size_t)row * D + col, pack8(r)); }) } }
    }
};
struct EpiProjC {
    static constexpr bool PERM = true, AFTER_DRAIN = false;
    const bf16_t* mrg; bf16_t* mrgb; const gate8_t* zg;
    DEV void operator()(const Acc& acc, const pg8::Unit& u, int wr, int wc, int fr, int fq) const {
        const int col = u.pn * 128 + wc * 32 + 8 * fq; u32x2 gq[4]; u32x4 mq[4];
        EPI_AI { EPI_M({ gq[m] = *(const u32x2*)(zg + (size_t)row * 3 * D + 2 * D + col); mq[m] = ld8(mrg + (size_t)row * D + col); }) EPI_M({ float g[8], r[8]; unpack_gate8(gq[m], g); unpack8(mq[m], r); float o[8];
                    UNROLL for (int j = 0; j < 4; ++j) { o[j] = r[j] + g[j] * acc[ai][0][m][0][j] * sigmoidf_(acc[ai][1][m][0][j]); o[4 + j] = r[4 + j] + g[4 + j] * acc[ai][0][m][1][j] * sigmoidf_(acc[ai][1][m][1][j]); }
                    st8(mrgb + (size_t)row * D + col, pack8(o)); }) }
    }
};
template <int NT> struct BatchOrder {
    int G, c;
    DEV bool next(int i, pg8::Unit& u) const { const long id = (long)i * G + c; if (id >= (long)CG * S5MT * NT) return false;
        const int g = (int)(id / (S5MT * NT)), r = (int)(id % (S5MT * NT)); u.pm = g * S5MT + r / NT; u.pn = g * NT + r % NT; return true; }
    DEV void a_ready(const pg8::Unit&) const {}
    DEV void done(const pg8::Unit&) const {}
};
struct PanelOrder {
    int G, c;
    DEV bool next(int i, pg8::Unit& u) const { const int L = i * G + c; if (L >= (M / 256) * (D / 256)) return false;
        const int x = L & 7, o = L >> 3; u.pm = ((o >> 5) * 8 + x) * 4 + (o & 3); u.pn = (o & 31) >> 2; return true; }
    DEV void a_ready(const pg8::Unit&) const {}
    DEV void done(const pg8::Unit&) const {}
};
struct ProjCOrder {
    pg8::StaticOrder base;
    DEV bool next(int i, pg8::Unit& u) const { if (!base.next(i >> 1, u)) return false; u.pn = 2 * u.pn + (i & 1); return true; }
    DEV void a_ready(const pg8::Unit&) const {}
    DEV void done(const pg8::Unit&) const {}
};
struct EpiS5a {
    static constexpr bool PERM = true, AFTER_DRAIN = false;
    bf16_t* yl; float* se;
    DEV void operator()(const Acc& acc, const pg8::Unit& u, int wr, int wc, int fr, int fq) const {
        const int g = u.pn / S5NT1, ni = u.pn % S5NT1, rbase = (u.pm % S5MT) * 256;
        UNROLL for (int bj = 0; bj < 2; ++bj) { const int col = ni * 256 + bj * 128 + wc * 32 + 8 * fq;
            EPI_ROWS({ const int r = rbase + (row - u.pm * 256);
                if (ni < S5NT2) { float o[8]; UNROLL for (int j = 0; j < 8; ++j) o[j] = acc[ai][bj][m][j >> 2][j & 3]; st8(yl + ((size_t)g * MCH + r) * S5K + col, pack8(o)); }
                else { float* p = se + ((size_t)g * MCH + r) * 256 + (col - S5K); *(f32x4*)p = acc[ai][bj][m][0]; *(f32x4*)(p + 4) = acc[ai][bj][m][1]; } }) }
    }
};
struct EpiS5b {
    static constexpr bool PERM = true, AFTER_DRAIN = false;
    const bf16_t *yl, *ug; bf16_t* yc; const float* dsk;
    DEV void operator()(const Acc& acc, const pg8::Unit& u, int wr, int wc, int fr, int fq) const {
        const int g = u.pn / S5NT2, ni = u.pn % S5NT2, rbase = (u.pm % S5MT) * 256;
        UNROLL for (int bj = 0; bj < 2; ++bj) { const int col = ni * 256 + bj * 128 + wc * 32 + 8 * fq, t = col >> 4, cl = col & 15;
            const f32x4 d0 = *(const f32x4*)(dsk + g * 16 + cl), d1 = *(const f32x4*)(dsk + g * 16 + cl + 4);
            u32x4 aq[4], uq[4];
            EPI_AI { EPI_M({ const int r = rbase + (row - u.pm * 256); const size_t off = ((size_t)g * MCH + (r < M / S5L ? r : 0)) * S5K + col; aq[m] = ld8(yl + off); uq[m] = ld8(ug + off); }) EPI_M({ const int r = rbase + (row - u.pm * 256);
                        if (r < M / S5L) { float a[8], uu[8], o[8]; unpack8(aq[m], a); unpack8(uq[m], uu);
                            UNROLL for (int j = 0; j < 4; ++j) { o[j] = geluf_(d0[j] * uu[j] + a[j] + acc[ai][bj][m][0][j]); o[4 + j] = geluf_(d1[j] * uu[4 + j] + a[4 + j] + acc[ai][bj][m][1][j]); }
                            st8(yc + ((size_t)r * S5L + t) * CW + g * 16 + cl, pack8(o)); } }) } }
    }
};

#ifndef CPU_EMU
#define XB_TMO      128
#define XB_XCNT(j)  (256  + 64 * (j))
#define XB_XSUB(j)  (1280 + 64 * (j))
#define XB_XGEN(j)  (2304 + 64 * (j))
#define XB_TOP      3328
#define XB_TOPGEN   3392
#define XCD_BAR_WORDS 3456
#define XB_SPIN_CAP (1u << 18)
__device__ __forceinline__ unsigned xb_ld(unsigned* p)              { return __hip_atomic_load(p, __ATOMIC_RELAXED, __HIP_MEMORY_SCOPE_AGENT); }
__device__ __forceinline__ unsigned xb_add(unsigned* p, unsigned v) { return __hip_atomic_fetch_add(p, v, __ATOMIC_RELAXED, __HIP_MEMORY_SCOPE_AGENT); }
__device__ __forceinline__ unsigned xb_xcc_id() { return (unsigned)__builtin_amdgcn_s_getreg((3 << 11) | 20) & 0xFu; }
#define XB_SPIN(cond, bar) do { unsigned _sp = 0; while (cond) { __builtin_amdgcn_s_sleep(1); \
    if ((++_sp & 255u) == 0u) { if (xb_ld(&(bar)[XB_TMO])) break; if (_sp > XB_SPIN_CAP) { atomicAdd(&(bar)[XB_TMO], 1u); break; } } } } while (0)
struct XcdBarrier { unsigned* bar; unsigned x; volatile LAS unsigned* st; };
__device__ __forceinline__ XcdBarrier xcd_barrier_post(unsigned* bar, volatile LAS unsigned* st) {
    XcdBarrier b; b.bar = bar; b.x = xb_xcc_id(); b.st = st;
    if (threadIdx.x == 0) (void)xb_add(&bar[XB_XCNT(b.x)], 1u);
    return b;
}
__device__ __forceinline__ void xcd_barrier_complete(unsigned* bar, unsigned x, unsigned& nloc, unsigned& nx) {
    const unsigned G = gridDim.x * gridDim.y * gridDim.z;
    unsigned sum, cnt, mine, sp = 0u;
    for (;;) {
        sum = 0u; cnt = 0u; mine = 0u;
#pragma unroll
        for (unsigned j = 0; j < 16; ++j) { const unsigned c = xb_ld(&bar[XB_XCNT(j)]); sum += c; cnt += (c > 0u) ? 1u : 0u; mine = (j == x) ? c : mine; }
        if (sum == G) break;
        __builtin_amdgcn_s_sleep(1);
        if ((++sp & 255u) == 0u) { if (xb_ld(&bar[XB_TMO])) break; if (sp > XB_SPIN_CAP) { atomicAdd(&bar[XB_TMO], 1u); break; } }
    }
    nloc = mine > 0u ? mine : 1u; nx = cnt > 0u ? cnt : 1u;
}
__device__ __forceinline__ void xcd_barrier(const XcdBarrier& b) {
    asm volatile("s_waitcnt vmcnt(0)" ::: "memory");
    __syncthreads();
    if (threadIdx.x == 0) {
        unsigned* bar = b.bar;
        __builtin_amdgcn_s_waitcnt(0);
        unsigned nloc = b.st[0], nx = b.st[1];
        if (nloc == 0u) { xcd_barrier_complete(bar, b.x, nloc, nx); b.st[0] = nloc; b.st[1] = nx; }
        const unsigned old = xb_add(&bar[XB_XSUB(b.x)], 1u);
        const unsigned gen = old / nloc;
        if (old + 1u == (gen + 1u) * nloc) {
            __builtin_amdgcn_fence(__ATOMIC_RELEASE, "agent");
            asm volatile("s_waitcnt vmcnt(0)" ::: "memory");
            const unsigned og = xb_add(&bar[XB_TOP], 1u);
            const unsigned tg = og / nx;
            if (og + 1u == (tg + 1u) * nx) xb_add(&bar[XB_TOPGEN], 1u);
            else XB_SPIN(xb_ld(&bar[XB_TOPGEN]) == tg, bar);
            __builtin_amdgcn_fence(__ATOMIC_ACQUIRE, "agent");
            xb_add(&bar[XB_XGEN(b.x)], 1u);
            asm volatile("s_waitcnt vmcnt(0)" ::: "memory");
        } else {
            XB_SPIN(xb_ld(&bar[XB_XGEN(b.x)]) == gen, bar);
            __builtin_amdgcn_fence(__ATOMIC_ACQUIRE, "agent");
            asm volatile("s_waitcnt vmcnt(0)" ::: "memory");
        }
    }
    __syncthreads();
}
#endif

constexpr int LDS_MAIN = 131072;
constexpr int LDS_MISC = 143360;
constexpr int LDS_BYTES = 147456;
struct Args { const float* in[N_IN]; float* out; unsigned char* ws; int ph_lo, ph_hi; };
struct Ctx {
    const Args CAS* a; LAS unsigned char* lds; int tid, lane, wave, bid, G;
    DEV const float* in(int i) const { return a->in[i]; }
    DEV float* out() const { return a->out; }
    template <class T> DEV T* ws(size_t off) const { return (T*)(a->ws + off); }
    DEV int gw() const { return wave * G + bid; }
    DEV int ngw() const { return G * NWAVES; }
};


struct Span2 { int a0, a1, b0, b1; };
DEV int cdiv_pos(long a, long b) { return a <= 0 ? 0 : (int)((a + b - 1) / b); }
DEV Span2 balanced_span(int w, int parts, int n0, long c0, int n1, long c1) {
    const long total = n0 * c0 + n1 * c1, tgt = (total + parts - 1) / parts, lo = (long)w * tgt, hi = lo + tgt, base = n0 * c0;
    Span2 s; s.a0 = cdiv_pos(lo, c0); s.a1 = cdiv_pos(hi, c0); if (s.a0 > n0) s.a0 = n0; if (s.a1 > n0) s.a1 = n0;
    s.b0 = cdiv_pos(lo - base, c1); s.b1 = cdiv_pos(hi - base, c1); if (s.b0 > n1) s.b0 = n1; if (s.b1 > n1) s.b1 = n1;
    return s;
}

DEV void phase_pro(const Ctx& c) {
    constexpr int NB = NMOD * D / 256, NITEM = DEPTH * NB, KW = D / NWAVES;
    LAS float* S = (LAS float*)c.lds;
    LAS float* P = (LAS float*)(c.lds + NCOND * D * 4);
    bool have = false;
    const int gstride = c.G >= 256 ? 128 : c.G;
    for (int it = c.bid; it < NITEM && c.bid < gstride; it += gstride) {
        if (!have) { for (int i = c.tid; i < NCOND * D; i += NTHREADS) { const int r = i / D, k = i % D; const float v = r == 0 ? c.in(I_CCTX)[k] : c.in(I_C)[(size_t)(r - 1) * D + k]; S[i] = siluf_(v); } have = true; wg_sync(); }
        const int l = it / NB, cb = it % NB;
        const float* W = c.in(I_WMOD) + (size_t)l * D * NMOD * D + (size_t)cb * 256 + c.lane * 4;
        f32x4 acc[NCOND];
#pragma unroll
        for (int r = 0; r < NCOND; ++r) acc[r] = (f32x4){0.f, 0.f, 0.f, 0.f};
        constexpr int GU = 16;
        static_assert(KW % GU == 0, "mod GEMV unroll");
        for (int k = c.wave * KW; k < (c.wave + 1) * KW; k += GU) { f32x4 w[GU];
#pragma unroll
            for (int q = 0; q < GU; ++q) w[q] = *(const f32x4*)(W + (size_t)(k + q) * NMOD * D);
#pragma unroll
            for (int q = 0; q < GU; ++q) {
#pragma unroll
                for (int r = 0; r < NCOND; ++r) acc[r] += w[q] * S[r * D + k + q]; } }
#pragma unroll
        for (int r = 0; r < NCOND; ++r) *(LAS f32x4*)(P + (c.wave * NCOND + r) * 256 + c.lane * 4) = acc[r];
        wg_sync();
        for (int i = c.tid; i < NCOND * 256; i += NTHREADS) { const int r = i / 256, n = i % 256; float s = c.in(I_BMOD)[(size_t)l * NMOD * D + cb * 256 + n];
#pragma unroll
            for (int w = 0; w < NWAVES; ++w) s += P[(w * NCOND + r) * 256 + n];
            c.ws<float>(WS_MOD)[((size_t)l * NCOND + r) * NMOD * D + cb * 256 + n] = s; }
        wg_sync();
    }
}

template <class MapF> DEV void cvt_item(const float* W, int ldw, int K, bf16_t* WT, LAS float* scr, int item, int nblk, int lane, MapF colmap) {
    const int kb = item / nblk, nb = item % nblk, k0 = 64 * kb, n0 = 64 * nb;
    const int r = lane >> 4, c4 = (lane & 15) * 4, col = colmap(n0 + c4);
    f32x4 v[16];
#pragma unroll
    for (int i = 0; i < 16; ++i) v[i] = col >= 0 ? *(const f32x4*)(W + (size_t)(k0 + 4 * i + r) * ldw + col) : (f32x4){0.f, 0.f, 0.f, 0.f};
#pragma unroll
    for (int i = 0; i < 16; ++i) { LAS float* d = scr + (4 * i + r) * 65 + c4; d[0] = v[i].x; d[1] = v[i].y; d[2] = v[i].z; d[3] = v[i].w; }
    LDS_WAIT(); CFENCE(); WAVE_SYNC();
    const int ch = lane & 7;
#pragma unroll
    for (int j = 0; j < 8; ++j) { const int n = (lane >> 3) + 8 * j; const LAS float* s = scr + (8 * ch) * 65 + n;
        u32x4 o; o.x = pk2(s[0 * 65], s[1 * 65]); o.y = pk2(s[2 * 65], s[3 * 65]); o.z = pk2(s[4 * 65], s[5 * 65]); o.w = pk2(s[6 * 65], s[7 * 65]);
        *(u32x4*)(WT + (size_t)(n0 + n) * K + k0 + 8 * ch) = o; }
    LDS_WAIT(); CFENCE(); WAVE_SYNC();
}
DEV void s5_build(const Ctx& c, int l, int g) {
    LAS float* POW = (LAS float*)c.lds;
    LAS float* BBv = POW + 2 * (S5L + 1) * 64 * 2;
    LAS float* KT = BBv + 2 * 64 * 16 * 2;
    static_assert((2 * (S5L + 1) * 64 * 2 + 2 * 64 * 16 * 2 + 2 * S5L * 256) * 4 <= LDS_MAIN_BYTES, "s5_build LDS");
    for (int e = c.tid; e < 2 * (S5L + 1) * 64; e += NTHREADS) { const int d = e / ((S5L + 1) * 64), m = (e / 64) % (S5L + 1), p = e % 64;
        const size_t gp = ((size_t)(l * 2 + d) * CG + g) * CP + p; const float delta = expf(c.in(I_CLDT)[(size_t)(l * 2 + d) * CG + g]);
        const float rho = c.in(I_CLRE)[gp] * delta, th = c.in(I_CLIM)[gp] * delta, mag = expf((float)m * rho);
        POW[e * 2] = mag * cosf((float)m * th); POW[e * 2 + 1] = mag * sinf((float)m * th); }
    for (int e = c.tid; e < 2 * 64 * 16; e += NTHREADS) { const int d = e / 1024, p = (e / 16) % 64, k = e % 16;
        const size_t gp = ((size_t)(l * 2 + d) * CG + g) * CP + p; const float lre = c.in(I_CLRE)[gp], lim = c.in(I_CLIM)[gp], delta = expf(c.in(I_CLDT)[(size_t)(l * 2 + d) * CG + g]);
        const float mag = expf(lre * delta), lbr = mag * cosf(lim * delta), lbi = mag * sinf(lim * delta), den = lre * lre + lim * lim;
        const float qr = ((lbr - 1.0f) * lre + lbi * lim) / den, qi = (lbi * lre - (lbr - 1.0f) * lim) / den;
        const float br = c.in(I_CBRE)[gp * 16 + k], bi = c.in(I_CBIM)[gp * 16 + k];
        BBv[e * 2] = qr * br - qi * bi; BBv[e * 2 + 1] = qr * bi + qi * br; }
    wg_sync();
    static_assert(NTHREADS == 2 * 16 * 16, "s5_build: one thread per (direction, output channel, input channel)");
    {
        const int d = c.tid >> 8, cc = (c.tid >> 4) & 15, k = c.tid & 15;
        const float* cre = c.in(I_CCRE) + (((size_t)(l * 2 + d) * CG + g) * 16 + cc) * CP; const float* cim = c.in(I_CCIM) + (((size_t)(l * 2 + d) * CG + g) * 16 + cc) * CP;
        float acc[S5L];
#pragma unroll
        for (int m = 0; m < S5L; ++m) acc[m] = 0.f;
#pragma unroll 2
        for (int p = 0; p < 64; ++p) { const float cr = cre[p], ci = cim[p], br = BBv[((d * 64 + p) * 16 + k) * 2], bi = BBv[((d * 64 + p) * 16 + k) * 2 + 1];
            const float wr = cr * br - ci * bi, wi = cr * bi + ci * br;
#pragma unroll
            for (int m = 0; m < S5L; ++m) { const f32x2 pw = *(const LAS f32x2*)(POW + ((d * (S5L + 1) + m) * 64 + p) * 2); acc[m] += wr * pw.x - wi * pw.y; } }
#pragma unroll
        for (int m = 0; m < S5L; ++m) KT[((d * S5L + m) * 16 + cc) * 16 + k] = acc[m];
    }
    wg_sync();
    bf16_t* W = c.ws<bf16_t>(WS_S5W + (size_t)l * S5W_L) + (size_t)g * S5N1 * S5K; bf16_t* F = c.ws<bf16_t>(WS_S5F + (size_t)l * S5F_L) + (size_t)g * S5K * 256;
    for (int e = c.tid; e < S5K * (S5K / 8); e += NTHREADS) { const int n = e / (S5K / 8), kc = e % (S5K / 8), t = n >> 4, cc = n & 15, j = kc >> 1, k0 = (kc & 1) * 8; float o[8];
#pragma unroll
        for (int q = 0; q < 8; ++q) o[q] = (j <= t ? KT[((0 * S5L + (t - j)) * 16 + cc) * 16 + k0 + q] : 0.f) + (j >= t ? KT[((1 * S5L + (j - t)) * 16 + cc) * 16 + k0 + q] : 0.f);
        st8(W + (size_t)n * S5K + kc * 8, pack8(o)); }
    for (int e = c.tid; e < 256 * (S5K / 8); e += NTHREADS) { const int q = e / (S5K / 8), kc = e % (S5K / 8), d = q >> 7, im = (q >> 6) & 1, p = q & 63, j = kc >> 1, k0 = (kc & 1) * 8, m = d ? j : S5L - 1 - j;
        const float pr = POW[((d * (S5L + 1) + m) * 64 + p) * 2], pi = POW[((d * (S5L + 1) + m) * 64 + p) * 2 + 1]; float o[8];
#pragma unroll
        for (int x = 0; x < 8; ++x) { const float br = BBv[((d * 64 + p) * 16 + k0 + x) * 2], bi = BBv[((d * 64 + p) * 16 + k0 + x) * 2 + 1]; o[x] = im ? (pr * bi + pi * br) : (pr * br - pi * bi); }
        st8(W + (size_t)(S5K + q) * S5K + kc * 8, pack8(o)); }
    for (int e = c.tid; e < S5K * 32; e += NTHREADS) { const int n = e / 32, qc = e % 32, t = n >> 4, cc = n & 15, q0 = qc * 8, d = q0 >> 7, im = (q0 >> 6) & 1, p0 = q0 & 63, m = d ? S5L - t : t + 1;
        const float* cre = c.in(I_CCRE) + (((size_t)(l * 2 + d) * CG + g) * 16 + cc) * CP + p0; const float* cim = c.in(I_CCIM) + (((size_t)(l * 2 + d) * CG + g) * 16 + cc) * CP + p0; float o[8];
#pragma unroll
        for (int x = 0; x < 8; ++x) { const float pr = POW[((d * (S5L + 1) + m) * 64 + p0 + x) * 2], pi = POW[((d * (S5L + 1) + m) * 64 + p0 + x) * 2 + 1]; o[x] = im ? -(cre[x] * pi + cim[x] * pr) : (cre[x] * pr - cim[x] * pi); }
        st8(F + (size_t)n * 256 + q0, pack8(o)); }
    wg_sync();
}
constexpr int CI_FI = (D / 64) * (2 * FF / 64), CI_FO = (FF / 64) * (D / 64), CI_WIM = (D / 64) * (NZ_MIX / 64), CI_WIG = (D / 64) * (3 * D / 64), CI_PA = (RW / 64) * (D / 64), CI_PB = (SW / 64) * (D / 64), CI_PC = (CW / 64) * (2 * D / 64), CI_WO = (D / 64) * (D / 64), CI_LR = 5 * 4 * (RW / 64);
constexpr int CONV_NE = CI_FI + CI_FO + CI_WIM + CI_LR, CONV_NL = CI_WIG + CI_PA + CI_PB + CI_PC + CI_WO + CI_FI + CI_FO;
static_assert((2 * FF) % 64 == 0 && NZ % 64 == 0 && NZ_MIX % 64 == 0 && FF % 64 == 0 && 8 * 16640 <= LDS_MISC && (LRN * 256) % 4096 == 0, "conversion tiles");
DEV void conv_one(const Ctx& c, int l, bool late, int r, LAS float* scr) {
    auto ident = [](int n) { return n; };
    auto ffmap = [](int n) { return ((n >> 7) & 1) * FF + (n >> 8) * 128 + (n & 127); };
    auto pcmap = [](int n) { return ((n >> 7) & 1) * D + (n >> 8) * 128 + (n & 127); };
    auto wimap = [](int n) { return n < RCOLS + SCOLS ? n : (n < RCOLS + ZB_LD ? -1 : n - (ZB_LD - SCOLS)); };
    if (!late) {
        if (r < CI_FI) { cvt_item(c.in(I_FWIN) + (size_t)(l * 2) * D * 2 * FF, 2 * FF, D, c.ws<bf16_t>(WS_FIT), scr, r, 2 * FF / 64, c.lane, ffmap); return; } r -= CI_FI;
        if (r < CI_FO) { cvt_item(c.in(I_FWOUT) + (size_t)(l * 2) * FF * D, D, FF, c.ws<bf16_t>(WS_FOT), scr, r, D / 64, c.lane, ident); return; } r -= CI_FO;
        if (r < CI_WIM) { cvt_item(c.in(I_WIN) + (size_t)l * D * DIN, DIN, D, c.ws<bf16_t>(WS_WIT), scr, (r / (NZ_MIX / 64)) * (NZ / 64) + r % (NZ_MIX / 64), NZ / 64, c.lane, wimap); return; } r -= CI_WIM;
        { const int blk = r / (4 * (RW / 64)), kb = (r / (RW / 64)) % 4, nb = r % (RW / 64);
          const bool data = blk < 2 ? kb == 0 : (blk < 4 ? kb == 1 : kb >= 2);
          const float* src = blk < 2 ? c.in(I_RW2) + (size_t)(l * 2 + blk) * 64 * RW : (blk < 4 ? c.in(I_RA2) + (size_t)(l * 2 + blk - 2) * 64 * RW - (size_t)64 * RW : c.in(I_RG2) + (size_t)l * 128 * RW - (size_t)128 * RW);
          auto zmap = [](int) { return -1; };
          if (data) cvt_item(src, RW, 256, c.ws<bf16_t>(WS_LRT) + (size_t)blk * RW * 256, scr, kb * (RW / 64) + nb, RW / 64, c.lane, ident);
          else cvt_item(src, RW, 256, c.ws<bf16_t>(WS_LRT) + (size_t)blk * RW * 256, scr, kb * (RW / 64) + nb, RW / 64, c.lane, zmap); }
        return;
    }
    if (r < CI_WIG) { cvt_item(c.in(I_WIN) + (size_t)l * D * DIN, DIN, D, c.ws<bf16_t>(WS_WIT), scr, (r / (3 * D / 64)) * (NZ / 64) + NZ_MIX / 64 + r % (3 * D / 64), NZ / 64, c.lane, wimap); return; } r -= CI_WIG;
    if (r < CI_PA) { cvt_item(c.in(I_PA) + (size_t)l * RW * D, D, RW, c.ws<bf16_t>(WS_PAT), scr, r, D / 64, c.lane, ident); return; } r -= CI_PA;
    if (r < CI_PB) { cvt_item(c.in(I_PB) + (size_t)l * SW * D, D, SW, c.ws<bf16_t>(WS_PBT), scr, r, D / 64, c.lane, ident); return; } r -= CI_PB;
    if (r < CI_PC) { cvt_item(c.in(I_PC) + (size_t)l * CW * 2 * D, 2 * D, CW, c.ws<bf16_t>(WS_PCT), scr, r, 2 * D / 64, c.lane, pcmap); return; } r -= CI_PC;
    if (r < CI_WO) { cvt_item(c.in(I_WOUT) + (size_t)l * D * D, D, D, c.ws<bf16_t>(WS_WOT), scr, r, D / 64, c.lane, ident); return; } r -= CI_WO;
    if (r < CI_FI) { cvt_item(c.in(I_FWIN) + (size_t)(l * 2 + 1) * D * 2 * FF, 2 * FF, D, c.ws<bf16_t>(WS_FIT) + (size_t)2 * FF * D, scr, r, 2 * FF / 64, c.lane, ffmap); return; } r -= CI_FI;
    cvt_item(c.in(I_FWOUT) + (size_t)(l * 2 + 1) * FF * D, D, FF, c.ws<bf16_t>(WS_FOT) + (size_t)D * FF, scr, r, D / 64, c.lane, ident);
}

DEV void phase_norm(const Ctx& c, int l, int j) {
    constexpr int NV = D / 256;
    const float* X = c.ws<float>(WS_X); bf16_t* H = c.ws<bf16_t>(WS_H);
    for (int row = c.gw(); row < M; row += c.ngw()) {
        const float* xrow = (l == 0 && j == 0) ? (row < MC ? c.in(I_XP) + (size_t)row * D : c.in(I_XS) + (size_t)(row - MC) * D) : X + (size_t)row * D;
        const f32x4* xr = (const f32x4*)xrow + c.lane; f32x4 v[NV]; float ss = 0.f;
#pragma unroll
        for (int i = 0; i < NV; ++i) { v[i] = xr[64 * i]; ss += (v[i].x * v[i].x + v[i].y * v[i].y) + (v[i].z * v[i].z + v[i].w * v[i].w); }
        const float rstd = rsqrtf(wave_sum(ss) * (1.0f / D) + EPS);
        const float* mod = c.ws<float>(WS_MOD) + ((size_t)l * NCOND + cond_of_row(row)) * NMOD * D;
        const f32x4* sh = (const f32x4*)(mod + (size_t)(3 * j) * D) + c.lane; const f32x4* sc = (const f32x4*)(mod + (size_t)(3 * j + 1) * D) + c.lane;
        const f32x4* g = (const f32x4*)(c.in(I_NORMG) + (size_t)(l * 3 + j) * D) + c.lane;
        u32x2* o = (u32x2*)(H + (size_t)row * D) + c.lane;
#pragma unroll
        for (int i = 0; i < NV; ++i) { const f32x4 y = v[i] * rstd * g[64 * i] * (sc[64 * i] + 1.0f) + sh[64 * i]; u32x2 w; w.x = pk2(y.x, y.y); w.y = pk2(y.z, y.w); o[64 * i] = w; }
    }
}
DEV void phase_final(const Ctx& c) {
    constexpr int NV = D / 256;
    const float* X = c.ws<float>(WS_X);
    for (int row = c.gw(); row < M; row += c.ngw()) {
        const f32x4* xr = (const f32x4*)(X + (size_t)row * D) + c.lane; f32x4 v[NV]; float ss = 0.f;
#pragma unroll
        for (int i = 0; i < NV; ++i) { v[i] = xr[64 * i]; ss += (v[i].x * v[i].x + v[i].y * v[i].y) + (v[i].z * v[i].z + v[i].w * v[i].w); }
        const float rstd = rsqrtf(wave_sum(ss) * (1.0f / D) + EPS);
        const f32x4* g = (const f32x4*)c.in(I_FNG) + c.lane; f32x4* o = (f32x4*)(c.out() + OUT_Y + (size_t)row * D) + c.lane;
#pragma unroll
        for (int i = 0; i < NV; ++i) o[64 * i] = v[i] * rstd * g[64 * i];
    }
}

DEV void acc8(float (&a)[8], const bf16_t* p, float w) { float f[8]; unpack8(ld8(p), f);
#pragma unroll
    for (int j = 0; j < 8; ++j) a[j] += w * f[j]; }
DEV void phase_prep(const Ctx& c, int l) {
    const bf16_t* ZA = c.ws<bf16_t>(WS_ZA); const bf16_t* ZB = c.ws<bf16_t>(WS_ZB);
    bf16_t* XS = c.ws<bf16_t>(WS_XS); bf16_t* KK = c.ws<bf16_t>(WS_KK); bf16_t* LRI = c.ws<bf16_t>(WS_LRI); bf16_t* XBC = c.ws<bf16_t>(WS_XBC); float* DT = c.ws<float>(WS_DT);
    for (int it = c.gw(); it < 2 * M; it += c.ngw()) {
        if (it < M) {
            const int row = it; int nbr[4]; float wn;
            if (row < MC) { const int t = row % SEQ; nbr[0] = t > 0 ? row - 1 : -1; nbr[1] = t < SEQ - 1 ? row + 1 : -1; nbr[2] = -1; nbr[3] = -1; wn = 0.5f; }
            else { const int t = (row - MC) % DEC_SEQ, gy = t / GRID_W, gx = t % GRID_W; nbr[0] = gy > 0 ? row - GRID_W : -1; nbr[1] = gy < DEC_SEQ / GRID_W - 1 ? row + GRID_W : -1; nbr[2] = gx > 0 ? row - 1 : -1; nbr[3] = gx < GRID_W - 1 ? row + 1 : -1; wn = 0.25f; }
            constexpr int NCH = RCOLS / 8, NIT = (NCH + 63) / 64;
            struct PrepLd { u32x4 z, n[4]; f32x4 mu0, mu1; };
            auto issue = [&](int i, PrepLd& L) { const int ch = c.lane + 64 * i; const int col = ch < NCH ? 8 * ch : 0;
                L.z = ld8(ZA + (size_t)row * RCOLS + col);
#pragma unroll
                for (int q = 0; q < 4; ++q) L.n[q] = nbr[q] >= 0 ? ld8(ZA + (size_t)nbr[q] * RCOLS + col) : (u32x4){0u, 0u, 0u, 0u};
                const float* mu = c.in(I_RMU) + (size_t)l * RCOLS + col; L.mu0 = *(const f32x4*)mu; L.mu1 = *(const f32x4*)(mu + 4); };
            auto finish = [&](int i, const PrepLd& L) {
                const int ch = c.lane + 64 * i; const bool act = ch < NCH; const int col = act ? 8 * ch : 0;
                float z[8], nb[8], xs[8], f[8];
                unpack8(L.z, z);
#pragma unroll
                for (int j = 0; j < 8; ++j) nb[j] = 0.f;
#pragma unroll
                for (int q = 0; q < 4; ++q) { unpack8(L.n[q], f);
#pragma unroll
                    for (int j = 0; j < 8; ++j) nb[j] += wn * f[j]; }
                const float mu[8] = {L.mu0.x, L.mu0.y, L.mu0.z, L.mu0.w, L.mu1.x, L.mu1.y, L.mu1.z, L.mu1.w};
#pragma unroll
                for (int j = 0; j < 8; ++j) xs[j] = z[j] + mu[j] * (nb[j] - z[j]);
                float kv[8], ssq = 0.f; const bool isk = act && col >= RW && col < 2 * RW;
                if (isk) { const float* kkw = c.in(I_RKK) + (size_t)l * RW + (col - RW);
#pragma unroll
                    for (int j = 0; j < 8; ++j) { kv[j] = xs[j] * kkw[j]; ssq += kv[j] * kv[j]; } }
                else {
#pragma unroll
                    for (int j = 0; j < 8; ++j) kv[j] = 0.f; }
                ssq = red8(ssq);
                if (act) {
                    if (col < 3 * RW) { st8(XS + (size_t)row * 3 * RW + col, pack8(xs));
                        if (isk) { const float rn = rsqrtf(ssq + 1e-12f);
#pragma unroll
                            for (int j = 0; j < 8; ++j) kv[j] *= rn;
                            st8(KK + (size_t)row * RW + (col - RW), pack8(kv)); } }
                    else { const int cc = col - 3 * RW; float o[8];
#pragma unroll
                        for (int j = 0; j < 8; ++j) o[j] = cc < 64 ? tanhf(xs[j]) : (cc < 128 ? xs[j] : sigmoidf_(xs[j]));
                        st8(LRI + (size_t)row * 256 + cc, pack8(o)); }
                } };
            PrepLd LA, LB; issue(0, LA);
#pragma unroll 1
            for (int i = 0; i < NIT; i += 2) {
                if (i + 1 < NIT) issue(i + 1, LB);
                finish(i, LA);
                if (i + 2 < NIT) issue(i + 2, LA);
                if (i + 1 < NIT) finish(i + 1, LB);
            }
        } else {
            const int row = it - M; int t, T; if (row < MC) { t = row % SEQ; T = SEQ; } else { t = (row - MC) % DEC_SEQ; T = DEC_SEQ; }
            constexpr int NCH = SXBC / 8, NIT = (NCH + 63) / 64;
            struct TapLd { u32x4 t[5]; };
            auto issue = [&](int i, TapLd& L) { const int ch = c.lane + 64 * i; const int col = ch < NCH ? 8 * ch : 0;
#pragma unroll
                for (int q = 0; q < 5; ++q) { const int tt = t + q - 2; L.t[q] = (tt >= 0 && tt < T) ? ld8(ZB + (size_t)(row + q - 2) * ZB_LD + SW + col) : (u32x4){0u, 0u, 0u, 0u}; } };
            auto finish = [&](int i, const TapLd& L) { const int ch = c.lane + 64 * i; if (ch >= NCH) return; const int col = 8 * ch; float a[8];
                const float* cb = c.in(I_SCB) + (size_t)l * SXBC + col;
#pragma unroll
                for (int j = 0; j < 8; ++j) a[j] = cb[j];
#pragma unroll
                for (int q = 0; q < 5; ++q) { float f[8]; unpack8(L.t[q], f);
                    const float* cw = c.in(I_SCW) + ((size_t)l * 5 + q) * SXBC + col;
#pragma unroll
                    for (int j = 0; j < 8; ++j) a[j] += cw[j] * f[j]; }
#pragma unroll
                for (int j = 0; j < 8; ++j) a[j] = siluf_(a[j]);
                st8(XBC + (size_t)row * SXBC + col, pack8(a)); };
            TapLd LA, LB; issue(0, LA);
#pragma unroll 1
            for (int i = 0; i < NIT; i += 2) {
                if (i + 1 < NIT) issue(i + 1, LB);
                finish(i, LA);
                if (i + 2 < NIT) issue(i + 2, LA);
                if (i + 1 < NIT) finish(i + 1, LB);
            }
            if (c.lane < SH) { const float raw = bf1(ZB[(size_t)row * ZB_LD + SW + SXBC + c.lane]);
#pragma unroll
                for (int d = 0; d < 2; ++d) DT[((size_t)d * M + row) * SH + c.lane] = softplusf_(raw + c.in(I_SDTB)[(size_t)(l * 2 + d) * SH + c.lane]); }
        }
    }
}

constexpr int TB = 32;
static_assert(SEQ % TB == 0 && DEC_SEQ % TB == 0, "scan block");
DEV void rwkv_chain(const Ctx& c, int l, bool lat, int b, int h, int d) {
    const int T = lat ? DEC_SEQ : SEQ, row0 = lat ? MC + b * DEC_SEQ : b * SEQ, nblk = T / TB;
    const bf16_t* XS = c.ws<bf16_t>(WS_XS); const bf16_t* KK = c.ws<bf16_t>(WS_KK);
    const bf16_t* OMD = c.ws<bf16_t>(WS_OMD) + (size_t)d * M * RW; const bf16_t* KD = c.ws<bf16_t>(WS_KD) + (size_t)d * M * RW; const bf16_t* BB = c.ws<bf16_t>(WS_BB) + (size_t)d * M * RW;
    bf16_t* O = c.ws<bf16_t>(WS_O) + (size_t)d * M * RW;
    LAS float* VEC = (LAS float*)c.lds;
    LAS float* OUTS = (LAS float*)(c.lds + 2 * TB * 6 * 64 * 4);
    const int vrow = c.tid >> 3, cg = c.tid & 7;
    f32x2 s2[4];
    if (lat) { const float* s0 = c.in(I_SRWKV) + ((((size_t)b * DEPTH + l) * 2 + d) * RH + h) * 4096 + vrow * 64 + cg * 8;
#pragma unroll
        for (int j = 0; j < 4; ++j) s2[j] = (f32x2){s0[2 * j], s0[2 * j + 1]}; }
    else {
#pragma unroll
        for (int j = 0; j < 4; ++j) s2[j] = (f32x2){0.f, 0.f}; }
    u32x4 stg[3];
    auto gload = [&](int blk) {
#pragma unroll
        for (int q = 0; q < 3; ++q) { const int task = c.tid + NTHREADS * q, i = task / 48, rem = task % 48, vec = rem >> 3, cc = rem & 7;
            const int st = blk * TB + i, row = row0 + (d ? T - 1 - st : st); const size_t hc = (size_t)h * 64 + cc * 8;
            const bf16_t* p = vec == 0 ? XS + (size_t)row * 3 * RW + hc : vec == 1 ? OMD + (size_t)row * RW + hc : vec == 2 ? KD + (size_t)row * RW + hc : vec == 3 ? BB + (size_t)row * RW + hc : vec == 4 ? KK + (size_t)row * RW + hc : XS + (size_t)row * 3 * RW + 2 * RW + hc;
            stg[q] = ld8(p); } };
    auto lstore = [&](int buf) {
#pragma unroll
        for (int q = 0; q < 3; ++q) { const int task = c.tid + NTHREADS * q, i = task / 48, rem = task % 48, vec = rem >> 3, cc = rem & 7; float f[8]; unpack8(stg[q], f);
            if (vec == 1) {
#pragma unroll
                for (int j = 0; j < 8; ++j) f[j] = 1.0f - f[j]; }
            LAS float* dst = VEC + ((buf * TB + i) * 6 + vec) * 64 + cc * 8; *(LAS f32x4*)dst = (f32x4){f[0], f[1], f[2], f[3]}; *(LAS f32x4*)(dst + 4) = (f32x4){f[4], f[5], f[6], f[7]}; } };
    gload(0); lstore(0); wg_sync();
    for (int blk = 0; blk < nblk; ++blk) {
        const int buf = blk & 1;
        if (blk + 1 < nblk) gload(blk + 1);
        struct RwOps { f32x4 r0, r1, w0, w1, k0, k1, b0, b1, q0, q1; float vv; };
#define RW_LOAD(X, i_) do { const LAS float* V_ = VEC + (buf * TB + (i_)) * 6 * 64 + cg * 8; \
            X.r0 = *(const LAS f32x4*)(V_); X.r1 = *(const LAS f32x4*)(V_ + 4); X.w0 = *(const LAS f32x4*)(V_ + 64); X.w1 = *(const LAS f32x4*)(V_ + 68); X.k0 = *(const LAS f32x4*)(V_ + 128); X.k1 = *(const LAS f32x4*)(V_ + 132); \
            X.b0 = *(const LAS f32x4*)(V_ + 192); X.b1 = *(const LAS f32x4*)(V_ + 196); X.q0 = *(const LAS f32x4*)(V_ + 256); X.q1 = *(const LAS f32x4*)(V_ + 260); X.vv = VEC[((buf * TB + (i_)) * 6 + 5) * 64 + vrow]; } while (0)
#define RW_STEP(X, i_) do { \
            f32x2 a2 = s2[0] * PR(X.q0, 0); a2 = s2[1] * PR(X.q0, 1) + a2; a2 = s2[2] * PR(X.q1, 0) + a2; a2 = s2[3] * PR(X.q1, 1) + a2; \
            const float skk = red8(a2.x + a2.y); const f32x2 v2 = (f32x2){X.vv, X.vv}, n2 = (f32x2){-skk, -skk}; \
            s2[0] = s2[0] * PR(X.w0, 0) + (n2 * PR(X.b0, 0) + v2 * PR(X.k0, 0)); s2[1] = s2[1] * PR(X.w0, 1) + (n2 * PR(X.b0, 1) + v2 * PR(X.k0, 1)); \
            s2[2] = s2[2] * PR(X.w1, 0) + (n2 * PR(X.b1, 0) + v2 * PR(X.k1, 0)); s2[3] = s2[3] * PR(X.w1, 1) + (n2 * PR(X.b1, 1) + v2 * PR(X.k1, 1)); \
            f32x2 o2 = s2[0] * PR(X.r0, 0); o2 = s2[1] * PR(X.r0, 1) + o2; o2 = s2[2] * PR(X.r1, 0) + o2; o2 = s2[3] * PR(X.r1, 1) + o2; \
            const float o = red8(o2.x + o2.y); if (cg == 0) OUTS[(i_) * 64 + vrow] = o; } while (0)
        static_assert(TB % 2 == 0, "paired steps");
        RwOps A, B; RW_LOAD(A, 0);
#pragma unroll 1
        for (int i = 0; i < TB; i += 2) {
            RW_LOAD(B, i + 1); RW_STEP(A, i);
            if (i + 2 < TB) RW_LOAD(A, i + 2);
            RW_STEP(B, i + 1);
        }
#undef RW_STEP
#undef RW_LOAD
        wg_sync();
        { const int i = c.tid >> 4, c4 = (c.tid & 15) * 4, st = blk * TB + i, row = row0 + (d ? T - 1 - st : st); const f32x4 v = *(const LAS f32x4*)(OUTS + i * 64 + c4);
          u32x2 w; w.x = pk2(v.x, v.y); w.y = pk2(v.z, v.w); *(u32x2*)(O + (size_t)row * RW + h * 64 + c4) = w; }
        if (blk + 1 < nblk) lstore(buf ^ 1);
        wg_sync();
    }
    if (!lat) { float* o = c.out() + OUT_RWKV + ((((size_t)b * DEPTH + l) * 2 + d) * RH + h) * 4096 + vrow * 64 + cg * 8;
        *(f32x4*)o = (f32x4){s2[0].x, s2[0].y, s2[1].x, s2[1].y}; *(f32x4*)(o + 4) = (f32x4){s2[2].x, s2[2].y, s2[3].x, s2[3].y}; }
}
typedef _Float16 h2_t __attribute__((ext_vector_type(2)));
#ifdef CPU_EMU
DEV h2_t hfma2(h2_t a, h2_t b, h2_t c) { h2_t r; r.x = (_Float16)((float)a.x * (float)b.x + (float)c.x); r.y = (_Float16)((float)a.y * (float)b.y + (float)c.y); return r; }
DEV float hdot2(h2_t a, h2_t b, float c) { return (float)a.x * (float)b.x + ((float)a.y * (float)b.y + c); }
#else
DEV h2_t hfma2(h2_t a, h2_t b, h2_t c) { return __builtin_elementwise_fma(a, b, c); }
DEV float hdot2(h2_t a, h2_t b, float c) { return __builtin_amdgcn_fdot2(a, b, c, false); }
#endif
DEV unsigned pkh2(float lo, float hi) { h2_t v; v.x = (_Float16)lo; v.y = (_Float16)hi; return __builtin_bit_cast(unsigned, v); }
DEV h2_t ash2(unsigned w) { return __builtin_bit_cast(h2_t, w); }
constexpr int TBH = 64;
static_assert(DEC_SEQ % TBH == 0 && 2 * TBH * 6 * 64 * 2 + (TBH + 1) * 64 * 4 <= LDS_MISC, "half rwkv chain blocks");
DEV void rwkv_chain_h(const Ctx& c, int l, int b, int h, int d) {
    constexpr int T = DEC_SEQ, nblk = T / TBH; const int row0 = MC + b * DEC_SEQ;
    const bf16_t* XS = c.ws<bf16_t>(WS_XS); const bf16_t* KK = c.ws<bf16_t>(WS_KK);
    const bf16_t* OMD = c.ws<bf16_t>(WS_OMD) + (size_t)d * M * RW; const bf16_t* KD = c.ws<bf16_t>(WS_KD) + (size_t)d * M * RW; const bf16_t* BB = c.ws<bf16_t>(WS_BB) + (size_t)d * M * RW;
    bf16_t* O = c.ws<bf16_t>(WS_O) + (size_t)d * M * RW;
    LAS unsigned* VEC = (LAS unsigned*)c.lds;
    LAS float* OUTS = (LAS float*)(c.lds + 2 * TBH * 6 * 64 * 2);
    const int vrow = c.tid >> 3, cg = c.tid & 7;
    h2_t s2[4];
    { const float* s0 = c.in(I_SRWKV) + ((((size_t)b * DEPTH + l) * 2 + d) * RH + h) * 4096 + vrow * 64 + cg * 8;
#pragma unroll
      for (int j = 0; j < 4; ++j) s2[j] = ash2(pkh2(s0[2 * j], s0[2 * j + 1])); }
    constexpr int NQ = TBH * 48 / NTHREADS; static_assert(TBH * 48 % NTHREADS == 0, "staging tasks");
    u32x4 stg[NQ];
    auto gload = [&](int blk) {
#pragma unroll
        for (int q = 0; q < NQ; ++q) { const int task = c.tid + NTHREADS * q, i = task / 48, rem = task % 48, vec = rem >> 3, cc = rem & 7;
            const int st = blk * TBH + i, row = row0 + (d ? T - 1 - st : st); const size_t hc = (size_t)h * 64 + cc * 8;
            const bf16_t* p = vec == 0 ? XS + (size_t)row * 3 * RW + hc : vec == 1 ? OMD + (size_t)row * RW + hc : vec == 2 ? KD + (size_t)row * RW + hc : vec == 3 ? BB + (size_t)row * RW + hc : vec == 4 ? KK + (size_t)row * RW + hc : XS + (size_t)row * 3 * RW + 2 * RW + hc;
            stg[q] = ld8(p); } };
    auto lstore = [&](int buf) {
#pragma unroll
        for (int q = 0; q < NQ; ++q) { const int task = c.tid + NTHREADS * q, i = task / 48, rem = task % 48, vec = rem >> 3, cc = rem & 7; float f[8]; unpack8(stg[q], f);
            if (vec == 1) {
#pragma unroll
                for (int j = 0; j < 8; ++j) f[j] = 1.0f - f[j]; }
            u32x4 o; o.x = pkh2(f[0], f[1]); o.y = pkh2(f[2], f[3]); o.z = pkh2(f[4], f[5]); o.w = pkh2(f[6], f[7]);
            *(LAS u32x4*)(VEC + ((buf * TBH + i) * 6 + vec) * 32 + cc * 4) = o; } };
    gload(0); lstore(0); wg_sync();
    for (int blk = 0; blk < nblk; ++blk) {
        const int buf = blk & 1;
        if (blk + 1 < nblk) gload(blk + 1);
        struct RwH { u32x4 r, w, k, b, q; unsigned vv; };
#define RH_LOAD(X, i_) do { const LAS unsigned* V_ = VEC + (buf * TBH + (i_)) * 6 * 32 + cg * 4; \
            X.r = *(const LAS u32x4*)(V_); X.w = *(const LAS u32x4*)(V_ + 32); X.k = *(const LAS u32x4*)(V_ + 64); X.b = *(const LAS u32x4*)(V_ + 96); X.q = *(const LAS u32x4*)(V_ + 128); \
            X.vv = ((const LAS unsigned short*)(VEC + ((buf * TBH + (i_)) * 6 + 5) * 32))[vrow]; } while (0)
#define RH_STEP(X, i_) do { \
            float sa = hdot2(s2[0], ash2(X.q.x), 0.f); sa = hdot2(s2[1], ash2(X.q.y), sa); sa = hdot2(s2[2], ash2(X.q.z), sa); sa = hdot2(s2[3], ash2(X.q.w), sa); \
            const float skk = red8(sa); const h2_t n2 = ash2(pkh2(-skk, -skk)), v2 = ash2(X.vv | (X.vv << 16)); \
            s2[0] = hfma2(s2[0], ash2(X.w.x), hfma2(v2, ash2(X.k.x), n2 * ash2(X.b.x))); s2[1] = hfma2(s2[1], ash2(X.w.y), hfma2(v2, ash2(X.k.y), n2 * ash2(X.b.y))); \
            s2[2] = hfma2(s2[2], ash2(X.w.z), hfma2(v2, ash2(X.k.z), n2 * ash2(X.b.z))); s2[3] = hfma2(s2[3], ash2(X.w.w), hfma2(v2, ash2(X.k.w), n2 * ash2(X.b.w))); \
            float o = hdot2(s2[0], ash2(X.r.x), 0.f); o = hdot2(s2[1], ash2(X.r.y), o); o = hdot2(s2[2], ash2(X.r.z), o); o = hdot2(s2[3], ash2(X.r.w), o); \
            o = red8(o); OUTS[cg == 0 ? (i_) * 64 + vrow : TBH * 64 + (c.tid & 63)] = o; } while (0)
        RwH A, B; RH_LOAD(A, 0);
#pragma unroll 1
        for (int i = 0; i < TBH; i += 2) {
            RH_LOAD(B, i + 1); RH_STEP(A, i);
            RH_LOAD(A, i + 2);
            RH_STEP(B, i + 1);
        }
#undef RH_STEP
#undef RH_LOAD
        wg_sync();
#pragma unroll
        for (int e = 0; e < TBH / 32; ++e) { const int i = (c.tid >> 4) + 32 * e, c4 = (c.tid & 15) * 4, st = blk * TBH + i, row = row0 + (d ? T - 1 - st : st); const f32x4 v = *(const LAS f32x4*)(OUTS + i * 64 + c4);
          u32x2 w; w.x = pk2(v.x, v.y); w.y = pk2(v.z, v.w); *(u32x2*)(O + (size_t)row * RW + h * 64 + c4) = w; }
        if (blk + 1 < nblk) lstore(buf ^ 1);
        wg_sync();
    }
}
DEV void ssd_chain(const Ctx& c, int l, bool lat, int b, int h, int d) {
    const int T = lat ? DEC_SEQ : SEQ, row0 = lat ? MC + b * DEC_SEQ : b * SEQ, nblk = T / TB, g = h / SHG;
    const bf16_t* XBC = c.ws<bf16_t>(WS_XBC); const float* DT = c.ws<float>(WS_DT) + (size_t)d * M * SH; bf16_t* Y = c.ws<bf16_t>(WS_YSSD) + (size_t)d * M * SW;
    const float aneg = -expf(c.in(I_SALOG)[(size_t)(l * 2 + d) * SH + h]);
    constexpr int BCS = 320;
    LAS float* BC = (LAS float*)c.lds;
    LAS float* XD = BC + 2 * TB * BCS;
    LAS float* DC = XD + 2 * TB * 64;
    LAS float* OUTS = DC + 2 * TB;
    const int p = c.tid >> 3, ng = c.tid & 7;
    f32x2 s2[8];
    if (lat) { const float* s0 = c.in(I_SSSD) + (((((size_t)b * DEPTH + l) * 2 + d) * SH + h) * 64 + p) * SN + ng * 16;
#pragma unroll
        for (int j = 0; j < 8; ++j) s2[j] = (f32x2){s0[2 * j], s0[2 * j + 1]}; }
    else {
#pragma unroll
        for (int j = 0; j < 8; ++j) s2[j] = (f32x2){0.f, 0.f}; }
    u32x4 stg[3]; float dtv = 0.f;
    auto rowof = [&](int blk, int i) { const int st = blk * TB + i; return row0 + (d ? T - 1 - st : st); };
    auto gload = [&](int blk) {
#pragma unroll
        for (int q = 0; q < 2; ++q) { const int task = c.tid + NTHREADS * q, i = task >> 5, cc = task & 31, row = rowof(blk, i);
            stg[q] = ld8(XBC + (size_t)row * SXBC + SW + (cc < 16 ? g * SN + cc * 8 : SG * SN + g * SN + (cc - 16) * 8)); }
        if (c.tid < TB * 8) { const int i = c.tid >> 3, cc = c.tid & 7, row = rowof(blk, i); stg[2] = ld8(XBC + (size_t)row * SXBC + h * 64 + cc * 8); dtv = DT[(size_t)row * SH + h]; } };
    auto lstore = [&](int buf) {
#pragma unroll
        for (int q = 0; q < 2; ++q) { const int task = c.tid + NTHREADS * q, i = task >> 5, cc = task & 31; float f[8]; unpack8(stg[q], f);
            LAS float* dst = BC + (buf * TB + i) * BCS + (cc >> 1) * 20 + (cc & 1) * 8; *(LAS f32x4*)dst = (f32x4){f[0], f[1], f[2], f[3]}; *(LAS f32x4*)(dst + 4) = (f32x4){f[4], f[5], f[6], f[7]}; }
        if (c.tid < TB * 8) { const int i = c.tid >> 3, cc = c.tid & 7; float f[8]; unpack8(stg[2], f);
            LAS float* dst = XD + (buf * TB + i) * 64 + cc * 8; *(LAS f32x4*)dst = (f32x4){f[0] * dtv, f[1] * dtv, f[2] * dtv, f[3] * dtv}; *(LAS f32x4*)(dst + 4) = (f32x4){f[4] * dtv, f[5] * dtv, f[6] * dtv, f[7] * dtv};
            if (cc == 0) DC[buf * TB + i] = expf(dtv * aneg); } };
    gload(0); lstore(0); wg_sync();
    for (int blk = 0; blk < nblk; ++blk) {
        const int buf = blk & 1;
        if (blk + 1 < nblk) gload(blk + 1);
        struct SsOps { f32x4 bv[4], cv[4]; float xd, dec; };
#define SS_LOAD(X, i_) do { const LAS float* Bp_ = BC + (buf * TB + (i_)) * BCS + ng * 20; \
            _Pragma("unroll") for (int q_ = 0; q_ < 4; ++q_) { X.bv[q_] = *(const LAS f32x4*)(Bp_ + 4 * q_); X.cv[q_] = *(const LAS f32x4*)(Bp_ + 160 + 4 * q_); } \
            X.xd = XD[(buf * TB + (i_)) * 64 + p]; X.dec = DC[buf * TB + (i_)]; } while (0)
#define SS_STEP(X, i_) do { const f32x2 xd2 = (f32x2){X.xd, X.xd}, dec2 = (f32x2){X.dec, X.dec}; f32x2 y2 = (f32x2){0.f, 0.f}; \
            _Pragma("unroll") for (int q_ = 0; q_ < 4; ++q_) { _Pragma("unroll") for (int hh = 0; hh < 2; ++hh) { s2[2 * q_ + hh] = s2[2 * q_ + hh] * dec2 + xd2 * PR(X.bv[q_], hh); y2 = s2[2 * q_ + hh] * PR(X.cv[q_], hh) + y2; } } \
            const float y = red8(y2.x + y2.y); if (ng == 0) OUTS[(i_) * 64 + p] = y; } while (0)
        SsOps A, B; SS_LOAD(A, 0);
#pragma unroll 1
        for (int i = 0; i < TB; i += 2) {
            SS_LOAD(B, i + 1); SS_STEP(A, i);
            if (i + 2 < TB) SS_LOAD(A, i + 2);
            SS_STEP(B, i + 1);
        }
#undef SS_STEP
#undef SS_LOAD
        wg_sync();
        { const int i = c.tid >> 4, c4 = (c.tid & 15) * 4, row = rowof(blk, i); const f32x4 v = *(const LAS f32x4*)(OUTS + i * 64 + c4);
          u32x2 w; w.x = pk2(v.x, v.y); w.y = pk2(v.z, v.w); *(u32x2*)(Y + (size_t)row * SW + h * 64 + c4) = w; }
        if (blk + 1 < nblk) lstore(buf ^ 1);
        wg_sync();
    }
    if (!lat) { float* o = c.out() + OUT_SSD + (((((size_t)b * DEPTH + l) * 2 + d) * SH + h) * 64 + p) * SN + ng * 16;
#pragma unroll
        for (int q = 0; q < 4; ++q) *(f32x4*)(o + 4 * q) = (f32x4){s2[2 * q].x, s2[2 * q].y, s2[2 * q + 1].x, s2[2 * q + 1].y}; }
}
DEV void s5_carry(const Ctx& c, int l, bool lat, int b, int g, int d) {
    const int T = lat ? DEC_SEQ : SEQ, nch = T / S5L, r0 = (lat ? MC + b * DEC_SEQ : b * SEQ) / S5L, p = c.lane;
    const float* SE = c.ws<float>(WS_SE) + (size_t)g * MCH * 256 + d * 128; bf16_t* SIN = c.ws<bf16_t>(WS_SIN) + (size_t)g * MCH * 256 + d * 128;
    const size_t gp = ((size_t)(l * 2 + d) * CG + g) * CP + p; const float delta = expf(c.in(I_CLDT)[(size_t)(l * 2 + d) * CG + g]);
    const float rho = c.in(I_CLRE)[gp] * delta * (float)S5L, th = c.in(I_CLIM)[gp] * delta * (float)S5L, mag = expf(rho), lr = mag * cosf(th), li = mag * sinf(th);
    float sr = 0.f, si = 0.f;
    if (lat) { const size_t so = (((size_t)b * DEPTH + l) * 2 + d) * CG * CP + (size_t)g * CP + p; sr = c.in(I_SRE)[so]; si = c.in(I_SIM)[so]; }
    constexpr int UB = 4; static_assert((SEQ / S5L) % UB == 0 && (DEC_SEQ / S5L) % UB == 0, "carry unroll");
    for (int cb = 0; cb < nch; cb += UB) {
        float er[UB], ei[UB];
#pragma unroll
        for (int q = 0; q < UB; ++q) { const int ch = d ? nch - 1 - (cb + q) : cb + q; er[q] = SE[(size_t)(r0 + ch) * 256 + p]; ei[q] = SE[(size_t)(r0 + ch) * 256 + 64 + p]; }
#pragma unroll
        for (int q = 0; q < UB; ++q) { const int ch = d ? nch - 1 - (cb + q) : cb + q; bf16_t* o = SIN + (size_t)(r0 + ch) * 256;
            o[p] = (bf16_t)f2bf(sr); o[64 + p] = (bf16_t)f2bf(si);
            const float nr = lr * sr - li * si + er[q], ni = lr * si + li * sr + ei[q]; sr = nr; si = ni; }
    }
    if (!lat) { const size_t so = (((size_t)b * DEPTH + l) * 2 + d) * CG * CP + (size_t)g * CP + p; c.out()[OUT_RE + so] = sr; c.out()[OUT_IM + so] = si; }
}
#ifdef CPU_EMU
#define MFMA16(a, b, c) emu_mfma16(a, b, c)
#else
#define MFMA16(a, b, c) __builtin_amdgcn_mfma_f32_16x16x32_bf16(a, b, c, 0, 0, 0)
#endif
constexpr int SCH = 64;
static_assert(SEQ % SCH == 0 && DEC_SEQ % SCH == 0 && SN == 128, "ssd chunking");
DEV void ssd_mfma_chain(const Ctx& c, int l, bool lat, int b, int h, int d) {
    const int T = lat ? DEC_SEQ : SEQ, row0 = lat ? MC + b * DEC_SEQ : b * SEQ, nch = T / SCH, g = h / SHG;
    const bf16_t* XBC = c.ws<bf16_t>(WS_XBC); const float* DT = c.ws<float>(WS_DT) + (size_t)d * M * SH; bf16_t* Y = c.ws<bf16_t>(WS_YSSD) + (size_t)d * M * SW;
    const float aneg = -expf(c.in(I_SALOG)[(size_t)(l * 2 + d) * SH + h]);
    constexpr int LDC = 136, LDX = 72;
    LAS bf16_t* Cs = (LAS bf16_t*)c.lds;
    LAS bf16_t* Bs = Cs + 64 * LDC;
    LAS bf16_t* Sb = Bs + 64 * LDC;
    LAS bf16_t* Bt = Sb + 64 * LDC;
    LAS bf16_t* Xt = Bt + 128 * LDX;
    LAS bf16_t* Xdt = Xt + 64 * LDX;
    LAS bf16_t* Ms = Xdt + 64 * LDX;
    LAS bf16_t* Ys = Ms + 64 * LDX;
    LAS bf16_t* Xs = Ys + 64 * LDX;
    LAS float* CUM = (LAS float*)(Xs + 64 * LDX);
    LAS float* DTV = CUM + 64;
    LAS float* WEND = DTV + 64;
    const int w = c.wave, lane = c.lane, r = lane & 15, q = lane >> 4;
    auto rowof = [&](int st) { return row0 + (d ? T - 1 - st : st); };
    f32x4 accS[4];
#pragma unroll
    for (int j = 0; j < 4; ++j) { const int ti = 4 * w + j, pt = ti >> 3, nt = ti & 7, p = 16 * pt + r, n0 = 16 * nt + 4 * q;
        accS[j] = lat ? *(const f32x4*)(c.in(I_SSSD) + (((((size_t)b * DEPTH + l) * 2 + d) * SH + h) * 64 + p) * SN + n0) : (f32x4){0.f, 0.f, 0.f, 0.f};
        u32x2 o; o.x = pk2(accS[j][0], accS[j][1]); o.y = pk2(accS[j][2], accS[j][3]); *(LAS u32x2*)(Sb + p * LDC + n0) = o; }
    u32x4 cR[2], bR[2], xR; float dtj = 0.f;
    auto prefetch = [&](int ck) {
#pragma unroll
        for (int e = 0; e < 2; ++e) { const int id = c.tid + NTHREADS * e, j = id >> 4, nc = (id & 15) * 8; const size_t ro = (size_t)rowof(ck * SCH + j) * SXBC + SW;
            cR[e] = ld8(XBC + ro + SG * SN + g * SN + nc); bR[e] = ld8(XBC + ro + g * SN + nc); }
        { const int j = c.tid >> 3, pc = (c.tid & 7) * 8; xR = ld8(XBC + (size_t)rowof(ck * SCH + j) * SXBC + h * 64 + pc); }
        dtj = DT[(size_t)rowof(ck * SCH + lane) * SH + h]; };
    prefetch(0);
    for (int ck = 0; ck < nch; ++ck) {
        float cum = dtj * aneg;
#pragma unroll
        for (int off = 1; off < 64; off <<= 1) { const float t = __shfl(cum, lane >= off ? lane - off : lane); if (lane >= off) cum += t; }
        const float cumL = __shfl(cum, 63), wend = dtj * __expf(cumL - cum), decL = __expf(cumL);
        if (w == 0) { CUM[lane] = cum; DTV[lane] = dtj; WEND[lane] = wend; }
#pragma unroll
        for (int e = 0; e < 2; ++e) { const int id = c.tid + NTHREADS * e, j = id >> 4, nc = (id & 15) * 8; *(LAS u32x4*)(Cs + j * LDC + nc) = cR[e]; *(LAS u32x4*)(Bs + j * LDC + nc) = bR[e]; }
        { const int j = c.tid >> 3, pc = (c.tid & 7) * 8; *(LAS u32x4*)(Xs + j * LDX + pc) = xR; }
        wg_sync();
#pragma unroll
        for (int e = 0; e < 2; ++e) { const int id = c.tid + NTHREADS * e, n = id & 127, s0 = (id >> 7) * 8; unsigned short v[8];
#pragma unroll
            for (int k = 0; k < 8; ++k) v[k] = Bs[(s0 + k) * LDC + n];
            u32x4 o; o.x = v[0] | ((unsigned)v[1] << 16); o.y = v[2] | ((unsigned)v[3] << 16); o.z = v[4] | ((unsigned)v[5] << 16); o.w = v[6] | ((unsigned)v[7] << 16); *(LAS u32x4*)(Bt + n * LDX + s0) = o; }
        { const int p = c.tid & 63, s0 = (c.tid >> 6) * 8; unsigned short v[8]; float f[8];
#pragma unroll
            for (int k = 0; k < 8; ++k) { v[k] = Xs[(s0 + k) * LDX + p]; f[k] = bf1(v[k]) * WEND[s0 + k]; }
            u32x4 o; o.x = v[0] | ((unsigned)v[1] << 16); o.y = v[2] | ((unsigned)v[3] << 16); o.z = v[4] | ((unsigned)v[5] << 16); o.w = v[6] | ((unsigned)v[7] << 16); *(LAS u32x4*)(Xt + p * LDX + s0) = o;
            *(LAS u32x4*)(Xdt + p * LDX + s0) = pack8(f); }
        wg_sync();
        if (ck + 1 < nch) prefetch(ck + 1);
#pragma unroll
        for (int e = 0; e < 2; ++e) { const int ti = 2 * w + e, tt = ti >> 2, st = ti & 3; f32x4 acc = (f32x4){0.f, 0.f, 0.f, 0.f};
            if (st <= tt) {
#pragma unroll
                for (int ks = 0; ks < 4; ++ks) acc = MFMA16(*(const LAS bf16x8*)(Bs + (16 * st + r) * LDC + 32 * ks + 8 * q), *(const LAS bf16x8*)(Cs + (16 * tt + r) * LDC + 32 * ks + 8 * q), acc); }
            const int t = 16 * tt + r, s0 = 16 * st + 4 * q; const float ct = CUM[t]; float v[4];
#pragma unroll
            for (int i = 0; i < 4; ++i) v[i] = s0 + i <= t ? acc[i] * __expf(ct - CUM[s0 + i]) * DTV[s0 + i] : 0.f;
            u32x2 o; o.x = pk2(v[0], v[1]); o.y = pk2(v[2], v[3]); *(LAS u32x2*)(Ms + t * LDX + s0) = o; }
        wg_sync();
#pragma unroll
        for (int e = 0; e < 2; ++e) { const int ti = 2 * w + e, tt = ti >> 2, pt = ti & 3; f32x4 a1 = (f32x4){0.f, 0.f, 0.f, 0.f}, a2 = a1;
#pragma unroll
            for (int ks = 0; ks < 2; ++ks) a1 = MFMA16(*(const LAS bf16x8*)(Xt + (16 * pt + r) * LDX + 32 * ks + 8 * q), *(const LAS bf16x8*)(Ms + (16 * tt + r) * LDX + 32 * ks + 8 * q), a1);
#pragma unroll
            for (int ks = 0; ks < 4; ++ks) a2 = MFMA16(*(const LAS bf16x8*)(Sb + (16 * pt + r) * LDC + 32 * ks + 8 * q), *(const LAS bf16x8*)(Cs + (16 * tt + r) * LDC + 32 * ks + 8 * q), a2);
            const int t = 16 * tt + r; const float ec = __expf(CUM[t]); u32x2 o; o.x = pk2(a1[0] + ec * a2[0], a1[1] + ec * a2[1]); o.y = pk2(a1[2] + ec * a2[2], a1[3] + ec * a2[3]); *(LAS u32x2*)(Ys + t * LDX + 16 * pt + 4 * q) = o; }
#pragma unroll
        for (int j = 0; j < 4; ++j) { const int ti = 4 * w + j, pt = ti >> 3, nt = ti & 7; accS[j] = accS[j] * decL;
#pragma unroll
            for (int ks = 0; ks < 2; ++ks) accS[j] = MFMA16(*(const LAS bf16x8*)(Bt + (16 * nt + r) * LDX + 32 * ks + 8 * q), *(const LAS bf16x8*)(Xdt + (16 * pt + r) * LDX + 32 * ks + 8 * q), accS[j]); }
        wg_sync();
#pragma unroll
        for (int j = 0; j < 4; ++j) { const int ti = 4 * w + j, pt = ti >> 3, nt = ti & 7; u32x2 o; o.x = pk2(accS[j][0], accS[j][1]); o.y = pk2(accS[j][2], accS[j][3]); *(LAS u32x2*)(Sb + (16 * pt + r) * LDC + 16 * nt + 4 * q) = o; }
        { const int t = c.tid >> 3, pc = (c.tid & 7) * 8; *(u32x4*)(Y + (size_t)rowof(ck * SCH + t) * SW + h * 64 + pc) = *(const LAS u32x4*)(Ys + t * LDX + pc); }
    }
    if (!lat) {
#pragma unroll
        for (int j = 0; j < 4; ++j) { const int ti = 4 * w + j, pt = ti >> 3, nt = ti & 7; *(f32x4*)(c.out() + OUT_SSD + (((((size_t)b * DEPTH + l) * 2 + d) * SH + h) * 64 + 16 * pt + r) * SN + 16 * nt + 4 * q) = accS[j]; } }
    wg_sync();
}
constexpr int TQ = 8;
static_assert(SEQ % TQ == 0 && (BATCH * RH * 2) % 4 == 0 && (BATCH * SH * 2) % 4 == 0, "quad scan shapes");
DEV void rwkv_quad(const Ctx& c, int l, int q) {
    constexpr int T = SEQ, nblk = T / TQ;
    const bf16_t* XS = c.ws<bf16_t>(WS_XS); const bf16_t* KK = c.ws<bf16_t>(WS_KK); const bf16_t* OMD = c.ws<bf16_t>(WS_OMD); const bf16_t* KD = c.ws<bf16_t>(WS_KD); const bf16_t* BB = c.ws<bf16_t>(WS_BB); bf16_t* O = c.ws<bf16_t>(WS_O);
    LAS float* VEC = (LAS float*)c.lds;
    LAS float* OUTS = VEC + 2 * 4 * TQ * 6 * 64;
    const int sg = c.tid >> 7, tg = c.tid & 127, rg = tg >> 3, cg = tg & 7;
    f32x2 s2[4][4];
#pragma unroll
    for (int rr = 0; rr < 4; ++rr)
#pragma unroll
        for (int j = 0; j < 4; ++j) s2[rr][j] = (f32x2){0.f, 0.f};
    u32x4 stg[3];
    auto gload = [&](int blk) {
#pragma unroll
        for (int qq = 0; qq < 3; ++qq) { const int task = c.tid + NTHREADS * qq, cq = task / (TQ * 48), rem = task % (TQ * 48), i = rem / 48, vec = (rem % 48) >> 3, cc = rem & 7;
            const int ch = 4 * q + cq, b = ch / (RH * 2), h = (ch >> 1) % RH, d = ch & 1, st = blk * TQ + i, row = b * SEQ + (d ? T - 1 - st : st); const size_t hc = (size_t)h * 64 + cc * 8, dm = (size_t)d * M * RW;
            const bf16_t* p = vec == 0 ? XS + (size_t)row * 3 * RW + hc : vec == 1 ? OMD + dm + (size_t)row * RW + hc : vec == 2 ? KD + dm + (size_t)row * RW + hc : vec == 3 ? BB + dm + (size_t)row * RW + hc : vec == 4 ? KK + (size_t)row * RW + hc : XS + (size_t)row * 3 * RW + 2 * RW + hc;
            stg[qq] = ld8(p); } };
    auto lstore = [&](int buf) {
#pragma unroll
        for (int qq = 0; qq < 3; ++qq) { const int task = c.tid + NTHREADS * qq, cq = task / (TQ * 48), rem = task % (TQ * 48), i = rem / 48, vec = (rem % 48) >> 3, cc = rem & 7; float f[8]; unpack8(stg[qq], f);
            if (vec == 1) {
#pragma unroll
                for (int j = 0; j < 8; ++j) f[j] = 1.0f - f[j]; }
            LAS float* dst = VEC + ((((buf * 4 + cq) * TQ + i) * 6 + vec) * 64) + cc * 8; *(LAS f32x4*)dst = (f32x4){f[0], f[1], f[2], f[3]}; *(LAS f32x4*)(dst + 4) = (f32x4){f[4], f[5], f[6], f[7]}; } };
    gload(0); lstore(0); wg_sync();
    for (int blk = 0; blk < nblk; ++blk) {
        const int buf = blk & 1;
        if (blk + 1 < nblk) gload(blk + 1);
#pragma unroll 1
        for (int i = 0; i < TQ; ++i) {
            const LAS float* V = VEC + ((buf * 4 + sg) * TQ + i) * 6 * 64;
            const f32x4 r0 = *(const LAS f32x4*)(V + cg * 8), r1 = *(const LAS f32x4*)(V + cg * 8 + 4), w0 = *(const LAS f32x4*)(V + 64 + cg * 8), w1 = *(const LAS f32x4*)(V + 68 + cg * 8), k0 = *(const LAS f32x4*)(V + 128 + cg * 8), k1 = *(const LAS f32x4*)(V + 132 + cg * 8),
                        b0 = *(const LAS f32x4*)(V + 192 + cg * 8), b1 = *(const LAS f32x4*)(V + 196 + cg * 8), q0 = *(const LAS f32x4*)(V + 256 + cg * 8), q1 = *(const LAS f32x4*)(V + 260 + cg * 8), v4 = *(const LAS f32x4*)(V + 320 + rg * 4);
            float skk[4];
#pragma unroll
            for (int rr = 0; rr < 4; ++rr) { f32x2 a2 = s2[rr][0] * PR(q0, 0); a2 = s2[rr][1] * PR(q0, 1) + a2; a2 = s2[rr][2] * PR(q1, 0) + a2; a2 = s2[rr][3] * PR(q1, 1) + a2; skk[rr] = a2.x + a2.y; }
#pragma unroll
            for (int rr = 0; rr < 4; ++rr) skk[rr] = red8(skk[rr]);
            float o[4];
#pragma unroll
            for (int rr = 0; rr < 4; ++rr) { const f32x2 v2 = (f32x2){v4[rr], v4[rr]}, n2 = (f32x2){-skk[rr], -skk[rr]};
                s2[rr][0] = s2[rr][0] * PR(w0, 0) + (n2 * PR(b0, 0) + v2 * PR(k0, 0)); s2[rr][1] = s2[rr][1] * PR(w0, 1) + (n2 * PR(b0, 1) + v2 * PR(k0, 1));
                s2[rr][2] = s2[rr][2] * PR(w1, 0) + (n2 * PR(b1, 0) + v2 * PR(k1, 0)); s2[rr][3] = s2[rr][3] * PR(w1, 1) + (n2 * PR(b1, 1) + v2 * PR(k1, 1));
                f32x2 o2 = s2[rr][0] * PR(r0, 0); o2 = s2[rr][1] * PR(r0, 1) + o2; o2 = s2[rr][2] * PR(r1, 0) + o2; o2 = s2[rr][3] * PR(r1, 1) + o2; o[rr] = o2.x + o2.y; }
#pragma unroll
            for (int rr = 0; rr < 4; ++rr) o[rr] = red8(o[rr]);
            if (cg == 0) *(LAS f32x4*)(OUTS + (sg * TQ + i) * 64 + rg * 4) = (f32x4){o[0], o[1], o[2], o[3]};
        }
        wg_sync();
        { const int cq = c.tid >> 7, i = (c.tid >> 4) & 7, c4 = (c.tid & 15) * 4, ch = 4 * q + cq, b = ch / (RH * 2), h = (ch >> 1) % RH, d = ch & 1, st = blk * TQ + i, row = b * SEQ + (d ? T - 1 - st : st);
          const f32x4 v = *(const LAS f32x4*)(OUTS + (cq * TQ + i) * 64 + c4); u32x2 w; w.x = pk2(v.x, v.y); w.y = pk2(v.z, v.w); *(u32x2*)(O + ((size_t)d * M + row) * RW + h * 64 + c4) = w; }
        if (blk + 1 < nblk) lstore(buf ^ 1);
        wg_sync();
    }
    { const int ch = 4 * q + sg, b = ch / (RH * 2), h = (ch >> 1) % RH, d = ch & 1;
#pragma unroll
      for (int rr = 0; rr < 4; ++rr) { float* o = c.out() + OUT_RWKV + ((((size_t)b * DEPTH + l) * 2 + d) * RH + h) * 4096 + (rg * 4 + rr) * 64 + cg * 8;
          *(f32x4*)o = (f32x4){s2[rr][0].x, s2[rr][0].y, s2[rr][1].x, s2[rr][1].y}; *(f32x4*)(o + 4) = (f32x4){s2[rr][2].x, s2[rr][2].y, s2[rr][3].x, s2[rr][3].y}; } }
}
DEV void ssd_quad(const Ctx& c, int l, int q) {
    constexpr int T = SEQ, nblk = T / TQ, BCS = 320;
    const bf16_t* XBC = c.ws<bf16_t>(WS_XBC); const float* DT = c.ws<float>(WS_DT); bf16_t* Y = c.ws<bf16_t>(WS_YSSD);
    LAS float* BC = (LAS float*)c.lds;
    LAS float* XD = BC + 2 * 4 * TQ * BCS;
    LAS float* DC = XD + 2 * 4 * TQ * 64;
    LAS float* OUTS = DC + 2 * 4 * TQ;
    const int sg = c.tid >> 7, tg = c.tid & 127, pg = tg >> 3, ng = tg & 7;
    f32x2 s2[4][8];
#pragma unroll
    for (int rr = 0; rr < 4; ++rr)
#pragma unroll
        for (int j = 0; j < 8; ++j) s2[rr][j] = (f32x2){0.f, 0.f};
    u32x4 stg[3]; float dtv = 0.f, anegv = 0.f;
    auto chain_of = [&](int cq, int& b, int& h, int& d) { const int ch = 4 * q + cq; b = ch / (SH * 2); h = (ch >> 1) % SH; d = ch & 1; };
    auto gload = [&](int blk) {
#pragma unroll
        for (int qq = 0; qq < 2; ++qq) { const int task = c.tid + NTHREADS * qq, cq = task >> 8, i = (task >> 5) & 7, cc = task & 31; int b, h, d; chain_of(cq, b, h, d); const int g = h / SHG, st = blk * TQ + i, row = b * SEQ + (d ? T - 1 - st : st);
            stg[qq] = ld8(XBC + (size_t)row * SXBC + SW + (cc < 16 ? g * SN + cc * 8 : SG * SN + g * SN + (cc - 16) * 8)); }
        if (c.tid < 4 * TQ * 8) { const int cq = c.tid >> 6, i = (c.tid >> 3) & 7, cc = c.tid & 7; int b, h, d; chain_of(cq, b, h, d); const int st = blk * TQ + i, row = b * SEQ + (d ? T - 1 - st : st);
            stg[2] = ld8(XBC + (size_t)row * SXBC + h * 64 + cc * 8); dtv = DT[((size_t)d * M + row) * SH + h]; anegv = -expf(c.in(I_SALOG)[(size_t)(l * 2 + d) * SH + h]); } };
    auto lstore = [&](int buf) {
#pragma unroll
        for (int qq = 0; qq < 2; ++qq) { const int task = c.tid + NTHREADS * qq, cq = task >> 8, i = (task >> 5) & 7, cc = task & 31; float f[8]; unpack8(stg[qq], f);
            LAS float* dst = BC + ((buf * 4 + cq) * TQ + i) * BCS + (cc >> 1) * 20 + (cc & 1) * 8; *(LAS f32x4*)dst = (f32x4){f[0], f[1], f[2], f[3]}; *(LAS f32x4*)(dst + 4) = (f32x4){f[4], f[5], f[6], f[7]}; }
        if (c.tid < 4 * TQ * 8) { const int cq = c.tid >> 6, i = (c.tid >> 3) & 7, cc = c.tid & 7; float f[8]; unpack8(stg[2], f);
            LAS float* dst = XD + ((buf * 4 + cq) * TQ + i) * 64 + cc * 8; *(LAS f32x4*)dst = (f32x4){f[0] * dtv, f[1] * dtv, f[2] * dtv, f[3] * dtv}; *(LAS f32x4*)(dst + 4) = (f32x4){f[4] * dtv, f[5] * dtv, f[6] * dtv, f[7] * dtv};
            if (cc == 0) DC[(buf * 4 + cq) * TQ + i] = expf(dtv * anegv); } };
    gload(0); lstore(0); wg_sync();
    for (int blk = 0; blk < nblk; ++blk) {
        const int buf = blk & 1;
        if (blk + 1 < nblk) gload(blk + 1);
#pragma unroll 1
        for (int i = 0; i < TQ; ++i) {
            const LAS float* Bp = BC + ((buf * 4 + sg) * TQ + i) * BCS + ng * 20; f32x4 bv[4], cv[4];
#pragma unroll
            for (int k = 0; k < 4; ++k) { bv[k] = *(const LAS f32x4*)(Bp + 4 * k); cv[k] = *(const LAS f32x4*)(Bp + 160 + 4 * k); }
            const f32x4 xd4 = *(const LAS f32x4*)(XD + ((buf * 4 + sg) * TQ + i) * 64 + pg * 4); const float dec = DC[(buf * 4 + sg) * TQ + i]; const f32x2 dec2 = (f32x2){dec, dec};
            float y[4];
#pragma unroll
            for (int rr = 0; rr < 4; ++rr) { const f32x2 xd2 = (f32x2){xd4[rr], xd4[rr]}; f32x2 y2 = (f32x2){0.f, 0.f};
#pragma unroll
                for (int k = 0; k < 4; ++k) {
#pragma unroll
                    for (int hh = 0; hh < 2; ++hh) { s2[rr][2 * k + hh] = s2[rr][2 * k + hh] * dec2 + xd2 * PR(bv[k], hh); y2 = s2[rr][2 * k + hh] * PR(cv[k], hh) + y2; } }
                y[rr] = y2.x + y2.y; }
#pragma unroll
            for (int rr = 0; rr < 4; ++rr) y[rr] = red8(y[rr]);
            if (ng == 0) *(LAS f32x4*)(OUTS + (sg * TQ + i) * 64 + pg * 4) = (f32x4){y[0], y[1], y[2], y[3]};
        }
        wg_sync();
        { const int cq = c.tid >> 7, i = (c.tid >> 4) & 7, c4 = (c.tid & 15) * 4; int b, h, d; chain_of(cq, b, h, d); const int st = blk * TQ + i, row = b * SEQ + (d ? T - 1 - st : st);
          const f32x4 v = *(const LAS f32x4*)(OUTS + (cq * TQ + i) * 64 + c4); u32x2 w; w.x = pk2(v.x, v.y); w.y = pk2(v.z, v.w); *(u32x2*)(Y + ((size_t)d * M + row) * SW + h * 64 + c4) = w; }
        if (blk + 1 < nblk) lstore(buf ^ 1);
        wg_sync();
    }
    { int b, h, d; chain_of(sg, b, h, d);
#pragma unroll
      for (int rr = 0; rr < 4; ++rr) { float* o = c.out() + OUT_SSD + (((((size_t)b * DEPTH + l) * 2 + d) * SH + h) * 64 + pg * 4 + rr) * SN + ng * 16;
#pragma unroll
          for (int k = 0; k < 4; ++k) *(f32x4*)(o + 4 * k) = (f32x4){s2[rr][2 * k].x, s2[rr][2 * k].y, s2[rr][2 * k + 1].x, s2[rr][2 * k + 1].y}; } }
}
struct PoolSpan { int i0, i1; };
DEV PoolSpan pool_span(long lo, long hi, long base, int n, long cost) { PoolSpan s; s.i0 = cdiv_pos(lo - base, cost); s.i1 = cdiv_pos(hi - base, cost); if (s.i0 > n) s.i0 = n; if (s.i1 > n) s.i1 = n; return s; }
#ifndef CONV_CF0
#define CONV_CF0 80
#endif
#ifndef CONV_CF1
#define CONV_CF1 44
#endif
DEV int wq_pull(const Ctx& c, unsigned* head) {
    volatile LAS unsigned* slot = (volatile LAS unsigned*)(c.lds + LDS_MISC) + 4;
    if (c.tid == 0) {
#ifdef CPU_EMU
        *slot = (*head)++;
#else
        *slot = __hip_atomic_fetch_add(head, 1u, __ATOMIC_RELAXED, __HIP_MEMORY_SCOPE_AGENT);
#endif
    }
    wg_sync(); const int it = (int)*slot; wg_sync(); return it;
}
DEV void phase_conv_early(const Ctx& c, int l) {
    LAS float* scr = (LAS float*)(c.lds + c.wave * 16640); unsigned* head = (unsigned*)(c.a->ws + WS_CTL) + 8192 + 256 * 2 * DEPTH;
    constexpr int nchunk = (CONV_NE + 63) / 64;
    for (int ch = wq_pull(c, head); ch < nchunk; ch = wq_pull(c, head)) { for (int k = 0; k < 8; ++k) { const int r = ch * 64 + k * 8 + c.wave; if (r < CONV_NE) conv_one(c, l, false, r, scr); } wg_sync(); }
}
DEV void phase_scan(const Ctx& c, int l) {
    for (int rep = 0; rep < REP_RS; ++rep) {
        constexpr int NLR = DEC_BATCH * RH * 2, NQR = BATCH * RH * 2 / 4, NLS = DEC_BATCH * SH * 2, NCS4 = BATCH * SH * 2 / 4, NTOT = NLR + NQR + NLS + NCS4;
        (void)NTOT;
        unsigned* head = (unsigned*)(c.a->ws + WS_CTL) + 8192 + 256 * (l * 2 + rep);
        constexpr int CONV_CH = 64; const int nconv = CONV_NL + (l + 1 < DEPTH ? CONV_NE : 0), nchunk = (nconv + CONV_CH - 1) / CONV_CH;
        int ncf = l + 1 < DEPTH ? CONV_CF0 : CONV_CF1; if (ncf > c.G / 2) ncf = c.G / 2;
        LAS float* scr = (LAS float*)(c.lds + c.wave * 16640);
#define CONV_POOL() for (int ch = wq_pull(c, head + 192); ch < nchunk; ch = wq_pull(c, head + 192)) { \
            for (int k = 0; k < CONV_CH / NWAVES; ++k) { const int r = ch * CONV_CH + k * NWAVES + c.wave; if (r < nconv) { if (r < CONV_NL) conv_one(c, l, true, r, scr); else conv_one(c, l + 1, false, r - CONV_NL, scr); } } wg_sync(); }
        if (rep == 0 && c.bid >= c.G - ncf) { CONV_POOL() }
        for (int it = c.bid; it < NLR; it += c.G) rwkv_chain_h(c, l, it / (RH * 2), (it >> 1) % RH, it & 1);
        for (int it = wq_pull(c, head); it < NQR; it = wq_pull(c, head)) rwkv_quad(c, l, it);
        for (int it = wq_pull(c, head + 64); it < NLS; it = wq_pull(c, head + 64)) ssd_mfma_chain(c, l, true, it / (SH * 2), (it >> 1) % SH, it & 1);
        if (rep == 0) { CONV_POOL() }
#undef CONV_POOL
        { unsigned* hc = (unsigned*)(c.a->ws + WS_CTL) + 12288 + 64 * (l * 2 + rep);
          constexpr int NLC = DEC_BATCH * CG * 2, NCC = BATCH * CG * 2, CL = NWAVES, CC = 8 * NWAVES, NCHL = (NLC + CL - 1) / CL, NCHC = (NCC + CC - 1) / CC;
          for (int ch = wq_pull(c, hc); ch < NCHL + NCHC; ch = wq_pull(c, hc)) {
              if (ch < NCHL) { const int i = ch * CL + c.wave; if (i < NLC) s5_carry(c, l, true, i / (CG * 2), (i >> 1) % CG, i & 1); }
              else { for (int k = 0; k < 8; ++k) { const int i = (ch - NCHL) * CC + k * NWAVES + c.wave; if (i < NCC) s5_carry(c, l, false, i / (CG * 2), (i >> 1) % CG, i & 1); } } } }
        for (int it = wq_pull(c, head + 128); it < 2 * NCS4; it = wq_pull(c, head + 128)) {
#pragma unroll 1
            for (int k = 0; k < 2; ++k) { const int i = 2 * it + k; ssd_mfma_chain(c, l, false, i / (SH * 2), (i >> 1) % SH, i & 1); } }
    }
}

DEV void phase_post(const Ctx& c, int l) {
    const bf16_t* XS = c.ws<bf16_t>(WS_XS); const bf16_t* O = c.ws<bf16_t>(WS_O); const bf16_t* GG = c.ws<bf16_t>(WS_GG);
    const bf16_t* XBC = c.ws<bf16_t>(WS_XBC); const bf16_t* ZB = c.ws<bf16_t>(WS_ZB); const bf16_t* YS = c.ws<bf16_t>(WS_YSSD);
    bf16_t* YA = c.ws<bf16_t>(WS_YA); bf16_t* YB = c.ws<bf16_t>(WS_YB);
    for (int it = c.gw(); it < 2 * M; it += c.ngw()) {
        if (it < M) {
            const int row = it; constexpr int NCH = RW / 8, NIT = (NCH + 63) / 64;
            struct PostLd { u32x4 o0, o1, r, k, v, g; };
            auto issue = [&](int i, PostLd& L) { const int ch = c.lane + 64 * i; const int col = ch < NCH ? 8 * ch : 0;
                L.o0 = ld8(O + (size_t)row * RW + col); L.o1 = ld8(O + ((size_t)M + row) * RW + col);
                L.r = ld8(XS + (size_t)row * 3 * RW + col); L.k = ld8(XS + (size_t)row * 3 * RW + RW + col); L.v = ld8(XS + (size_t)row * 3 * RW + 2 * RW + col); L.g = ld8(GG + (size_t)row * RW + col); };
            auto finish = [&](int i, const PostLd& L) {
                const int ch = c.lane + 64 * i; const bool act = ch < NCH; const int col = act ? 8 * ch : 0, h = col / 64;
                float o[8], t[8], r[8], k[8], v[8], g[8];
                unpack8(L.o0, o); unpack8(L.o1, t); unpack8(L.r, r); unpack8(L.k, k); unpack8(L.v, v); unpack8(L.g, g);
                const float* rk = c.in(I_RRK) + ((size_t)l * RH + h) * 64 + (col & 63); const float* lg = c.in(I_RLNG) + (size_t)l * RW + col; const float* lb = c.in(I_RLNB) + (size_t)l * RW + col;
                float sm = 0.f, bn = 0.f;
#pragma unroll
                for (int j = 0; j < 8; ++j) { o[j] += t[j]; sm += o[j]; bn += r[j] * k[j] * rk[j]; }
                const float mu = red8(sm) * (1.0f / 64.0f); bn = red8(bn); float vq = 0.f;
#pragma unroll
                for (int j = 0; j < 8; ++j) { o[j] -= mu; vq += o[j] * o[j]; }
                const float rstd = rsqrtf(red8(vq) * (1.0f / 64.0f) + RWKV_LN_EPS);
#pragma unroll
                for (int j = 0; j < 8; ++j) o[j] = (o[j] * rstd * lg[j] + lb[j] + bn * v[j]) * g[j];
                if (act) st8(YA + (size_t)row * RW + col, pack8(o)); };
            PostLd LA, LB; issue(0, LA);
#pragma unroll 1
            for (int i = 0; i < NIT; i += 2) {
                if (i + 1 < NIT) issue(i + 1, LB);
                finish(i, LA);
                if (i + 2 < NIT) issue(i + 2, LA);
                if (i + 1 < NIT) finish(i + 1, LB);
            }
        } else {
            const int row = it - M; constexpr int NCH = SW / 8, NIT = (NCH + 63) / 64; float y[NIT][8]; float ss = 0.f;
#pragma unroll
            for (int i = 0; i < NIT; ++i) {
                const int ch = c.lane + 64 * i; const bool act = ch < NCH; const int col = act ? 8 * ch : 0; float x[8], a[8], b[8], z[8];
                unpack8(ld8(XBC + (size_t)row * SXBC + col), x); unpack8(ld8(YS + (size_t)row * SW + col), a); unpack8(ld8(YS + ((size_t)M + row) * SW + col), b); unpack8(ld8(ZB + (size_t)row * ZB_LD + col), z);
                const float dsk = c.in(I_SD)[(size_t)l * SH + col / 64];
#pragma unroll
                for (int j = 0; j < 8; ++j) { const float v = act ? (dsk * x[j] + a[j] + b[j]) * siluf_(z[j]) : 0.f; y[i][j] = v; ss += v * v; }
            }
            const float rstd = rsqrtf(wave_sum(ss) * (1.0f / SW) + EPS);
#pragma unroll
            for (int i = 0; i < NIT; ++i) { const int ch = c.lane + 64 * i; if (ch < NCH) { const int col = 8 * ch; const float* g = c.in(I_SNG) + (size_t)l * SW + col; float o[8];
#pragma unroll
                for (int j = 0; j < 8; ++j) o[j] = y[i][j] * rstd * g[j];
                st8(YB + (size_t)row * SW + col, pack8(o)); } }
        }
    }
}

constexpr int PH_PER_LAYER = 18, NPH = 2 + DEPTH * PH_PER_LAYER;
template <class Epi> DEV void run_gemm(const Ctx& c, const bf16_t* A, const bf16_t* Bt, int N, int K, const Epi& E) {
#ifndef CPU_EMU
    asm volatile("" : "+s"(K));
#endif
    pg8::Gemm g{A, Bt, M, N, K}; pg8::StaticOrder S; S.init(M, N, c.G, c.bid);
    pg8::gemm_phase<Epi, pg8::StaticOrder, PG8_ALIGN, PG8_SP2>(c.lds, c.tid, g, S, E);
}
template <class Epi, int NT> DEV void run_gemm_batched(const Ctx& c, const bf16_t* A, const bf16_t* Bt, int K, const Epi& E) {
#ifndef CPU_EMU
    asm volatile("" : "+s"(K));
#endif
    pg8::Gemm g{A, Bt, 0, 0, K}; BatchOrder<NT> S{c.G, c.bid};
    pg8::gemm_phase<Epi, BatchOrder<NT>, PG8_ALIGN, PG8_SP2>(c.lds, c.tid, g, S, E);
}
template <class Epi> DEV void run_gemm_projc(const Ctx& c, const bf16_t* A, const bf16_t* Bt, int K, const Epi& E) {
#ifndef CPU_EMU
    asm volatile("" : "+s"(K));
#endif
    pg8::Gemm g{A, Bt, M, 2 * D, K}; ProjCOrder S; S.base.init(M, D, c.G, c.bid);
    pg8::gemm_phase<Epi, ProjCOrder, PG8_ALIGN, PG8_SP2>(c.lds, c.tid, g, S, E);
}
template <class Epi> DEV void run_gemm_norm(const Ctx& c, const bf16_t* A, const bf16_t* Bt, int K, const Epi& E) {
#ifndef CPU_EMU
    asm volatile("" : "+s"(K));
    static_assert(PG8_ALIGN && M / 256 == 64 && D / 256 == 8, "fused norm: aligned epilogue, 64 x 8 units");
    pg8::Gemm g{A, Bt, M, D, K}; PanelOrder S{c.G, c.bid};
    pg8::gemm_phase<Epi, PanelOrder, PG8_ALIGN, PG8_SP2>(c.lds, c.tid, g, S, E);
#else
    pg8::Gemm g{A, Bt, M, D, K}; pg8::StaticOrder S; S.init(M, D, c.G, c.bid);
    pg8::gemm_phase<Epi, pg8::StaticOrder, PG8_ALIGN, PG8_SP2>(c.lds, c.tid, g, S, E);
#endif
}
#define NORM_CNT(l, j) ((unsigned*)(c.a->ws + WS_CTL) + CTL_NORM_CNT + (size_t)((l) * 3 + (j)) * 4096)
#define NORM_SLOTS() ((float*)(c.a->ws + WS_CTL) + CTL_NORM_SLOTS)
#ifdef CPU_EMU
#define GRID_BAR() do {} while (0)
#else
#define GRID_BAR() xcd_barrier(bar)
#endif
#ifdef CPU_EMU
inline void mega_body(const Args& args, unsigned char* lds_base)
#else
__global__ void __launch_bounds__(NTHREADS, 2) mega_fwd(Args args)
#endif
{
#ifndef CPU_EMU
    extern __shared__ __attribute__((aligned(16))) unsigned char lds_base[];
#endif
#ifndef CPU_EMU
    volatile LAS unsigned* MISC = (volatile LAS unsigned*)((LAS unsigned char*)lds_base + LDS_MISC);
    if (threadIdx.x < 16) MISC[threadIdx.x] = 0u;
    __syncthreads();
    XcdBarrier bar = xcd_barrier_post((unsigned*)(args.ws + WS_CTL) + 4096, MISC + 8);
    const int wave_s = __builtin_amdgcn_readfirstlane(threadIdx.x >> 6);
#define MKCTX() Ctx c; { const Args CAS* ap_ = (const Args CAS*)__builtin_amdgcn_kernarg_segment_ptr(); asm volatile("" : "+s"(ap_)); int tid_ = wave_s * 64 + (int)__builtin_amdgcn_mbcnt_hi(~0u, __builtin_amdgcn_mbcnt_lo(~0u, 0u)); asm volatile("" : "+v"(tid_)); \
        c.a = ap_; c.lds = (LAS unsigned char*)lds_base; c.tid = tid_; c.lane = tid_ & 63; c.wave = RFL(tid_ >> 6); c.bid = blockIdx.x; c.G = gridDim.x; }
#else
#define MKCTX() Ctx c; c.a = &args; c.lds = lds_base; c.tid = threadIdx.x; c.lane = c.tid & 63; c.wave = c.tid >> 6; c.bid = blockIdx.x; c.G = gridDim.x;
#endif
    const int lo = args.ph_lo, hi = args.ph_hi;
#ifndef PHMASK
#define PHMASK 0xFFFFFu
#endif
#define PHON(j) (((PHMASK) >> (j)) & 1u)
#define IN(k) (lo <= (k) && (k) < hi)
#define SEAM(k) do { if (IN((k) + 1)) GRID_BAR(); } while (0)
    if (PHON(18) && IN(0)) { { MKCTX(); for (int it = c.G - 1 - c.bid; it < DEPTH * CG; it += c.G) s5_build(c, it / CG, it % CG); } { MKCTX(); for (int rep = 0; rep < REP_CONV; ++rep) phase_pro(c); } { MKCTX(); phase_conv_early(c, 0); } SEAM(0); }
#define MOD_L(l) const float* mod = c.ws<float>(WS_MOD) + (size_t)(l) * NCOND * NMOD * D; (void)mod
#ifndef LRSEL
#define LRSEL 7
#endif
#define LAYER_BODY(l) { const int pb = 1 + (l) * PH_PER_LAYER; \
        if ((l) == 0 && PHON(0) && IN(pb + 0)) { { MKCTX(); phase_norm(c, l, 0); } SEAM(pb + 0); } \
        if (PHON(2) && IN(pb + 2)) { MKCTX(); MOD_L(l); run_gemm(c, c.ws<bf16_t>(WS_H), c.ws<bf16_t>(WS_FIT), 2 * FF, D, EpiSwiglu{c.ws<bf16_t>(WS_ACT)}); SEAM(pb + 2); } \
        if (PHON(3) && IN(pb + 3)) { MKCTX(); MOD_L(l); run_gemm_norm(c, c.ws<bf16_t>(WS_ACT), c.ws<bf16_t>(WS_FOT), FF, EpiResidNorm<false, true, (l) == 0>{c.ws<bf16_t>(WS_X), mod + 2 * D, c.in(I_NORMG) + (size_t)((l) * 3 + 1) * D, mod + 3 * D, c.ws<bf16_t>(WS_H), nullptr, NORM_SLOTS(), NORM_CNT(l, 0), c.lds, c.in(I_XP), c.in(I_XS)}); SEAM(pb + 3); } \
        if (PHON(5) && IN(pb + 5)) { { MKCTX(); run_gemm(c, c.ws<bf16_t>(WS_H), c.ws<bf16_t>(WS_WIT), RCOLS + ZB_LD, D, EpiZ{c.ws<bf16_t>(WS_ZA), c.ws<bf16_t>(WS_ZB)}); } { MKCTX(); run_gemm(c, c.ws<bf16_t>(WS_H), c.ws<bf16_t>(WS_WIT) + (size_t)(RCOLS + ZB_LD) * D, CW, D, EpiZC{c.ws<bf16_t>(WS_UG)}); } SEAM(pb + 5); } \
        if (PHON(6) && IN(pb + 6)) { MKCTX(); MOD_L(l); for (int rep = 0; rep < REP_ELT; ++rep) phase_prep(c, l); SEAM(pb + 6); } \
        if (PHON(7) && IN(pb + 7)) { \
            if (LRSEL & 1) { MKCTX(); run_gemm(c, c.ws<bf16_t>(WS_LRI), c.ws<bf16_t>(WS_LRT), 2 * RW, 256, EpiLRw{c.ws<bf16_t>(WS_OMD), c.in(I_RW0) + (size_t)l * 2 * RW}); } \
            if (LRSEL & 2) { MKCTX(); run_gemm(c, c.ws<bf16_t>(WS_LRI), c.ws<bf16_t>(WS_LRT) + (size_t)2 * RW * 256, 2 * RW, 256, \
                     EpiLRa{c.ws<bf16_t>(WS_KD), c.ws<bf16_t>(WS_BB), c.ws<bf16_t>(WS_XS), c.ws<bf16_t>(WS_KK), c.in(I_RA0) + (size_t)l * 2 * RW, c.in(I_RKA) + (size_t)l * RW}); } \
            if (LRSEL & 4) { MKCTX(); run_gemm(c, c.ws<bf16_t>(WS_LRI), c.ws<bf16_t>(WS_LRT) + (size_t)4 * RW * 256, RW, 256, EpiLRg{c.ws<bf16_t>(WS_GG)}); } \
            { MKCTX(); run_gemm_batched<EpiS5a, S5NT1>(c, c.ws<bf16_t>(WS_UG), c.ws<bf16_t>(WS_S5W + (size_t)(l) * S5W_L), S5K, EpiS5a{c.ws<bf16_t>(WS_YL), c.ws<float>(WS_SE)}); } \
            SEAM(pb + 7); } \
        if (PHON(8) && IN(pb + 8)) { MKCTX(); MOD_L(l); phase_scan(c, l); SEAM(pb + 8); } \
        if (PHON(9) && IN(pb + 9)) { { MKCTX(); MOD_L(l); for (int rep = 0; rep < REP_ELT; ++rep) phase_post(c, l); } { MKCTX(); run_gemm_batched<EpiS5b, S5NT2>(c, c.ws<bf16_t>(WS_SIN), c.ws<bf16_t>(WS_S5F + (size_t)(l) * S5F_L), 256, EpiS5b{c.ws<bf16_t>(WS_YL), c.ws<bf16_t>(WS_UG), c.ws<bf16_t>(WS_YC), c.in(I_CD) + (size_t)(l) * CW}); } { MKCTX(); run_gemm(c, c.ws<bf16_t>(WS_H), c.ws<bf16_t>(WS_WIT) + (size_t)NZ_MIX * D, 3 * D, D, EpiGate{c.ws<gate8_t>(WS_ZG)}); } SEAM(pb + 9); } \
        if (PHON(11) && IN(pb + 11)) { { MKCTX(); run_gemm(c, c.ws<bf16_t>(WS_YA), c.ws<bf16_t>(WS_PAT), D, RW, EpiProjAB<true>{c.ws<bf16_t>(WS_MRG), c.ws<gate8_t>(WS_ZG), 0}); } \
            { MKCTX(); run_gemm(c, c.ws<bf16_t>(WS_YB), c.ws<bf16_t>(WS_PBT), D, SW, EpiProjAB<false>{c.ws<bf16_t>(WS_MRG), c.ws<gate8_t>(WS_ZG), D}); } \
            { MKCTX(); run_gemm_projc(c, c.ws<bf16_t>(WS_YC), c.ws<bf16_t>(WS_PCT), CW, EpiProjC{c.ws<bf16_t>(WS_MRG), c.ws<bf16_t>(WS_MRGB), c.ws<gate8_t>(WS_ZG)}); } SEAM(pb + 11); } \
        if (PHON(14) && IN(pb + 14)) { MKCTX(); MOD_L(l); run_gemm_norm(c, c.ws<bf16_t>(WS_MRGB), c.ws<bf16_t>(WS_WOT), D, EpiResidNorm<false, false>{c.ws<bf16_t>(WS_X), mod + 5 * D, c.in(I_NORMG) + (size_t)((l) * 3 + 2) * D, mod + 6 * D, c.ws<bf16_t>(WS_H3), nullptr, NORM_SLOTS(), NORM_CNT(l, 1), c.lds, nullptr, nullptr}); SEAM(pb + 14); } \
        if (PHON(16) && IN(pb + 16)) { MKCTX(); MOD_L(l); run_gemm(c, c.ws<bf16_t>(WS_H3), c.ws<bf16_t>(WS_FIT) + (size_t)2 * FF * D, 2 * FF, D, EpiSwiglu{c.ws<bf16_t>(WS_ACT)}); SEAM(pb + 16); } \
        if (PHON(17) && IN(pb + 17)) { MKCTX(); MOD_L(l); \
            if ((l) + 1 < DEPTH) { run_gemm_norm(c, c.ws<bf16_t>(WS_ACT), c.ws<bf16_t>(WS_FOT) + (size_t)D * FF, FF, EpiResidNorm<false, true>{c.ws<bf16_t>(WS_X), mod + 8 * D, c.in(I_NORMG) + (size_t)(((l) + 1) * 3) * D, mod + (size_t)NCOND * NMOD * D, c.ws<bf16_t>(WS_H), nullptr, NORM_SLOTS(), NORM_CNT(l, 2), c.lds, nullptr, nullptr}); SEAM(pb + 17); } \
            else run_gemm_norm(c, c.ws<bf16_t>(WS_ACT), c.ws<bf16_t>(WS_FOT) + (size_t)D * FF, FF, EpiResidNorm<true, true>{c.ws<bf16_t>(WS_X), mod + 8 * D, c.in(I_FNG), nullptr, nullptr, c.out() + OUT_Y, NORM_SLOTS(), NORM_CNT(l, 2), c.lds, nullptr, nullptr}); } }
    LAYER_BODY(0)
    LAYER_BODY(1)
    static_assert(DEPTH == 2, "two layer bodies written out");
#undef IN
#undef SEAM
}

#ifndef CPU_EMU
#ifndef MK_PER_PHASE
#define MK_PER_PHASE 0
#endif
extern "C" void kernel_launch(void* const* d_in, const int* in_sizes, int n_in, void* d_out, int out_size, void* d_ws, size_t ws_size, hipStream_t stream) {
    static int grid = 0;
    if (grid == 0) {
        if (n_in != N_IN || (size_t)out_size != OUT_END || ws_size < WS_END) { fprintf(stderr, "kernel_launch: shape mismatch: n_in %d out %d ws %zu (need %zu)\n", n_in, out_size, ws_size, (size_t)WS_END); grid = -1; return; }
        int dev = 0, cus = 0, per_cu = 0;
        if (hipGetDevice(&dev) != hipSuccess || hipDeviceGetAttribute(&cus, hipDeviceAttributeMultiprocessorCount, dev) != hipSuccess) { grid = -1; return; }
        if (hipFuncSetAttribute((const void*)mega_fwd, hipFuncAttributeMaxDynamicSharedMemorySize, LDS_BYTES) != hipSuccess) { fprintf(stderr, "kernel_launch: hipFuncSetAttribute failed\n"); grid = -1; return; }
        if (hipOccupancyMaxActiveBlocksPerMultiprocessor(&per_cu, (const void*)mega_fwd, NTHREADS, LDS_BYTES) != hipSuccess || per_cu < 1) fprintf(stderr, "kernel_launch: occupancy query reports %d\n", per_cu);
        (void)hipGetLastError();
        grid = cus;
    }
    if (grid < 0) return;
    (void)hipMemsetAsync((char*)d_ws + WS_CTL, 0, CTL_BYTES, stream);
    Args a{};
    for (int i = 0; i < N_IN; ++i) a.in[i] = (const float*)d_in[i];
    a.out = (float*)d_out; a.ws = (unsigned char*)d_ws;
#if MK_PER_PHASE
    for (int p = 0; p < NPH; ++p) { a.ph_lo = p; a.ph_hi = p + 1; hipLaunchKernelGGL(mega_fwd, dim3(grid), dim3(NTHREADS), LDS_BYTES, stream, a); }
#else
    a.ph_lo = 0; a.ph_hi = NPH;
    hipLaunchKernelGGL(mega_fwd, dim3(grid), dim3(NTHREADS), LDS_BYTES, stream, a);
#endif
    const hipError_t le = hipPeekAtLastError();
    if (le != hipSuccess) fprintf(stderr, "kernel_launch: launch failed: %s\n", hipGetErrorName(le));
}
#endif
```
